# Optimizing an MI355X kernel written in HIP

```python
import math
import jax
import jax.numpy as jnp
from jax import lax
import numpy as np

D_MODEL = 4096
BATCH = 8
SEQ = 2048
DEPTH = 4

N_HEADS = 32
HEAD_DIM = D_MODEL // N_HEADS
N_KV_GROUPS = 4
GROUP_SIZE = N_HEADS // N_KV_GROUPS
N_A_LAYERS = DEPTH // 2
CMP_BLOCK = 32
CMP_STRIDE = 16
CMP_HIDDEN = HEAD_DIM
SLC_BLOCK = 64
N_SELECT = 16
WINDOW = 512
Q_BLOCK = 128
N_BUCKETS = 32
MAX_DISTANCE = 128
RMS_EPS = 1e-6
FORCE_SCORE = 1e6
NSA_IN = 4 * N_HEADS * HEAD_DIM + 6 * N_KV_GROUPS * HEAD_DIM + 3 * N_HEADS
SB_IN = 2 * N_HEADS * HEAD_DIM

kernel_name = 'hybrid_nsa_stickbreaking_yoco'


def rms_norm(x, g):
    xf = x.astype(jnp.float32)
    y = xf * lax.rsqrt(jnp.mean(xf * xf, axis=-1, keepdims=True) + RMS_EPS)
    return (y * g.astype(jnp.float32)).astype(x.dtype)


def t5_bucket(dist):
    max_exact = N_BUCKETS // 2
    d = jnp.maximum(dist, 0)
    log_ratio = jnp.log(jnp.maximum(d, max_exact).astype(jnp.float32) / max_exact)
    large = max_exact + (log_ratio / math.log(MAX_DISTANCE / max_exact)
                         * (N_BUCKETS - max_exact)).astype(jnp.int32)
    return jnp.where(d < max_exact, d, jnp.minimum(large, N_BUCKETS - 1))


def static_bias(rel_bias, dist):
    q_len, k_len = dist.shape
    b = rel_bias[t5_bucket(dist)].astype(jnp.float32)
    return b.transpose(2, 0, 1).reshape(N_KV_GROUPS, GROUP_SIZE, q_len, k_len)


def masked_softmax(s, mask):
    s = jnp.where(mask, s, -jnp.inf)
    m = jnp.max(s, axis=-1, keepdims=True)
    m = jnp.where(jnp.isfinite(m), m, 0.0)
    e = jnp.where(mask, jnp.exp(s - m), 0.0)
    return e / jnp.maximum(jnp.sum(e, axis=-1, keepdims=True), 1e-30)


def compress(k, pos, w1, w2):
    b, g, t, dh = k.shape
    n_cmp = (t - CMP_BLOCK) // CMP_STRIDE + 1
    idx = np.arange(n_cmp)[:, None] * CMP_STRIDE + np.arange(CMP_BLOCK)[None, :]
    blocks = (k[:, :, idx, :] + pos).reshape(b, g, n_cmp, CMP_BLOCK * dh)
    return jax.nn.silu(blocks @ w1) @ w2


def nsa_layer(h, w_in, cmp_pos, cmp_k_w1, cmp_k_w2, cmp_v_w1, cmp_v_w2, w_out, rel_bias):
    B, T, _ = h.shape
    G, R, Dh = N_KV_GROUPS, GROUP_SIZE, HEAD_DIM
    HD, GD = N_HEADS * HEAD_DIM, N_KV_GROUPS * HEAD_DIM
    scale = 1.0 / math.sqrt(Dh)
    cuts = [int(c) for c in np.cumsum([HD, GD, GD, GD, GD, GD, GD, 3 * N_HEADS, HD, HD])]
    (q, kc_raw, vc_raw, ks_raw, vs_raw, kw_raw, vw_raw, gate_logits,
     z_c, z_s, z_w) = jnp.split(h @ w_in, cuts, axis=-1)

    def to_groups(t):
        return t.reshape(B, T, G, Dh).transpose(0, 2, 1, 3)

    q = q.reshape(B, T, G, R, Dh).transpose(0, 2, 3, 1, 4)

    n_cmp = (T - CMP_BLOCK) // CMP_STRIDE + 1
    cmp_start = (np.arange(n_cmp) * CMP_STRIDE).astype(np.int32)
    cmp_end = (cmp_start + CMP_BLOCK - 1).astype(np.int32)
    kc = compress(to_groups(kc_raw), cmp_pos, cmp_k_w1, cmp_k_w2)
    vc = compress(to_groups(vc_raw), cmp_pos, cmp_v_w1, cmp_v_w2)

    n_slc = T // SLC_BLOCK
    n_sel = min(N_SELECT, n_slc)
    slc_start = (np.arange(n_slc) * SLC_BLOCK).astype(np.int32)
    overlap = jnp.asarray(((cmp_start[:, None] < slc_start[None, :] + SLC_BLOCK)
                           & (cmp_end[:, None] >= slc_start[None, :])).astype(np.float32))
    ks_blk = to_groups(ks_raw).reshape(B, G, n_slc, SLC_BLOCK, Dh)
    vs_blk = to_groups(vs_raw).reshape(B, G, n_slc, SLC_BLOCK, Dh)
    b_idx = jnp.arange(B)[:, None, None, None]
    g_idx = jnp.arange(G)[None, :, None, None]
    bias_by_group = rel_bias.reshape(N_BUCKETS, G, R).transpose(1, 0, 2)

    pad = ((0, 0), (0, 0), (WINDOW, 0), (0, 0))
    kw = jnp.pad(to_groups(kw_raw), pad)
    vw = jnp.pad(to_groups(vw_raw), pad)

    def query_block(i):
        q0 = i * Q_BLOCK
        qi = lax.dynamic_slice_in_dim(q, q0, Q_BLOCK, axis=3)
        tpos = q0 + jnp.arange(Q_BLOCK)

        dist_c = tpos[:, None] - cmp_end[None, :]
        s_c = (jnp.einsum('bgrqd,bgnd->bgrqn', qi, kc, preferred_element_type=jnp.float32) * scale
               + static_bias(rel_bias, dist_c))
        p_c = masked_softmax(s_c, dist_c >= 0)
        o_c = jnp.einsum('bgrqn,bgnd->bgrqd', p_c.astype(vc.dtype), vc)

        imp = jnp.einsum('bgrqn,ns->bgqs', p_c, overlap)
        j = jnp.arange(n_slc)[None, :]
        cur = (tpos // SLC_BLOCK)[:, None]
        forced = (j == 0) | (j == cur) | (j == cur - 1)
        valid = slc_start[None, :] <= tpos[:, None]
        imp = jnp.where(forced, FORCE_SCORE, jnp.where(valid, imp, -1.0))
        _, sel = lax.top_k(imp, n_sel)
        n_key = n_sel * SLC_BLOCK
        ks = ks_blk[b_idx, g_idx, sel].reshape(B, G, Q_BLOCK, n_key, Dh)
        vs = vs_blk[b_idx, g_idx, sel].reshape(B, G, Q_BLOCK, n_key, Dh)
        kpos_s = (sel[..., None] * SLC_BLOCK + jnp.arange(SLC_BLOCK)).reshape(B, G, Q_BLOCK, n_key)
        dist_s = tpos[None, None, :, None] - kpos_s
        bias_s = jnp.moveaxis(bias_by_group[g_idx, t5_bucket(dist_s)], -1, 2).astype(jnp.float32)
        s_s = (jnp.einsum('bgrqd,bgqkd->bgrqk', qi, ks, preferred_element_type=jnp.float32) * scale
               + bias_s)
        p_s = masked_softmax(s_s, (dist_s >= 0)[:, :, None])
        o_s = jnp.einsum('bgrqk,bgqkd->bgrqd', p_s.astype(vs.dtype), vs)

        kwi = lax.dynamic_slice_in_dim(kw, q0, Q_BLOCK + WINDOW, axis=2)
        vwi = lax.dynamic_slice_in_dim(vw, q0, Q_BLOCK + WINDOW, axis=2)
        kpos_w = q0 - WINDOW + jnp.arange(Q_BLOCK + WINDOW)
        dist_w = tpos[:, None] - kpos_w[None, :]
        mask_w = (dist_w >= 0) & (dist_w < WINDOW) & (kpos_w[None, :] >= 0)
        s_w = (jnp.einsum('bgrqd,bgkd->bgrqk', qi, kwi, preferred_element_type=jnp.float32) * scale
               + static_bias(rel_bias, dist_w))
        p_w = masked_softmax(s_w, mask_w)
        o_w = jnp.einsum('bgrqk,bgkd->bgrqd', p_w.astype(vwi.dtype), vwi)
        return o_c, o_s, o_w

    o_c, o_s, o_w = lax.map(query_block, jnp.arange(T // Q_BLOCK))

    def gated(o, z):
        o = o.transpose(1, 0, 4, 2, 3, 5).reshape(B, T, N_HEADS, Dh)
        return o * jax.nn.silu(z.reshape(B, T, N_HEADS, Dh))

    gates = jax.nn.sigmoid(gate_logits).reshape(B, T, 3, N_HEADS, 1)
    mixed = (gates[:, :, 0] * gated(o_c, z_c) + gates[:, :, 1] * gated(o_s, z_s)
             + gates[:, :, 2] * gated(o_w, z_w))
    return mixed.reshape(B, T, HD) @ w_out


def stick_breaking_layer(h, w_in, w_out, k_sh, v_sh):
    B, T, _ = h.shape
    H, Dh = N_HEADS, HEAD_DIM
    scale = 1.0 / math.sqrt(Dh)
    q, z = jnp.split(h @ w_in, 2, axis=-1)
    q = q.reshape(B, T, H, Dh).transpose(0, 2, 1, 3)
    kpos = jnp.arange(T)

    def query_block(i):
        q0 = i * Q_BLOCK
        qi = lax.dynamic_slice_in_dim(q, q0, Q_BLOCK, axis=2)
        tpos = q0 + jnp.arange(Q_BLOCK)
        logits = jnp.einsum('bhqd,bhkd->bhqk', qi, k_sh, preferred_element_type=jnp.float32) * scale
        mask = kpos[None, :] < tpos[:, None]
        neg_log_keep = jnp.where(mask, jax.nn.softplus(logits), 0.0)
        between = lax.cumsum(neg_log_keep, axis=3, reverse=True) - neg_log_keep
        a = jnp.where(mask, jnp.exp(jax.nn.log_sigmoid(logits) - between), 0.0)
        return jnp.einsum('bhqk,bhkd->bhqd', a.astype(v_sh.dtype), v_sh)

    o = lax.map(query_block, jnp.arange(T // Q_BLOCK))
    o = o.transpose(1, 0, 3, 2, 4).reshape(B, T, H * Dh)
    return (o * jax.nn.silu(z)) @ w_out


def setup_inputs(seed: int = 0) -> dict:
    key = jax.random.key(seed)
    keys = iter(jax.random.split(key, 48))
    HD = N_HEADS * HEAD_DIM

    def normal(shape, scale):
        return jax.random.normal(next(keys), shape, jnp.float32) * scale

    def gain():
        return 1.0 + normal((D_MODEL,), 0.01)

    inputs = {'x': normal((BATCH, SEQ, D_MODEL), 1.0),
              'rel_bias': normal((N_BUCKETS, N_HEADS), 0.5)}
    for l in range(N_A_LAYERS):
        p = f'a{l}_'
        inputs[p + 'norm'] = gain()
        inputs[p + 'w_in'] = normal((D_MODEL, NSA_IN), D_MODEL ** -0.5)
        inputs[p + 'cmp_pos'] = normal((CMP_BLOCK, HEAD_DIM), 0.1)
        inputs[p + 'cmp_k_w1'] = normal((CMP_BLOCK * HEAD_DIM, CMP_HIDDEN), (CMP_BLOCK * HEAD_DIM) ** -0.5)
        inputs[p + 'cmp_k_w2'] = normal((CMP_HIDDEN, HEAD_DIM), CMP_HIDDEN ** -0.5)
        inputs[p + 'cmp_v_w1'] = normal((CMP_BLOCK * HEAD_DIM, CMP_HIDDEN), (CMP_BLOCK * HEAD_DIM) ** -0.5)
        inputs[p + 'cmp_v_w2'] = normal((CMP_HIDDEN, HEAD_DIM), CMP_HIDDEN ** -0.5)
        inputs[p + 'w_out'] = normal((HD, D_MODEL), HD ** -0.5)
    inputs['kv_norm'] = gain()
    inputs['w_kv'] = normal((D_MODEL, 2 * HD), D_MODEL ** -0.5)
    for l in range(N_A_LAYERS, DEPTH):
        p = f'b{l}_'
        inputs[p + 'norm'] = gain()
        inputs[p + 'w_in'] = normal((D_MODEL, SB_IN), D_MODEL ** -0.5)
        inputs[p + 'w_out'] = normal((HD, D_MODEL), HD ** -0.5)
    inputs['final_norm'] = gain()
    return inputs


def reference(x, rel_bias,
              a0_norm, a0_w_in, a0_cmp_pos, a0_cmp_k_w1, a0_cmp_k_w2, a0_cmp_v_w1, a0_cmp_v_w2, a0_w_out,
              a1_norm, a1_w_in, a1_cmp_pos, a1_cmp_k_w1, a1_cmp_k_w2, a1_cmp_v_w1, a1_cmp_v_w2, a1_w_out,
              kv_norm, w_kv,
              b2_norm, b2_w_in, b2_w_out,
              b3_norm, b3_w_in, b3_w_out,
              final_norm):
    nsa_params = [
        (a0_norm, a0_w_in, a0_cmp_pos, a0_cmp_k_w1, a0_cmp_k_w2, a0_cmp_v_w1, a0_cmp_v_w2, a0_w_out),
        (a1_norm, a1_w_in, a1_cmp_pos, a1_cmp_k_w1, a1_cmp_k_w2, a1_cmp_v_w1, a1_cmp_v_w2, a1_w_out),
    ]
    sb_params = [(b2_norm, b2_w_in, b2_w_out), (b3_norm, b3_w_in, b3_w_out)]
    B, T, _ = x.shape
    k_sh = v_sh = None
    for layer in range(DEPTH):
        if layer < N_A_LAYERS:
            norm, w_in, pos, kw1, kw2, vw1, vw2, w_out = nsa_params[layer]
            x = x + nsa_layer(rms_norm(x, norm), w_in, pos, kw1, kw2, vw1, vw2, w_out, rel_bias)
        else:
            if layer == N_A_LAYERS:
                k_flat, v_flat = jnp.split(rms_norm(x, kv_norm) @ w_kv, 2, axis=-1)
                k_sh = k_flat.reshape(B, T, N_HEADS, HEAD_DIM).transpose(0, 2, 1, 3)
                v_sh = v_flat.reshape(B, T, N_HEADS, HEAD_DIM).transpose(0, 2, 1, 3)
            norm, w_in, w_out = sb_params[layer - N_A_LAYERS]
            x = x + stick_breaking_layer(rms_norm(x, norm), w_in, w_out, k_sh, v_sh)
    return rms_norm(x, final_norm)
```

```cpp
#include <hip/hip_runtime.h>
#include <cstdio>
#include <cstdint>

#define LAS __attribute__((address_space(3)))
#define GAS __attribute__((address_space(1)))
typedef unsigned short bf16_t;
typedef short bf16x8 __attribute__((ext_vector_type(8)));
typedef short s16x4 __attribute__((ext_vector_type(4)));
typedef float f32x4 __attribute__((ext_vector_type(4)));
typedef float f32x16 __attribute__((ext_vector_type(16)));
typedef unsigned u32x4 __attribute__((ext_vector_type(4)));
typedef unsigned u32x2 __attribute__((ext_vector_type(2)));

constexpr int BATCH = 8, SEQ = 2048, DM = 4096, NH = 32, HD = 128, NGRP = 4, GSZ = 8;
constexpr int MTOK = BATCH * SEQ;
constexpr int NSA_N = 19456;
constexpr int KVW = 3072, ZW = 12288, NGATE = 96;
constexpr int NCMP = 127;
constexpr float RMS_EPS = 1e-6f;
constexpr float SM_SCALE = 0.08838834764831845f;
constexpr float LOG2E = 1.4426950408889634f;
constexpr float LN2 = 0.6931471805599453f;

constexpr size_t MiB = 1u << 20;
constexpr size_t WS_CTL = 0, CTL_ZERO_BYTES = 512 * 1024;
constexpr size_t WS_SS = 64 * 1024;
constexpr size_t WS_C1 = 1 * MiB;
constexpr size_t WS_KC = 2 * MiB;
constexpr size_t WS_VC = 3 * MiB;
constexpr size_t WS_W2T = 4 * MiB;
constexpr size_t WS_W1T = 8 * MiB;
constexpr size_t WS_SSP = 12 * MiB;
constexpr int SS_NP = 64;
constexpr size_t WS_WG = 16 * MiB;
constexpr size_t WS_WAIN = 20 * MiB;
constexpr size_t WAIN_BYTES = (size_t)NSA_N * DM * 2;
constexpr size_t WS_WAOUT = WS_WAIN + 2 * WAIN_BYTES;
constexpr size_t WOUT_BYTES = (size_t)DM * DM * 2;
constexpr size_t WS_WKVQ = WS_WAOUT + 2 * WOUT_BYTES;
constexpr size_t WS_WB3 = WS_WKVQ + (size_t)16384 * DM * 2;
constexpr size_t WS_WBOUT = WS_WB3 + (size_t)8192 * DM * 2;
constexpr size_t WS_HN = WS_WBOUT + 2 * WOUT_BYTES;
constexpr size_t WS_PROJ = WS_HN + (size_t)MTOK * DM * 2;
constexpr size_t WS_Q = WS_PROJ;
constexpr size_t WS_KV = WS_Q + (size_t)MTOK * DM * 2;
constexpr size_t WS_Z = WS_KV + (size_t)MTOK * KVW * 2;
constexpr size_t WS_G = WS_Z + (size_t)MTOK * ZW * 2;
constexpr size_t WS_KVSH = WS_PROJ;
constexpr size_t WS_QZ = WS_KVSH + (size_t)MTOK * 8192 * 2;
constexpr size_t WS_XB = WS_G + (size_t)MTOK * NGATE * 4;
constexpr size_t WS_END = WS_XB + (size_t)MTOK * DM * 2;
static_assert(WS_END <= (size_t)1515 * MiB, "d_ws map must fit the guaranteed workspace (sum of inputs = 1515 MiB)");
static_assert(WS_QZ + (size_t)MTOK * 8192 * 2 <= WS_XB, "SB overlay");
static_assert(WS_SS + 5 * 16384 * 4 <= CTL_ZERO_BYTES, "SS inside the memset region");

constexpr int LDS_BYTES = 147456;
constexpr int MISC_OFF = LDS_BYTES - 256;

__device__ __forceinline__ float row_sumsq(const float* ss, int np, int row) {
    float s = 0.f;
#pragma unroll 8
    for (int p = 0; p < np; ++p) s += ss[(size_t)p * MTOK + row];
    return s;
}
namespace pg8 {
#define PG8_LAS __attribute__((address_space(3)))
typedef unsigned short bf16_t;
typedef short bf16x8 __attribute__((ext_vector_type(8)));
typedef float f32x4 __attribute__((ext_vector_type(4)));
typedef unsigned u32x4 __attribute__((ext_vector_type(4)));
constexpr int BM = 256, BK = 64, HALF = 128, HTB = HALF * BK * 2  , STAGE_BYTES = 8 * HTB, NXCD = 8, WGM = 8;

__host__ __device__ __forceinline__ int lds_byte(int r, int c) { const int st = (r >> 4) * 2 + (c >> 5), rr = r & 15, cc = c & 31, ob = rr * 64 + cc * 2; return st * 1024 + (ob ^ (((ob >> 9) & 1) << 5)); }
__host__ __device__ __forceinline__ void stage_rc(int b, int& R, int& C) { const int st = b / 1024, sb = b % 1024, swz = sb ^ (((sb >> 9) & 1) << 5); R = (st >> 1) * 16 + swz / 64; C = (st & 1) * 32 + (swz % 64) / 2; }
__host__ __device__ __forceinline__ int perm32(int rho) { const int n = rho >> 4, i = rho & 15; return 8 * (i >> 2) + 4 * n + (i & 3); }

struct Unit { int pm, pn; };
struct Gemm { const bf16_t* A; const bf16_t* Bt; int M, N, K; };

struct StaticOrder {
    int nM, nN, nwg, G, c;
    __host__ __device__ void init(int M, int N, int G_, int c_) { nM = M / BM; nN = N / BM; nwg = nM * nN; G = G_; c = c_; }
    __host__ __device__ bool next(int i, Unit& u) const {
        const long L = (long)i * G + c; if (L >= nwg) return false;
        int wgid = (int)L; { const int q = nwg / NXCD, r = nwg % NXCD, xcd = wgid % NXCD, off = wgid / NXCD; wgid = (xcd < r ? xcd * (q + 1) : r * (q + 1) + (xcd - r) * q) + off; }
        const int nig = WGM * nN, gid = wgid / nig, fm = gid * WGM, gsz = (nM - fm) < WGM ? (nM - fm) : WGM;
        u.pm = fm + ((wgid % nig) % gsz); u.pn = (wgid % nig) / gsz; return true;
    }
    __device__ __forceinline__ void a_ready(const Unit&) const {}
    __device__ __forceinline__ void done(const Unit&) const {}
};


__device__ __forceinline__ unsigned cvt_pk_bf16(float lo, float hi) { unsigned r; asm volatile("v_cvt_pk_bf16_f32 %0, %1, %2" : "=v"(r) : "v"(lo), "v"(hi)); return r; }

struct EpiSplit {
    static constexpr bool PERM = true, AFTER_DRAIN = false;
    bf16_t* O0; int ld0; int t1; bf16_t* O1; int ld1; int t2; bf16_t* O2; int ld2; const float* ss; const PG8_LAS float* rs_lds; int fm; int np;
    __device__ __forceinline__ void operator()(const f32x4 (&acc)[2][2][4][2], const Unit& u, int wr, int wc, int fr, int fq) const {
        const int row0 = u.pm * BM + wr * 64 + fr;
        bf16_t* base; int ldc, ct;
        if (u.pn < t1) { base = O0; ldc = ld0; ct = u.pn; } else if (u.pn < t2) { base = O1; ldc = ld1; ct = u.pn - t1; } else { base = O2; ldc = ld2; ct = u.pn - t2; }
        const int col0 = ct * BM + wc * 32 + 8 * fq;
#pragma unroll
        for (int ai = 0; ai < 2; ++ai)
#pragma unroll
            for (int m = 0; m < 4; ++m) { bf16_t* rowp = base + (size_t)(row0 + ai * HALF + m * 16) * ldc + col0;
                const unsigned pl = (unsigned)(u.pm - fm);
                const float rs = pl < 8u ? rs_lds[pl * BM + wr * 64 + fr + ai * HALF + m * 16] : 1.0f / sqrtf(row_sumsq(ss, np, row0 + ai * HALF + m * 16) * (1.0f / 4096.0f) + 1e-6f);
#pragma unroll
                for (int bj = 0; bj < 2; ++bj) { const f32x4 v0 = acc[ai][bj][m][0] * rs, v1 = acc[ai][bj][m][1] * rs;
                    u32x4 w; w.x = cvt_pk_bf16(v0[0], v0[1]); w.y = cvt_pk_bf16(v0[2], v0[3]); w.z = cvt_pk_bf16(v1[0], v1[1]); w.w = cvt_pk_bf16(v1[2], v1[3]);
                    *(u32x4*)(rowp + bj * HALF) = w; } }
    }
};
struct EpiRes {
    static constexpr bool PERM = true, AFTER_DRAIN = false;
    bf16_t* xb; float* out; int ldc; float* ssp; int last;
    __device__ __forceinline__ void operator()(const f32x4 (&acc)[2][2][4][2], const Unit& u, int wr, int wc, int fr, int fq) const {
        const int row0 = u.pm * BM + wr * 64 + fr, col0 = u.pn * BM + wc * 32 + 8 * fq;
        float* sp = ssp + (size_t)(u.pn * 4 + wc) * MTOK;
#pragma unroll
        for (int ai = 0; ai < 2; ++ai) {
            u32x4 r[4][2];
#pragma unroll
            for (int m = 0; m < 4; ++m) { const size_t off = (size_t)(row0 + ai * HALF + m * 16) * ldc + col0;
#pragma unroll
                for (int bj = 0; bj < 2; ++bj) r[m][bj] = *(const u32x4*)(xb + off + bj * HALF); }
#pragma unroll
            for (int m = 0; m < 4; ++m) { const size_t off = (size_t)(row0 + ai * HALF + m * 16) * ldc + col0;
                float sq = 0.f;
#pragma unroll
                for (int bj = 0; bj < 2; ++bj) { const u32x4 rv = r[m][bj];
                    const f32x4 o0 = (f32x4){__uint_as_float(rv.x << 16), __uint_as_float(rv.x & 0xffff0000u), __uint_as_float(rv.y << 16), __uint_as_float(rv.y & 0xffff0000u)} + acc[ai][bj][m][0];
                    const f32x4 o1 = (f32x4){__uint_as_float(rv.z << 16), __uint_as_float(rv.z & 0xffff0000u), __uint_as_float(rv.w << 16), __uint_as_float(rv.w & 0xffff0000u)} + acc[ai][bj][m][1];
                    sq += ((o0[0] * o0[0] + o0[1] * o0[1]) + (o0[2] * o0[2] + o0[3] * o0[3])) + ((o1[0] * o1[0] + o1[1] * o1[1]) + (o1[2] * o1[2] + o1[3] * o1[3]));
                    if (last) { *(f32x4*)(out + off + bj * HALF) = o0; *(f32x4*)(out + off + bj * HALF + 4) = o1; }
                    else { u32x4 w; w.x = cvt_pk_bf16(o0[0], o0[1]); w.y = cvt_pk_bf16(o0[2], o0[3]); w.z = cvt_pk_bf16(o1[0], o1[1]); w.w = cvt_pk_bf16(o1[2], o1[3]); *(u32x4*)(xb + off + bj * HALF) = w; } }
                sq += __shfl_xor(sq, 16); sq += __shfl_xor(sq, 32);
                if (fq == 0) sp[row0 + ai * HALF + m * 16] = sq; }
            asm volatile("" ::: "memory");
        }
    }
};
template <class Epi, class Sched, bool ALIGN_EPI = false, bool SP2 = false>
__device__ __forceinline__ void gemm_phase(PG8_LAS unsigned char* lds, const Gemm g, const Sched& S, const Epi& E) {
    int tid_ = (int)threadIdx.x; asm volatile("" : "+v"(tid_));
    const int tid = tid_, wid = __builtin_amdgcn_readfirstlane(tid >> 6), lane = tid & 63, wr = wid >> 2, wc = wid & 3, fr = lane & 15, fq = lane >> 4;
    const int K = g.K, nt = K / BK;
    unsigned voffA[2], voffB[2];
#pragma unroll
    for (int i = 0; i < 2; ++i) { int R, C; stage_rc(tid * 16 + i * 8192, R, C); const int Rb = Epi::PERM ? ((R & ~31) + perm32(R & 31)) : R;
        voffA[i] = (unsigned)(R * K + C) * 2u; voffB[i] = (unsigned)(Rb * K + C) * 2u; }
    asm volatile("" : "+v"(voffA[0]), "+v"(voffA[1]), "+v"(voffB[0]), "+v"(voffB[1]));
    const size_t kstep = (size_t)(BK * 2);
    const size_t hstep = (size_t)HALF * K * 2;
    const size_t tstep = 2 * hstep;
    const unsigned ldsw = (unsigned)wid * 1024u;
    const int aoff = lds_byte(wr * 64 + fr, fq * 8), boff = lds_byte(wc * 32 + fr, fq * 8);
#define PG8_SA(b, h) (((b) * 2 + (h)) * HTB)
#define PG8_SB(b, h) ((4 + (b) * 2 + (h)) * HTB)
#define PG8_STAGE(bufoff, gbase, voff) do { _Pragma("unroll") for (int _i = 0; _i < 2; ++_i) \
        __builtin_amdgcn_global_load_lds((const unsigned*)((const char*)(gbase) + (voff)[_i]), (PG8_LAS unsigned*)(lds + (bufoff) + ldsw + _i * 8192), 16, 0, 0); } while (0)
#define PG8_LDA(dst, b, h) do { _Pragma("unroll") for (int m = 0; m < 4; ++m) _Pragma("unroll") for (int k = 0; k < 2; ++k) dst[m][k] = *(const PG8_LAS bf16x8*)(lds + PG8_SA(b, h) + aoff + m * 2048 + k * 1024); } while (0)
#define PG8_LDB(dst, b, h) do { _Pragma("unroll") for (int n = 0; n < 2; ++n) _Pragma("unroll") for (int k = 0; k < 2; ++k) dst[n][k] = *(const PG8_LAS bf16x8*)(lds + PG8_SB(b, h) + boff + n * 2048 + k * 1024); } while (0)
#define PG8_MMA(ai, bj, At, Bt) do { __builtin_amdgcn_s_setprio(1); _Pragma("unroll") for (int m = 0; m < 4; ++m) _Pragma("unroll") for (int n = 0; n < 2; ++n) _Pragma("unroll") for (int k = 0; k < 2; ++k) \
        acc[ai][bj][m][n] = __builtin_amdgcn_mfma_f32_16x16x32_bf16(Bt[n][k], At[m][k], acc[ai][bj][m][n], 0, 0, 0); __builtin_amdgcn_s_setprio(0); } while (0)
#define PG8_WAIT_V(n) asm volatile("s_waitcnt vmcnt(" #n ")" ::: "memory")
#define PG8_WAIT_L(n) asm volatile("s_waitcnt lgkmcnt(" #n ")" ::: "memory")
#define PG8_BAR __builtin_amdgcn_s_barrier()
#define PG8_SCHED __builtin_amdgcn_sched_barrier(0)
    Unit cur, nxt; int ui = 0;
    if (!S.next(0, cur)) return;
    f32x4 acc[2][2][4][2];
#pragma unroll
    for (int a = 0; a < 2; ++a)
#pragma unroll
        for (int b = 0; b < 2; ++b)
#pragma unroll
            for (int m = 0; m < 4; ++m)
#pragma unroll
                for (int n = 0; n < 2; ++n) acc[a][b][m][n] = (f32x4){0.f, 0.f, 0.f, 0.f};
    bf16x8 At[4][2], B0[2][2], B1[2][2];
    const char* cA = (const char*)g.A + (size_t)cur.pm * tstep; const char* cB = (const char*)g.Bt + (size_t)cur.pn * tstep;
    S.a_ready(cur);
    if constexpr (SP2) {
        PG8_STAGE(PG8_SB(0, 0), cB, voffB); PG8_STAGE(PG8_SB(0, 1), cB + hstep, voffB); PG8_STAGE(PG8_SA(0, 0), cA, voffA); PG8_STAGE(PG8_SA(0, 1), cA + hstep, voffA);
        if (wr == 1) PG8_BAR;
        PG8_WAIT_V(2); PG8_BAR;
        PG8_STAGE(PG8_SB(1, 0), cB + kstep, voffB); PG8_STAGE(PG8_SA(1, 0), cA + kstep, voffA); PG8_STAGE(PG8_SB(1, 1), cB + hstep + kstep, voffB);
        PG8_WAIT_V(6); PG8_BAR;
    } else {
        PG8_STAGE(PG8_SB(0, 0), cB, voffB); PG8_STAGE(PG8_SA(0, 0), cA, voffA); PG8_STAGE(PG8_SB(0, 1), cB + hstep, voffB); PG8_STAGE(PG8_SA(0, 1), cA + hstep, voffA);
        if (wr == 1) PG8_BAR;
        PG8_WAIT_V(4); PG8_BAR;
        PG8_STAGE(PG8_SB(1, 0), cB + kstep, voffB); PG8_STAGE(PG8_SA(1, 0), cA + kstep, voffA); PG8_STAGE(PG8_SB(1, 1), cB + hstep + kstep, voffB);
        PG8_WAIT_V(6); PG8_BAR;
    }
    for (;;) {
        const bool has_next = S.next(ui + 1, nxt);
        const char* nA = has_next ? (const char*)g.A + (size_t)nxt.pm * tstep : cA; const char* nB = has_next ? (const char*)g.Bt + (size_t)nxt.pn * tstep : cB;
        for (int t = 0; t < nt; t += 2) {
            const bool last = (t == nt - 2);
            const char* a1 = cA + (size_t)(t + 1) * kstep;
            const char* a2 = last ? nA : cA + (size_t)(t + 2) * kstep; const char* b2 = last ? nB : cB + (size_t)(t + 2) * kstep;
            const char* a3 = a2 + kstep; const char* b3 = b2 + kstep;
            if (last && has_next) S.a_ready(nxt);
            if constexpr (SP2) {
            PG8_LDB(B0, 0, 0); PG8_LDB(B1, 0, 1); PG8_SCHED; PG8_LDA(At, 0, 0); PG8_STAGE(PG8_SA(1, 1), a1 + hstep, voffA);
            PG8_WAIT_V(8); PG8_WAIT_L(0); PG8_BAR; PG8_MMA(0, 0, At, B0); PG8_MMA(0, 1, At, B1); PG8_BAR; PG8_SCHED;
            PG8_LDA(At, 0, 1); PG8_STAGE(PG8_SB(0, 0), b2, voffB); PG8_STAGE(PG8_SB(0, 1), b2 + hstep, voffB); PG8_STAGE(PG8_SA(0, 0), a2, voffA);
            PG8_WAIT_V(8); PG8_WAIT_L(0); PG8_BAR; PG8_MMA(1, 0, At, B0); PG8_MMA(1, 1, At, B1); PG8_BAR; PG8_SCHED;
            PG8_LDB(B0, 1, 0); PG8_LDB(B1, 1, 1); PG8_SCHED; PG8_LDA(At, 1, 0); PG8_STAGE(PG8_SA(0, 1), a2 + hstep, voffA);
            PG8_WAIT_V(8); PG8_WAIT_L(0); PG8_BAR; PG8_MMA(0, 0, At, B0); PG8_MMA(0, 1, At, B1); PG8_BAR; PG8_SCHED;
            PG8_LDA(At, 1, 1); PG8_STAGE(PG8_SB(1, 0), b3, voffB); PG8_STAGE(PG8_SB(1, 1), b3 + hstep, voffB); PG8_STAGE(PG8_SA(1, 0), a3, voffA);
            PG8_WAIT_V(8); PG8_WAIT_L(0); PG8_BAR; PG8_MMA(1, 0, At, B0); PG8_MMA(1, 1, At, B1); PG8_BAR; PG8_SCHED;
            } else {
            PG8_LDB(B0, 0, 0); PG8_SCHED; PG8_LDA(At, 0, 0); PG8_STAGE(PG8_SA(1, 1), a1 + hstep, voffA);
            PG8_WAIT_L(8); PG8_BAR; PG8_WAIT_L(0); PG8_MMA(0, 0, At, B0); PG8_BAR; PG8_SCHED;
            PG8_LDB(B1, 0, 1); PG8_STAGE(PG8_SB(0, 0), b2, voffB);
            PG8_BAR; PG8_WAIT_L(0); PG8_MMA(0, 1, At, B1); PG8_BAR;
            PG8_LDA(At, 0, 1); PG8_STAGE(PG8_SA(0, 0), a2, voffA);
            PG8_BAR; PG8_WAIT_L(0); PG8_MMA(1, 0, At, B0); PG8_BAR; PG8_SCHED;
            PG8_STAGE(PG8_SB(0, 1), b2 + hstep, voffB);
            PG8_WAIT_V(6); PG8_BAR; PG8_MMA(1, 1, At, B1); PG8_BAR;
            PG8_LDB(B0, 1, 0); PG8_SCHED; PG8_LDA(At, 1, 0); PG8_STAGE(PG8_SA(0, 1), a2 + hstep, voffA);
            PG8_WAIT_L(8); PG8_BAR; PG8_WAIT_L(0); PG8_MMA(0, 0, At, B0); PG8_BAR; PG8_SCHED;
            PG8_LDB(B1, 1, 1); PG8_STAGE(PG8_SB(1, 0), b3, voffB);
            PG8_BAR; PG8_WAIT_L(0); PG8_MMA(0, 1, At, B1); PG8_BAR;
            PG8_LDA(At, 1, 1); PG8_STAGE(PG8_SA(1, 0), a3, voffA);
            PG8_BAR; PG8_WAIT_L(0); PG8_MMA(1, 0, At, B0); PG8_BAR; PG8_SCHED;
            PG8_STAGE(PG8_SB(1, 1), b3 + hstep, voffB);
            PG8_WAIT_V(6); PG8_BAR; PG8_MMA(1, 1, At, B1); PG8_BAR;
            }
        }
        if constexpr (ALIGN_EPI) { if (wr == 0) PG8_BAR; }
        if constexpr (!Epi::AFTER_DRAIN) { E(acc, cur, wr, wc, fr, fq); S.done(cur); }
        if (!has_next) break;
#pragma unroll
        for (int a = 0; a < 2; ++a)
#pragma unroll
            for (int b = 0; b < 2; ++b)
#pragma unroll
                for (int m = 0; m < 4; ++m)
#pragma unroll
                    for (int n = 0; n < 2; ++n) acc[a][b][m][n] = (f32x4){0.f, 0.f, 0.f, 0.f};
        cur = nxt; cA = nA; cB = nB; ++ui;
        if constexpr (ALIGN_EPI) { if (wr == 1) PG8_BAR; }
    }
    PG8_WAIT_V(0);
    if constexpr (!ALIGN_EPI) { if (wr == 0) PG8_BAR; }
    PG8_BAR;
    if constexpr (Epi::AFTER_DRAIN) { E.fused(acc, cur, wr, wc, fr, fq, lds, wid, lane); S.done(cur); }
#undef PG8_SA
#undef PG8_SB
#undef PG8_STAGE
#undef PG8_LDA
#undef PG8_LDB
#undef PG8_MMA
#undef PG8_WAIT_V
#undef PG8_WAIT_L
#undef PG8_BAR
#undef PG8_SCHED
}
}
#define XB_TMO      128
#define XB_XCNT(j)  (256  + 64 * (j))
#define XB_XSUB(j)  (1280 + 64 * (j))
#define XB_XGEN(j)  (2304 + 64 * (j))
#define XB_TOP      3328
#define XB_TOPGEN   3392
#define XCD_BAR_WORDS 3456
#define XB_SPIN_CAP (1u << 18)

__device__ __forceinline__ unsigned xb_ld(unsigned* p)              { return __hip_atomic_load(p, __ATOMIC_RELAXED, __HIP_MEMORY_SCOPE_AGENT); }
__device__ __forceinline__ unsigned xb_add(unsigned* p, unsigned v) { return __hip_atomic_fetch_add(p, v, __ATOMIC_RELAXED, __HIP_MEMORY_SCOPE_AGENT); }
__device__ __forceinline__ unsigned xb_xcc_id() { return (unsigned)__builtin_amdgcn_s_getreg((3 << 11) | 20) & 0xFu; }
#define XB_SPIN(cond, bar) do { unsigned _sp = 0; while (cond) { __builtin_amdgcn_s_sleep(1); \
    if ((++_sp & 255u) == 0u) { if (xb_ld(&(bar)[XB_TMO])) break; if (_sp > XB_SPIN_CAP) { atomicAdd(&(bar)[XB_TMO], 1u); break; } } } } while (0)

struct XcdBarrier {
    unsigned* bar; unsigned x;
    volatile LAS unsigned* st;
};

__device__ __forceinline__ XcdBarrier xcd_barrier_post(unsigned* bar, volatile LAS unsigned* st) {
    XcdBarrier b; b.bar = bar; b.x = xb_xcc_id(); b.st = st;
    if (threadIdx.x == 0) (void)xb_add(&bar[XB_XCNT(b.x)], 1u);
    return b;
}
__device__ __forceinline__ void xcd_barrier_complete(unsigned* bar, unsigned x, unsigned& nloc, unsigned& nx) {
    const unsigned G = gridDim.x * gridDim.y * gridDim.z;
    unsigned sum, cnt, mine, sp = 0u;
    for (;;) {
        sum = 0u; cnt = 0u; mine = 0u;
#pragma unroll
        for (unsigned j = 0; j < 16; ++j) { const unsigned c = xb_ld(&bar[XB_XCNT(j)]); sum += c; cnt += (c > 0u) ? 1u : 0u; mine = (j == x) ? c : mine; }
        if (sum == G) break;
        __builtin_amdgcn_s_sleep(1);
        if ((++sp & 255u) == 0u) { if (xb_ld(&bar[XB_TMO])) break; if (sp > XB_SPIN_CAP) { atomicAdd(&bar[XB_TMO], 1u); break; } }
    }
    nloc = mine > 0u ? mine : 1u; nx = cnt > 0u ? cnt : 1u;
}

__device__ __forceinline__ void xcd_barrier(const XcdBarrier& b) {
    asm volatile("s_waitcnt vmcnt(0)" ::: "memory");
    __syncthreads();
    if (threadIdx.x == 0) {
        unsigned* bar = b.bar;
        __builtin_amdgcn_s_waitcnt(0);
        unsigned nloc = b.st[0], nx = b.st[1];
        if (nloc == 0u) { xcd_barrier_complete(bar, b.x, nloc, nx); b.st[0] = nloc; b.st[1] = nx; }
        const unsigned old = xb_add(&bar[XB_XSUB(b.x)], 1u);
        const unsigned gen = old / nloc;
        if (old + 1u == (gen + 1u) * nloc) {
            __builtin_amdgcn_fence(__ATOMIC_RELEASE, "agent");
            asm volatile("s_waitcnt vmcnt(0)" ::: "memory");
            const unsigned og = xb_add(&bar[XB_TOP], 1u);
            const unsigned tg = og / nx;
            if (og + 1u == (tg + 1u) * nx) xb_add(&bar[XB_TOPGEN], 1u);
            else XB_SPIN(xb_ld(&bar[XB_TOPGEN]) == tg, bar);
            __builtin_amdgcn_fence(__ATOMIC_ACQUIRE, "agent");
            xb_add(&bar[XB_XGEN(b.x)], 1u);
            asm volatile("s_waitcnt vmcnt(0)" ::: "memory");
        } else {
            XB_SPIN(xb_ld(&bar[XB_XGEN(b.x)]) == gen, bar);
            __builtin_amdgcn_fence(__ATOMIC_ACQUIRE, "agent");
            asm volatile("s_waitcnt vmcnt(0)" ::: "memory");
        }
    }
    __syncthreads();
}

#define LDS_WAIT() asm volatile("s_waitcnt lgkmcnt(0)" ::: "memory")
#define VM_WAIT() asm volatile("s_waitcnt vmcnt(0)" ::: "memory")
#define SBAR() __builtin_amdgcn_sched_barrier(0)
__device__ __forceinline__ unsigned cvtpk(float lo, float hi) { unsigned r; asm volatile("v_cvt_pk_bf16_f32 %0, %1, %2" : "=v"(r) : "v"(lo), "v"(hi)); return r; }
__device__ __forceinline__ float bf_lo(unsigned w) { return __uint_as_float(w << 16); }
__device__ __forceinline__ float bf_hi(unsigned w) { return __uint_as_float(w & 0xffff0000u); }
__device__ __forceinline__ float bf2f(bf16_t h) { return __uint_as_float(((unsigned)h) << 16); }
__device__ __forceinline__ float wave_sum(float v) {
#pragma unroll
    for (int o = 1; o < 64; o <<= 1) v += __shfl_xor(v, o);
    return v;
}
__device__ __forceinline__ float fast_exp2(float x) { return __builtin_amdgcn_exp2f(x); }
__device__ __forceinline__ float fast_log2(float x) { return __builtin_amdgcn_logf(x); }
__device__ __forceinline__ float fast_rcp(float x) { return __builtin_amdgcn_rcpf(x); }

__device__ __forceinline__ int tid_now() { int t = (int)threadIdx.x; asm volatile("" : "+v"(t)); return t; }

struct Params { const float* in[27]; float* out; unsigned char* ws; int ph_lo, ph_hi; };

struct TrJob { int src, N, c0, ncols, K, gain, r0; size_t dst; };
__device__ __forceinline__ void tr_item(const float* W, int N, int c0, int ncols, int K, const float* gain, bf16_t* WT, int r0, int kb, int nb, LAS float* scr, int lane) {
    const int k0 = kb * 64, n0 = nb * 64;
    const float* src = W + (size_t)k0 * N + c0 + n0 + lane;
#pragma unroll 16
    for (int i = 0; i < 64; ++i) scr[i * 65 + lane] = src[(size_t)i * N];
    LDS_WAIT(); asm volatile("" ::: "memory");
    const int c = lane & 7;
    float gv[8];
#pragma unroll
    for (int e = 0; e < 8; ++e) gv[e] = gain ? gain[k0 + 8 * c + e] : 1.0f;
#pragma unroll
    for (int j = 0; j < 8; ++j) { const int n = (lane >> 3) + 8 * j; const LAS float* s = scr + (8 * c) * 65 + n;
        u32x4 o; o.x = cvtpk(s[0 * 65] * gv[0], s[1 * 65] * gv[1]); o.y = cvtpk(s[2 * 65] * gv[2], s[3 * 65] * gv[3]); o.z = cvtpk(s[4 * 65] * gv[4], s[5 * 65] * gv[5]); o.w = cvtpk(s[6 * 65] * gv[6], s[7 * 65] * gv[7]);
        if (n0 + n >= ncols) o = (u32x4){0u, 0u, 0u, 0u};
        *(u32x4*)(WT + (size_t)(r0 + n0 + n) * K + k0 + 8 * c) = o; }
    LDS_WAIT(); asm volatile("" ::: "memory");
}
constexpr int NJOBS = 21;
__device__ __forceinline__ TrJob get_job(int id) {
    TrJob j{};
    if (id < 16) { const int l = id >> 3, k = id & 7, ib = 2 + 8 * l;
        switch (k) {
        case 0: j = TrJob{ib + 1, 19552, 0, 7168, 4096, ib, 0, WS_WAIN + l * WAIN_BYTES}; break;
        case 1: j = TrJob{ib + 1, 19552, 7264, 12288, 4096, ib, 7168, WS_WAIN + l * WAIN_BYTES}; break;
        case 2: j = TrJob{ib + 1, 19552, 7168, 96, 4096, ib, 0, WS_WG + (size_t)l * 128 * 4096 * 2}; break;
        case 3: j = TrJob{ib + 7, 4096, 0, 4096, 4096, -1, 0, WS_WAOUT + l * WOUT_BYTES}; break;
        case 4: j = TrJob{ib + 3, 128, 0, 128, 4096, -1, 0, WS_W1T + (size_t)(l * 2 + 0) * 128 * 4096 * 2}; break;
        case 5: j = TrJob{ib + 5, 128, 0, 128, 4096, -1, 0, WS_W1T + (size_t)(l * 2 + 1) * 128 * 4096 * 2}; break;
        case 6: j = TrJob{ib + 4, 128, 0, 128, 128, -1, 0, WS_W2T + (size_t)(l * 2 + 0) * 128 * 128 * 2}; break;
        default: j = TrJob{ib + 6, 128, 0, 128, 128, -1, 0, WS_W2T + (size_t)(l * 2 + 1) * 128 * 128 * 2}; break;
        }
    } else {
        switch (id) {
        case 16: j = TrJob{19, 8192, 0, 8192, 4096, 18, 0, WS_WKVQ}; break;
        case 17: j = TrJob{21, 8192, 0, 8192, 4096, 20, 8192, WS_WKVQ}; break;
        case 18: j = TrJob{22, 4096, 0, 4096, 4096, -1, 0, WS_WBOUT}; break;
        case 19: j = TrJob{24, 8192, 0, 8192, 4096, 23, 0, WS_WB3}; break;
        default: j = TrJob{25, 4096, 0, 4096, 4096, -1, 0, WS_WBOUT + WOUT_BYTES}; break;
        }
    }
    return j;
}
__device__ __forceinline__ int job_items(const TrJob& j) { return (j.K / 64) * ((j.ncols + 63) / 64); }

__device__ __forceinline__ void phase_x_to_bf16(const float* x, bf16_t* xb, float* ss) {
    const int tid = tid_now(), lane = tid & 63, gw = blockIdx.x * 8 + __builtin_amdgcn_readfirstlane(tid >> 6), ngw = gridDim.x * 8;
    for (int m = gw; m < MTOK; m += ngw) {
        const f32x4* xr = (const f32x4*)(x + (size_t)m * DM) + lane; u32x2* o8 = (u32x2*)(xb + (size_t)m * DM) + lane;
        f32x4 v[16]; float s = 0.f;
#pragma unroll
        for (int j = 0; j < 16; ++j) { v[j] = xr[64 * j]; s += (v[j].x * v[j].x + v[j].y * v[j].y) + (v[j].z * v[j].z + v[j].w * v[j].w); }
#pragma unroll
        for (int j = 0; j < 16; ++j) { u32x2 w; w.x = cvtpk(v[j].x, v[j].y); w.y = cvtpk(v[j].z, v[j].w); o8[64 * j] = w; }
        s = wave_sum(s);
        if (lane == 0) ss[m] = s;
    }
}
__device__ __forceinline__ void phase_final_norm(const bf16_t* xb, float* out, const float* g, const float* ss, LAS unsigned char* lds) {
    const int tid = tid_now(), lane = tid & 63, wave = __builtin_amdgcn_readfirstlane(tid >> 6);
    LAS float* RSF = (LAS float*)lds;
    for (int r0 = blockIdx.x * 64; r0 < MTOK; r0 += gridDim.x * 64) {
        __syncthreads();
        if (tid < 64) RSF[tid] = 1.0f / sqrtf(row_sumsq(ss, SS_NP, r0 + tid) * (1.0f / DM) + RMS_EPS);
        __syncthreads();
        for (int k = 0; k < 8; ++k) { const int m = r0 + wave * 8 + k;
            const u32x4* xr = (const u32x4*)(xb + (size_t)m * DM) + lane; f32x4* orow = (f32x4*)(out + (size_t)m * DM) + 2 * lane; const f32x4* gr = (const f32x4*)g + 2 * lane;
            const float rstd = RSF[wave * 8 + k];
#pragma unroll
            for (int j = 0; j < 8; ++j) { const u32x4 v = xr[64 * j];
                const f32x4 lo = (f32x4){__uint_as_float(v.x << 16), __uint_as_float(v.x & 0xffff0000u), __uint_as_float(v.y << 16), __uint_as_float(v.y & 0xffff0000u)};
                const f32x4 hi = (f32x4){__uint_as_float(v.z << 16), __uint_as_float(v.z & 0xffff0000u), __uint_as_float(v.w << 16), __uint_as_float(v.w & 0xffff0000u)};
                orow[128 * j] = lo * rstd * gr[128 * j]; orow[128 * j + 1] = hi * rstd * gr[128 * j + 1]; } }
    }
}

__device__ __forceinline__ void phase_prologue(const Params& P, LAS unsigned char* lds) {
    const int tid = tid_now(), lane = tid & 63, wave = __builtin_amdgcn_readfirstlane(tid >> 6), G = gridDim.x;
    LAS float* scr = (LAS float*)(lds + wave * 16640);
    const int gw = blockIdx.x * 8 + wave, ngw = G * 8;
    int base = 0;
    for (int id = 0; id < NJOBS; ++id) {
        const TrJob j = get_job(id); const int ni = job_items(j), nbn = (j.ncols + 63) / 64;
        int it = gw - (base % ngw); if (it < 0) it += ngw;
        const float* W = P.in[j.src]; const float* gain = j.gain >= 0 ? P.in[j.gain] : nullptr; bf16_t* WT = (bf16_t*)(P.ws + j.dst);
        for (; it < ni; it += ngw) tr_item(W, j.N, j.c0, j.ncols, j.K, gain, WT, j.r0, it / nbn, it % nbn, scr, lane);
        base += ni;
    }
    __syncthreads();
    for (int item = blockIdx.x; item < 64; item += G) {
        const int lk = item >> 4, kp = item & 15, l = lk >> 1, kv = lk & 1, ib = 2 + 8 * l;
        const float* pos = P.in[ib + 2]; const float* w1 = P.in[ib + 3 + 2 * kv];
        const int col = tid & 127, part = tid >> 7, kbeg = kp * 256 + part * 64; float s = 0.f;
#pragma unroll 8
        for (int k = kbeg; k < kbeg + 64; ++k) s += pos[k] * w1[(size_t)k * 128 + col];
        LAS float* red = (LAS float*)lds;
        red[part * 128 + col] = s; __syncthreads();
        if (tid < 128) ((float*)(P.ws + WS_C1))[item * 128 + tid] = (red[tid] + red[128 + tid]) + (red[256 + tid] + red[384 + tid]);
        __syncthreads();
    }
    phase_x_to_bf16(P.in[0], (bf16_t*)(P.ws + WS_XB), (float*)(P.ws + WS_SS));
}

__device__ __forceinline__ bf16x8 ld8(const bf16_t* p) { return *(const bf16x8*)p; }
__device__ __forceinline__ void compress_unit(const Params& P, int l, int cu, LAS unsigned char* lds) {
    const int tid = tid_now(), lane = tid & 63, wave = __builtin_amdgcn_readfirstlane(tid >> 6);
    const int rt = cu & 3, kv = (cu >> 2) & 1, bg = cu >> 3, b = bg >> 2, g = bg & 3;
    const bf16_t* raw = (const bf16_t*)(P.ws + WS_KV) + (size_t)(b * SEQ) * KVW + kv * 512 + g * 128;
    const bf16_t* w1t = (const bf16_t*)(P.ws + WS_W1T) + (size_t)(l * 2 + kv) * 128 * 4096;
    const bf16_t* w2t = (const bf16_t*)(P.ws + WS_W2T) + (size_t)(l * 2 + kv) * 128 * 128;
    const float* c1p = (const float*)(P.ws + WS_C1) + (size_t)(l * 2 + kv) * 16 * 128;
    bf16_t* outp = (bf16_t*)(P.ws + (kv ? WS_VC : WS_KC)) + (size_t)bg * 128 * 128;
    const int fr = lane & 15, fq = lane >> 4;
    LAS float* PART = (LAS float*)lds;
    LAS bf16_t* H = (LAS bf16_t*)(lds + 131072);
    {
        int n0 = rt * 32 + fr, n1 = n0 + 16; n0 = n0 > 126 ? 126 : n0; n1 = n1 > 126 ? 126 : n1;
        const bf16_t* ap0 = raw + (size_t)(16 * n0 + wave * 4) * KVW + fq * 8; const bf16_t* ap1 = raw + (size_t)(16 * n1 + wave * 4) * KVW + fq * 8;
        const bf16_t* bp = w1t + (size_t)fr * 4096 + wave * 512 + fq * 8;
        f32x4 acc[2][8];
#pragma unroll
        for (int i = 0; i < 2; ++i)
#pragma unroll
            for (int c = 0; c < 8; ++c) acc[i][c] = (f32x4){0.f, 0.f, 0.f, 0.f};
#pragma unroll 4
        for (int ks = 0; ks < 16; ++ks) {
            const bf16x8 a0 = ld8(ap0 + (size_t)(ks >> 2) * KVW + (ks & 3) * 32), a1 = ld8(ap1 + (size_t)(ks >> 2) * KVW + (ks & 3) * 32);
            bf16x8 bb[8];
#pragma unroll
            for (int c = 0; c < 8; ++c) bb[c] = ld8(bp + (size_t)c * 16 * 4096 + ks * 32);
#pragma unroll
            for (int c = 0; c < 8; ++c) { acc[0][c] = __builtin_amdgcn_mfma_f32_16x16x32_bf16(a0, bb[c], acc[0][c], 0, 0, 0); acc[1][c] = __builtin_amdgcn_mfma_f32_16x16x32_bf16(a1, bb[c], acc[1][c], 0, 0, 0); }
        }
#pragma unroll
        for (int i = 0; i < 2; ++i)
#pragma unroll
            for (int c = 0; c < 8; ++c)
#pragma unroll
                for (int r = 0; r < 4; ++r) PART[(wave * 32 + i * 16 + fq * 4 + r) * 128 + c * 16 + fr] = acc[i][c][r];
    }
    __syncthreads();
    { const int col = tid & 127; float cc = 0.f;
#pragma unroll
      for (int kp = 0; kp < 16; ++kp) cc += c1p[kp * 128 + col];
#pragma unroll
      for (int e = 0; e < 8; ++e) { const int row = (tid >> 7) * 8 + e; float v = cc;
#pragma unroll
          for (int w = 0; w < 8; ++w) v += PART[(w * 32 + row) * 128 + col];
          const float sv = v * fast_rcp(1.0f + fast_exp2(-v * LOG2E));
          H[row * 136 + col] = (bf16_t)(cvtpk(sv, 0.f) & 0xffffu); } }
    __syncthreads();
    const int rtile = wave & 1, ct0 = (wave >> 1) * 2;
    f32x4 o0 = {0.f, 0.f, 0.f, 0.f}, o1 = {0.f, 0.f, 0.f, 0.f};
#pragma unroll
    for (int ks = 0; ks < 4; ++ks) {
        const bf16x8 a = *(const LAS bf16x8*)(H + (rtile * 16 + fr) * 136 + ks * 32 + fq * 8);
        const bf16x8 b0 = ld8(w2t + (size_t)(ct0 * 16 + fr) * 128 + ks * 32 + fq * 8), b1 = ld8(w2t + (size_t)((ct0 + 1) * 16 + fr) * 128 + ks * 32 + fq * 8);
        o0 = __builtin_amdgcn_mfma_f32_16x16x32_bf16(a, b0, o0, 0, 0, 0);
        o1 = __builtin_amdgcn_mfma_f32_16x16x32_bf16(a, b1, o1, 0, 0, 0);
    }
#pragma unroll
    for (int c = 0; c < 2; ++c) { const int col = (ct0 + c) * 16 + fr;
#pragma unroll
        for (int r = 0; r < 4; ++r) { const int nr = rt * 32 + rtile * 16 + fq * 4 + r; const float v = nr < NCMP ? (c ? o1[r] : o0[r]) : 0.f;
            outp[(size_t)nr * 128 + col] = (bf16_t)(cvtpk(v, 0.f) & 0xffffu); } }
    __syncthreads();
}
__device__ __forceinline__ void gate_unit(const Params& P, int l, int gu, LAS unsigned char* lds) {
    const int tid = tid_now(), lane = tid & 63, wave = __builtin_amdgcn_readfirstlane(tid >> 6);
    const bf16_t* xb = (const bf16_t*)(P.ws + WS_XB); const bf16_t* wg = (const bf16_t*)(P.ws + WS_WG) + (size_t)l * 128 * 4096;
    const float* ss = l == 0 ? (const float*)(P.ws + WS_SS) : (const float*)(P.ws + WS_SSP); const int np = l == 0 ? 1 : SS_NP;
    float* Gt = (float*)(P.ws + WS_G);
    const int fr = lane & 15, fq = lane >> 4, kq = wave & 3, rh = wave >> 2;
    LAS float* PART = (LAS float*)lds;
    {
        const bf16_t* ap = xb + (size_t)(gu * 64 + rh * 32 + fr) * DM + kq * 1024 + fq * 8;
        const bf16_t* bp = wg + (size_t)fr * DM + kq * 1024 + fq * 8;
        f32x4 acc[2][6];
#pragma unroll
        for (int i = 0; i < 2; ++i)
#pragma unroll
            for (int c = 0; c < 6; ++c) acc[i][c] = (f32x4){0.f, 0.f, 0.f, 0.f};
#pragma unroll 4
        for (int ks = 0; ks < 32; ++ks) {
            const bf16x8 a0 = ld8(ap + ks * 32), a1 = ld8(ap + (size_t)16 * DM + ks * 32);
            bf16x8 bb[6];
#pragma unroll
            for (int c = 0; c < 6; ++c) bb[c] = ld8(bp + (size_t)c * 16 * DM + ks * 32);
#pragma unroll
            for (int c = 0; c < 6; ++c) { acc[0][c] = __builtin_amdgcn_mfma_f32_16x16x32_bf16(a0, bb[c], acc[0][c], 0, 0, 0); acc[1][c] = __builtin_amdgcn_mfma_f32_16x16x32_bf16(a1, bb[c], acc[1][c], 0, 0, 0); }
        }
#pragma unroll
        for (int i = 0; i < 2; ++i)
#pragma unroll
            for (int c = 0; c < 6; ++c)
#pragma unroll
                for (int r = 0; r < 4; ++r) PART[(kq * 64 + rh * 32 + i * 16 + fq * 4 + r) * 96 + c * 16 + fr] = acc[i][c][r];
    }
    LAS float* RSG = (LAS float*)(lds + 98304);
    if (tid < 64) RSG[tid] = 1.0f / sqrtf(row_sumsq(ss, np, gu * 64 + tid) * (1.0f / DM) + RMS_EPS);
    __syncthreads();
    for (int e = tid; e < 64 * 96; e += 512) { const int row = e / 96, col = e - row * 96;
        const float v = (PART[row * 96 + col] + PART[(64 + row) * 96 + col]) + (PART[(128 + row) * 96 + col] + PART[(192 + row) * 96 + col]);
        const float lg = v * RSG[row];
        Gt[(size_t)(gu * 64 + row) * NGATE + col] = fast_rcp(1.0f + fast_exp2(-lg * LOG2E)); }
    __syncthreads();
}

namespace att {
constexpr int SHM_K = 16384, SHM_V = 16384, NSLOT = 3;
constexpr int OFF_V = 0, OFF_K = NSLOT * SHM_V;
constexpr int OFF_IMP = NSLOT * (SHM_V + SHM_K);
constexpr int OFF_FIN = OFF_IMP + 8 * 32 * 33 * 4;
constexpr int OFF_SELM = OFF_FIN + 32 * 33 * 4;
constexpr int OFF_BT = OFF_SELM + 128;
constexpr int OFF_WS = OFF_BT + 8 * 132 * 4;
constexpr int OFF_DONE = OFF_WS + 8 * 64 * 4;
constexpr int ATT_LDS_END = OFF_DONE + 64;
static_assert(ATT_LDS_END <= MISC_OFF, "attention LDS map");

#define KSWZ(row, colB) ((row) * 256 + ((colB) ^ (((row) & 7) << 4)))
__device__ __forceinline__ int v_st(int k, int c) { const int kk = (k & ~0xC) | ((k & 4) << 1) | ((k & 8) >> 1); return ((kk >> 3) * 4 + (c >> 5)) * 512 + ((kk & 7) * 32 + (c & 31)) * 2; }
__device__ __forceinline__ int v_rd_base(int lane) { return ((lane & 3) << 3) | (((lane >> 2) & 3) << 6) | (((lane >> 4) & 1) << 5) | (((lane >> 5) & 1) << 8); }
constexpr int v_rd_off(int d0, int ks, int half) { return d0 * 512 + ks * 4096 + half * 2048; }
__device__ __forceinline__ int crow(int r, int hi) { return (r & 3) + 8 * (r >> 2) + 4 * hi; }

struct Geo { int tid, wid, lane, r32, hi, vb0; };
__device__ __forceinline__ Geo make_geo(LAS unsigned char* lds) {
    Geo g; g.tid = tid_now(); g.wid = __builtin_amdgcn_readfirstlane(g.tid >> 6); g.lane = g.tid & 63; g.r32 = g.lane & 31; g.hi = g.lane >> 5;
    g.vb0 = (int)(uintptr_t)(lds + OFF_V) + v_rd_base(g.lane);
    return g;
}
struct DmaOff { unsigned k[2], v[2]; };
__device__ __forceinline__ DmaOff make_dma(const Geo& g, int ld) {
    DmaOff d;
#pragma unroll
    for (int i = 0; i < 2; ++i) { const int ch = g.wid + 8 * i;
        const int krow = 4 * ch + (g.lane >> 4), kc = (g.lane & 15) ^ (krow & 7);
        d.k[i] = (unsigned)(krow * ld * 2 + kc * 16);
        const int sub = 2 * ch + (g.lane >> 5), kk = 8 * (sub >> 2) + ((g.lane & 31) >> 2), key = (kk & ~0xC) | ((kk & 4) << 1) | ((kk & 8) >> 1);
        d.v[i] = (unsigned)(key * ld * 2 + ((sub & 3) * 32 + (g.lane & 3) * 8) * 2); }
    return d;
}
__device__ __forceinline__ void dma_tile(LAS unsigned char* lds, int slot, const bf16_t* Kp, const bf16_t* Vp, size_t ld, int key0, DmaOff d, const Geo& g) {
    asm volatile("" : "+v"(d.k[0]), "+v"(d.k[1]), "+v"(d.v[0]), "+v"(d.v[1]));
    const char* kb = (const char*)Kp + (size_t)key0 * ld * 2; const char* vb = (const char*)Vp + (size_t)key0 * ld * 2;
#pragma unroll
    for (int i = 0; i < 2; ++i) {
        __builtin_amdgcn_global_load_lds((const unsigned*)(kb + d.k[i]), (LAS unsigned*)(lds + OFF_K + slot * SHM_K + (g.wid + 8 * i) * 1024), 16, 0, 0);
        __builtin_amdgcn_global_load_lds((const unsigned*)(vb + d.v[i]), (LAS unsigned*)(lds + OFF_V + slot * SHM_V + (g.wid + 8 * i) * 1024), 16, 0, 0); }
}
#define WAIT_VM(n) asm volatile("s_waitcnt vmcnt(" #n ")" ::: "memory")
#define RAW_BAR() do { asm volatile("s_waitcnt lgkmcnt(0)" ::: "memory"); __builtin_amdgcn_s_barrier(); asm volatile("" ::: "memory"); } while (0)
__device__ __forceinline__ void qkt(f32x16& p0, f32x16& p1, LAS unsigned char* lds, int buf, const Geo& g, const bf16x8* qr) {
    p0 = f32x16{}; p1 = f32x16{};
    LAS unsigned char* kb[4];
#pragma unroll
    for (int dd = 0; dd < 4; ++dd) kb[dd] = lds + OFF_K + buf * SHM_K + KSWZ(g.r32, (dd * 16 + g.hi * 8) * 2);
#pragma unroll
    for (int d0 = 0; d0 < 8; ++d0) { LAS unsigned char* a = kb[d0 & 3] + (d0 >> 2) * 128;
        const bf16x8 b0 = *(const LAS bf16x8*)a, b1 = *(const LAS bf16x8*)(a + 32 * 256);
        p0 = __builtin_amdgcn_mfma_f32_32x32x16_bf16(b0, qr[d0], p0, 0, 0, 0);
        p1 = __builtin_amdgcn_mfma_f32_32x32x16_bf16(b1, qr[d0], p1, 0, 0, 0); }
}
__device__ __forceinline__ void pv_tile(f32x16* o, int vb, bf16x8 pa0, bf16x8 pa1, bf16x8 pa2, bf16x8 pa3) {
#define TRRD(dst, off) asm volatile("ds_read_b64_tr_b16 %0, %1 offset:%2" : "=&v"(dst) : "v"(vb), "i"(off) : "memory")
#define PV_D0(d0) do { s16x4 l0, l1, l2, l3, h0, h1, h2, h3; constexpr int b_ = v_rd_off(d0, 0, 0); \
        TRRD(l0, b_); TRRD(h0, b_ + 2048); TRRD(l1, b_ + 4096); TRRD(h1, b_ + 6144); TRRD(l2, b_ + 8192); TRRD(h2, b_ + 10240); TRRD(l3, b_ + 12288); TRRD(h3, b_ + 14336); \
        asm volatile("s_waitcnt lgkmcnt(0)" ::: "memory"); SBAR(); \
        o[d0] = __builtin_amdgcn_mfma_f32_32x32x16_bf16(pa0, (bf16x8){l0[0], l0[1], l0[2], l0[3], h0[0], h0[1], h0[2], h0[3]}, o[d0], 0, 0, 0); \
        o[d0] = __builtin_amdgcn_mfma_f32_32x32x16_bf16(pa1, (bf16x8){l1[0], l1[1], l1[2], l1[3], h1[0], h1[1], h1[2], h1[3]}, o[d0], 0, 0, 0); \
        o[d0] = __builtin_amdgcn_mfma_f32_32x32x16_bf16(pa2, (bf16x8){l2[0], l2[1], l2[2], l2[3], h2[0], h2[1], h2[2], h2[3]}, o[d0], 0, 0, 0); \
        o[d0] = __builtin_amdgcn_mfma_f32_32x32x16_bf16(pa3, (bf16x8){l3[0], l3[1], l3[2], l3[3], h3[0], h3[1], h3[2], h3[3]}, o[d0], 0, 0, 0); } while (0)
    PV_D0(0); PV_D0(1); PV_D0(2); PV_D0(3);
#undef PV_D0
#undef TRRD
}
__device__ __forceinline__ void pack_p(const f32x16& p0, const f32x16& p1, bf16x8& pa0, bf16x8& pa1, bf16x8& pa2, bf16x8& pa3) {
#define PK4(P, B_, OUT) do { unsigned a0 = cvtpk(P[B_+0], P[B_+1]), a1 = cvtpk(P[B_+2], P[B_+3]); \
        unsigned b0 = cvtpk(P[B_+4], P[B_+5]), b1 = cvtpk(P[B_+6], P[B_+7]); \
        auto r0 = __builtin_amdgcn_permlane32_swap(a0, b0, false, false); auto r1 = __builtin_amdgcn_permlane32_swap(a1, b1, false, false); \
        u32x4 w = {r0[0], r1[0], r0[1], r1[1]}; OUT = *reinterpret_cast<bf16x8*>(&w); } while (0)
    PK4(p0, 0, pa0); PK4(p0, 8, pa1); PK4(p1, 0, pa2); PK4(p1, 8, pa3);
#undef PK4
}
__device__ __forceinline__ void pair_vals(float x, float& lo, float& hi) {
    auto rr = __builtin_amdgcn_permlane32_swap(__float_as_uint(x), __float_as_uint(x), false, false);
    lo = __uint_as_float(rr[0]); hi = __uint_as_float(rr[1]);
}
__device__ __forceinline__ float pair_max(float x) { float a, b; pair_vals(x, a, b); return fmaxf(a, b); }
__device__ __forceinline__ float pair_sum(float x) { float a, b; pair_vals(x, a, b); return a + b; }

constexpr float SM_THR = 8.0f;
__device__ __forceinline__ void rescale_o(f32x16* o, float alpha, LAS float* al_l, const Geo& g) {
    if (g.hi == 0) al_l[g.r32] = alpha;
    LDS_WAIT();
#pragma unroll
    for (int r = 0; r < 16; ++r) { const float a = al_l[crow(r, g.hi)];
#pragma unroll
        for (int d = 0; d < 4; ++d) o[d][r] *= a; }
}
__device__ __forceinline__ void softmax_step(f32x16& p0, f32x16& p1, float mulc, float badd, bool ok, float& m_reg, float& l_reg, f32x16* o, LAS float* al_l, const Geo& g) {
    const float NEG = -__builtin_inff();
    float xmax = fmaxf(p0[0], p1[0]);
#pragma unroll
    for (int r = 1; r < 16; ++r) xmax = fmaxf(xmax, fmaxf(p0[r], p1[r]));
    xmax = pair_max(xmax);
    const float smax = ok ? fmaf(xmax, mulc, badd) : NEG;
    float mn = m_reg, alpha = 1.0f;
    if (!__all(smax - m_reg <= SM_THR)) { mn = fmaxf(m_reg, smax); alpha = fast_exp2(m_reg - mn); m_reg = mn; rescale_o(o, alpha, al_l, g); }
    const float addc = ok ? (badd - mn) : NEG;
    float ps = 0.f;
#pragma unroll
    for (int r = 0; r < 16; ++r) { p0[r] = fast_exp2(fmaf(p0[r], mulc, addc)); ps += p0[r]; }
#pragma unroll
    for (int r = 0; r < 16; ++r) { p1[r] = fast_exp2(fmaf(p1[r], mulc, addc)); ps += p1[r]; }
    ps = pair_sum(ps);
    l_reg = l_reg * alpha + ps;
}

struct NsaT { const bf16_t* Q; const bf16_t* KV; const bf16_t* Z; const float* Gt; const bf16_t* KC; const bf16_t* VC; bf16_t* MIX; const float* rel_bias; };

constexpr int EMIT_ROWB = 144, EMIT_TILE = 32 * EMIT_ROWB;
static_assert(8 * EMIT_TILE <= OFF_SELM - OFF_IMP, "emit tiles fit the IMP + FIN region");
__device__ __forceinline__ void silu2_mul(unsigned ov, unsigned zv, float& lo, float& hi) {
    const float z0 = bf_lo(zv), z1 = bf_hi(zv);
    lo = bf_lo(ov) * z0 * fast_rcp(1.0f + fast_exp2(-z0 * LOG2E)); hi = bf_hi(ov) * z1 * fast_rcp(1.0f + fast_exp2(-z1 * LOG2E));
}
__device__ __forceinline__ float lane_xor1(float x) { return __int_as_float(__builtin_amdgcn_update_dpp(0, __float_as_int(x), 0xB1, 0xF, 0xF, true)); }
template <bool RMW, bool SCALE>
__device__ __forceinline__ void emit_tile(LAS unsigned char* lds, const f32x16* o, float f, const bf16_t* zb  , size_t zld,
                                          bf16_t* mb  , LAS float* li_l, const Geo& g) {
    const int row = g.lane >> 1, half = g.lane & 1;
    unsigned zoff = (unsigned)(row * (int)zld + half * 32), moff = (unsigned)(row * DM + half * 32);
    asm volatile("" : "+v"(zoff), "+v"(moff));
    u32x4 zv[2][4]; u32x4 old[2][4];
#pragma unroll
    for (int c = 0; c < 2; ++c)
#pragma unroll
        for (int q = 0; q < 4; ++q) zv[c][q] = *(const u32x4*)(zb + zoff + 64 * c + q * 8);
    if (RMW) {
#pragma unroll
        for (int c = 0; c < 2; ++c)
#pragma unroll
            for (int q = 0; q < 4; ++q) { const unsigned long long* ap = (const unsigned long long*)(mb + moff + 64 * c + q * 8);
                const unsigned long long a0 = __hip_atomic_load(ap, __ATOMIC_RELAXED, __HIP_MEMORY_SCOPE_AGENT), a1 = __hip_atomic_load(ap + 1, __ATOMIC_RELAXED, __HIP_MEMORY_SCOPE_AGENT);
                old[c][q] = (u32x4){(unsigned)a0, (unsigned)(a0 >> 32), (unsigned)a1, (unsigned)(a1 >> 32)}; }
    }
    float fr[16];
    if (SCALE) { if (g.hi == 0) li_l[g.r32] = f;
        LDS_WAIT();
#pragma unroll
        for (int r = 0; r < 16; ++r) fr[r] = li_l[(r & 3) + 8 * (r >> 2) + 4 * g.hi]; }
    LAS unsigned char* T = lds + OFF_IMP + g.wid * EMIT_TILE;
    const LAS unsigned char* trow = T + row * EMIT_ROWB + half * 64;
#pragma unroll
    for (int c = 0; c < 2; ++c) {
#pragma unroll
        for (int r = 0; r < 16; ++r) { const int rc = (r & 3) + 8 * (r >> 2);
#pragma unroll
            for (int dd = 0; dd < 2; ++dd) { const float v = SCALE ? o[2 * c + dd][r] * fr[r] : o[2 * c + dd][r]; const float vn = lane_xor1(v);
                if ((g.r32 & 1) == 0) *(LAS unsigned*)(T + (rc + 4 * g.hi) * EMIT_ROWB + (dd * 32 + g.r32) * 2) = cvtpk(v, vn); } }
        LDS_WAIT();
#pragma unroll
        for (int q = 0; q < 4; ++q) { const u32x4 ov = *(const LAS u32x4*)(trow + q * 16); u32x4 w;
#pragma unroll
            for (int e = 0; e < 4; ++e) { float lo, hi; silu2_mul(ov[e], zv[c][q][e], lo, hi);
                if (RMW) { lo += bf_lo(old[c][q][e]); hi += bf_hi(old[c][q][e]); }
                w[e] = cvtpk(lo, hi); }
            *(u32x4*)(mb + moff + 64 * c + q * 8) = w; }
        asm volatile("" ::: "memory");
    }
}

template <int MODE>
__device__ __forceinline__ void tile_softmax(f32x16& p0, f32x16& p1, int kb, int t0, bool selbit, const LAS float* btw, float& m_reg, float& l_reg, f32x16* o, LAS float* al_l, const Geo& g) {
    constexpr float C2 = SM_SCALE * LOG2E; const float NEG = -__builtin_inff();
    const bool near = (kb + 63 + 128 > t0);
    const bool wedge = (MODE == 2) && (t0 + 31 - kb >= 512);
    bool ok = (MODE == 1) ? selbit : true; float mulc = C2, badd = btw[128];
    if (near || wedge) {
        const int dq = t0 + g.r32 - kb - 4 * g.hi; const unsigned W = (MODE == 2) ? 512u : 0x7fffffffu;
#pragma unroll
        for (int r = 0; r < 16; ++r) { const int c = (r & 3) + 8 * (r >> 2);
            const unsigned d0 = (unsigned)(dq - c), d1 = (unsigned)(dq - c - 32);
            float b0 = btw[d0 < 128u ? d0 : 128u], b1 = btw[d1 < 128u ? d1 : 128u];
            asm volatile("" : "+v"(b0), "+v"(b1));
            p0[r] = (ok && d0 < W) ? fmaf(p0[r], C2, b0) : NEG; p1[r] = (ok && d1 < W) ? fmaf(p1[r], C2, b1) : NEG;
            if ((r & 3) == 3) asm volatile("" ::: "memory"); }
        mulc = 1.0f; badd = 0.f; ok = true;
    }
    softmax_step(p0, p1, mulc, badd, ok, m_reg, l_reg, o, al_l, g);
}

struct TileIter { unsigned rem; int nxt, j_hi, j, j1, j2; };
template <int MODE> __device__ __forceinline__ void ti_next(TileIter& it, int& dst) {
    if (MODE == 1) { dst = it.rem ? __builtin_ctz(it.rem) : -1; it.rem &= it.rem - 1u; } else { dst = (it.nxt <= it.j_hi) ? it.nxt : -1; ++it.nxt; } }
template <int MODE> __device__ __forceinline__ TileIter ti_init(unsigned umask, int j_lo, int j_hi) {
    TileIter it; it.rem = umask; it.nxt = j_lo; it.j_hi = j_hi; ti_next<MODE>(it, it.j); ti_next<MODE>(it, it.j1); ti_next<MODE>(it, it.j2); return it; }
__device__ __forceinline__ void branch_issue(LAS unsigned char* lds, const TileIter& it, const bf16_t* Kp, const bf16_t* Vp, size_t ld, const DmaOff& dof, const Geo& g) {
    dma_tile(lds, 0, Kp, Vp, ld, 64 * it.j, dof, g);
    if (it.j1 >= 0) dma_tile(lds, 1, Kp, Vp, ld, 64 * it.j1, dof, g);
}
template <int MODE>
__device__ __forceinline__ void branch_run(f32x16* o, float& l_out, LAS unsigned char* lds, TileIter it, const bf16_t* Kp, const bf16_t* Vp, size_t ld, const DmaOff& dof, const bf16x8* qr,
                                           unsigned selword, int t0, const LAS float* btw, LAS float* al_l, const Geo& g) {
    float m_reg = -1e30f, l_reg = 0.f;
#pragma unroll
    for (int d = 0; d < 4; ++d) o[d] = f32x16{};
    int slot = 0; bool first = true;
    for (;;) {
        if (first || it.j1 < 0) WAIT_VM(0); else WAIT_VM(4);
        first = false;
        RAW_BAR();
        if (it.j2 >= 0) dma_tile(lds, slot >= 1 ? slot - 1 : 2, Kp, Vp, ld, 64 * it.j2, dof, g);
        f32x16 p0, p1;
        qkt(p0, p1, lds, slot, g, qr);
        tile_softmax<MODE>(p0, p1, 64 * it.j, t0, ((selword >> it.j) & 1u) != 0u, btw, m_reg, l_reg, o, al_l, g);
        bf16x8 pa0, pa1, pa2, pa3; pack_p(p0, p1, pa0, pa1, pa2, pa3);
        pv_tile(o, g.vb0 + slot * SHM_V, pa0, pa1, pa2, pa3);
        if (it.j1 < 0) break;
        it.j = it.j1; it.j1 = it.j2; ti_next<MODE>(it, it.j2); slot = slot == 2 ? 0 : slot + 1;
    }
    RAW_BAR();
    l_out = l_reg;
}

__device__ __forceinline__ int t5_bucket(int d) {
    if (d < 16) return d;
    const float lr = logf((float)d / 16.0f);
    int large = 16 + (int)(lr / 2.0794415416798357f * 16.0f);
    return large < 31 ? large : 31;
}


struct NsaUnit { int b, grp, t0; };
__device__ __forceinline__ NsaUnit nsa_decode(int u) {
    const int p = u >> 1, s2 = u & 1, k = p >> 8, w = p & 255, bg = (w & 7) + 8 * k, i = ((w >> 3) + 8 * k) & 31;
    NsaUnit r; r.b = bg >> 2; r.grp = bg & 3; r.t0 = s2 ? 32 * i : 32 * (63 - i); return r; }
__device__ __forceinline__ void nsa_issue_cmp(LAS unsigned char* lds, const NsaT& A, const NsaUnit& U, const Geo& g) {
    const bf16_t* Kc = A.KC + (size_t)(U.b * NGRP + U.grp) * 128 * 128; const bf16_t* Vc = A.VC + (size_t)(U.b * NGRP + U.grp) * 128 * 128;
    const DmaOff dc = make_dma(g, 128);
    dma_tile(lds, 0, Kc, Vc, 128, 0, dc, g); dma_tile(lds, 1, Kc, Vc, 128, 64, dc, g);
}
__device__ __forceinline__ void nsa_unit(LAS unsigned char* lds, const NsaT& A, const NsaUnit U, bool build_bt) {
    const Geo g = make_geo(lds);
    __syncthreads();
    nsa_issue_cmp(lds, A, U, g);
    const int b = U.b, grp = U.grp, t0 = U.t0, h = grp * 8 + g.wid;
    LAS float* IMP = (LAS float*)(lds + OFF_IMP); LAS float* FIN = (LAS float*)(lds + OFF_FIN); LAS unsigned* SELM = (LAS unsigned*)(lds + OFF_SELM);
    LAS float* BT = (LAS float*)(lds + OFF_BT); LAS float* wsl = (LAS float*)(lds + OFF_WS) + g.wid * 64;
    const LAS float* btw = BT + g.wid * 132;
    float gates[3];
    { const float* gp = A.Gt + (size_t)(b * SEQ + t0) * NGATE + h + (unsigned)(g.r32 * NGATE);
#pragma unroll
      for (int br = 0; br < 3; ++br) gates[br] = gp[br * 32]; }
    bf16x8 qr[8];
    { const bf16_t* qp = A.Q + (size_t)(b * SEQ + t0) * DM + h * 128 + (unsigned)(g.r32 * DM + g.hi * 8);
#pragma unroll
      for (int d0 = 0; d0 < 8; ++d0) qr[d0] = *(const bf16x8*)(qp + d0 * 16); }
    if (build_bt) for (int e = g.tid; e < 8 * 129; e += 512) { const int r = e / 129, d = e - r * 129; BT[r * 132 + d] = A.rel_bias[t5_bucket(d) * NH + grp * 8 + r] * LOG2E; }
    const bf16_t* Ks = A.KV + (size_t)(b * SEQ) * KVW + 1024 + grp * 128; const bf16_t* Vs = Ks + 512;
    const bf16_t* Kw = Ks + 1024; const bf16_t* Vw = Kw + 512;
    const DmaOff dof = make_dma(g, KVW);
    f32x16 o[4]; float l_reg;
    unsigned selword, um;
    WAIT_VM(0);
    __syncthreads();
    {
        f32x16 pA0, pA1, pB0, pB1;
        qkt(pA0, pA1, lds, 0, g, qr); qkt(pB0, pB1, lds, 1, g, qr);
        constexpr float C2 = SM_SCALE * LOG2E; const float NEG = -__builtin_inff();
        const int dbase = t0 + g.r32 - 31 - 64 * g.hi;
        float pmax = NEG;
#pragma unroll
        for (int r = 0; r < 16; ++r) { const int c = (r & 3) + 8 * (r >> 2);
#define CSC(P, NL) do { const int dist = dbase - 16 * (NL); const unsigned ud = (unsigned)dist; const float bb = btw[ud < 128u ? ud : 128u]; \
            P[r] = dist >= 0 ? fmaf(P[r], C2, bb) : NEG; pmax = fmaxf(pmax, P[r]); } while (0)
            CSC(pA0, c); CSC(pA1, c + 32); CSC(pB0, c + 64); CSC(pB1, c + 96);
#undef CSC
        }
        pmax = pair_max(pmax);
        const float mref = (pmax == NEG) ? 0.f : pmax;
        float ps = 0.f;
#pragma unroll
        for (int r = 0; r < 16; ++r) { pA0[r] = fast_exp2(pA0[r] - mref); pA1[r] = fast_exp2(pA1[r] - mref); pB0[r] = fast_exp2(pB0[r] - mref); pB1[r] = fast_exp2(pB1[r] - mref);
            ps += (pA0[r] + pA1[r]) + (pB0[r] + pB1[r]); }
        ps = pair_sum(ps);
        l_reg = ps;
        const float inv = ps > 0.f ? 1.0f / ps : 0.f;
        float qs[16], e3[16];
#pragma unroll
        for (int i = 0; i < 4; ++i) {
            qs[0 + i] = ((pA0[4 * i] + pA0[4 * i + 1]) + (pA0[4 * i + 2] + pA0[4 * i + 3])) * inv; e3[0 + i] = pA0[4 * i + 3] * inv;
            qs[4 + i] = ((pA1[4 * i] + pA1[4 * i + 1]) + (pA1[4 * i + 2] + pA1[4 * i + 3])) * inv; e3[4 + i] = pA1[4 * i + 3] * inv;
            qs[8 + i] = ((pB0[4 * i] + pB0[4 * i + 1]) + (pB0[4 * i + 2] + pB0[4 * i + 3])) * inv; e3[8 + i] = pB0[4 * i + 3] * inv;
            qs[12 + i] = ((pB1[4 * i] + pB1[4 * i + 1]) + (pB1[4 * i + 2] + pB1[4 * i + 3])) * inv; e3[12 + i] = pB1[4 * i + 3] * inv;
        }
        { LAS float* ip = IMP + (g.wid * 32 + g.r32) * 33;
          float prev_hi1 = 0.f;
#pragma unroll
          for (int idx = 0; idx < 16; ++idx) { float lo, hi1; pair_vals(e3[idx], lo, hi1);
              const float add = g.hi ? lo : prev_hi1;
              ip[2 * idx + g.hi] = qs[idx] + add; prev_hi1 = hi1; } }
        bf16x8 a0, a1, a2, a3, c0, c1, c2, c3;
        pack_p(pA0, pA1, a0, a1, a2, a3); pack_p(pB0, pB1, c0, c1, c2, c3);
#pragma unroll
        for (int d = 0; d < 4; ++d) o[d] = f32x16{};
        pv_tile(o, g.vb0, a0, a1, a2, a3); pv_tile(o, g.vb0 + SHM_V, c0, c1, c2, c3);
    }
    LDS_WAIT();
    __syncthreads();
    dma_tile(lds, 0, Ks, Vs, KVW, 0, dof, g);
    {
        const int tl = g.tid >> 4, j0 = (g.tid & 15) * 2, tok = t0 + tl, cur = tok >> 6;
        float v2[2];
#pragma unroll
        for (int e = 0; e < 2; ++e) { const int j = j0 + e; float v = 0.f;
#pragma unroll
            for (int r = 0; r < 8; ++r) v += IMP[(r * 32 + tl) * 33 + j];
            const bool forced = (j == 0) || (j == cur) || (j == cur - 1), valid = (64 * j <= tok);
            v = forced ? 1.0e6f : (valid ? v : -1.0f); v2[e] = v; FIN[tl * 33 + j] = v; }
        LDS_WAIT();
        __syncthreads();
        unsigned bits = 0u;
#pragma unroll
        for (int e = 0; e < 2; ++e) { const int j = j0 + e; int cnt = 0;
#pragma unroll
            for (int i = 0; i < 32; ++i) { const float w = FIN[tl * 33 + i]; cnt += (w > v2[e] || (w == v2[e] && i < j)) ? 1 : 0; }
            if (cnt < 16) bits |= 1u << j; }
        bits |= (unsigned)__builtin_amdgcn_update_dpp(0, (int)bits, 0xB1, 0xF, 0xF, true);
        bits |= (unsigned)__builtin_amdgcn_update_dpp(0, (int)bits, 0x4E, 0xF, 0xF, true);
        bits |= (unsigned)__builtin_amdgcn_update_dpp(0, (int)bits, 0x141, 0xF, 0xF, true);
        bits |= (unsigned)__builtin_amdgcn_update_dpp(0, (int)bits, 0x140, 0xF, 0xF, true);
        if ((g.tid & 15) == 0) SELM[tl] = bits;
        LDS_WAIT();
        __syncthreads();
        selword = SELM[g.r32]; um = selword;
        um |= __shfl_xor(um, 1); um |= __shfl_xor(um, 2); um |= __shfl_xor(um, 4); um |= __shfl_xor(um, 8); um |= __shfl_xor(um, 16);
        const int jmax = (t0 + 31) >> 6;
        um = __builtin_amdgcn_readfirstlane(um) & (jmax >= 31 ? 0xffffffffu : ((2u << jmax) - 1u));
    }
    TileIter its = ti_init<1>(um, 0, 0);
    if (its.j1 >= 0) dma_tile(lds, 1, Ks, Vs, KVW, 64 * its.j1, dof, g);
    const bf16_t* zb = A.Z + (size_t)(b * SEQ + t0) * ZW + h * 128;
    bf16_t* mb = A.MIX + (size_t)(b * SEQ + t0) * DM + h * 128;
    emit_tile<false, true>(lds, o, (l_reg > 0.f ? 1.0f / l_reg : 0.f) * gates[0], zb, ZW, mb, wsl, g);
    branch_run<1>(o, l_reg, lds, its, Ks, Vs, KVW, dof, qr, selword, t0, btw, wsl + 32, g);
    const int lowk = t0 - 511;
    TileIter itw = ti_init<2>(0u, lowk > 0 ? lowk >> 6 : 0, (t0 + 31) >> 6);
    branch_issue(lds, itw, Kw, Vw, KVW, dof, g);
    emit_tile<true, true>(lds, o, (1.0f / l_reg) * gates[1], zb + 4096, ZW, mb, wsl, g);
    branch_run<2>(o, l_reg, lds, itw, Kw, Vw, KVW, dof, qr, 0u, t0, btw, wsl + 32, g);
    emit_tile<true, true>(lds, o, (1.0f / l_reg) * gates[2], zb + 8192, ZW, mb, wsl, g);
}
__device__ __forceinline__ void nsa_phase(LAS unsigned char* lds, const NsaT& A) {
    const int G = gridDim.x, first = 2 * (int)blockIdx.x;
    if (first >= 2048) return;
    int prev_grp = -1;
#pragma unroll 1
    for (int u = first; u < 2048; u = (u & 1) ? u + 2 * G - 1 : u + 1) {
        const NsaUnit U = nsa_decode(u);
        nsa_unit(lds, A, U, U.grp != prev_grp);
        prev_grp = U.grp;
    }
    VM_WAIT();
    __syncthreads();
}

constexpr bool SB_EARLY_EXIT = true;
constexpr float SB_PCUT = 1.0e-37f;
struct SbT { const bf16_t* QZ; const bf16_t* KVSH; bf16_t* MIX; };
struct SbUnit { int b, h, qb; };
__device__ __forceinline__ SbUnit sb_decode(int u) {
    const int p = u >> 1, s2 = u & 1, k = p >> 8, w = p & 255, bh = k * 64 + (w & 7) * 8 + (w >> 5), pi = ((w >> 3) + k) & 3;
    SbUnit r; r.b = bh >> 5; r.h = bh & 31; r.qb = s2 ? pi : 7 - pi; return r; }
__device__ __forceinline__ void sb_issue(LAS unsigned char* lds, const SbT& A, const SbUnit& U, const Geo& g) {
    const bf16_t* Kp = A.KVSH + (size_t)(U.b * SEQ) * 8192 + U.h * 128; const bf16_t* Vp = Kp + 4096;
    const DmaOff dof = make_dma(g, 8192); const int j = 4 * U.qb + 3;
    dma_tile(lds, 0, Kp, Vp, 8192, 64 * j, dof, g); dma_tile(lds, 1, Kp, Vp, 8192, 64 * (j - 1), dof, g);
}
__device__ __forceinline__ void sb_unit(LAS unsigned char* lds, const SbT& A, const SbUnit U, bool has_next, const SbUnit UN) {
    const Geo g = make_geo(lds);
    const int b = U.b, h = U.h, qb = U.qb;
    LAS unsigned* DONE = (LAS unsigned*)(lds + OFF_DONE);
    const int tw0 = qb * 256 + g.wid * 32, t = tw0 + g.r32;
    bf16x8 qr[8];
    { const bf16_t* qp = A.QZ + (size_t)(b * SEQ + tw0) * 8192 + h * 128 + (unsigned)(g.r32 * 8192 + g.hi * 8);
#pragma unroll
      for (int d0 = 0; d0 < 8; ++d0) qr[d0] = *(const bf16x8*)(qp + d0 * 16); }
    const bf16_t* Kp = A.KVSH + (size_t)(b * SEQ) * 8192 + h * 128; const bf16_t* Vp = Kp + 4096;
    f32x16 o[4];
#pragma unroll
    for (int d = 0; d < 4; ++d) o[d] = f32x16{};
    float PR = 1.0f; bool wdone = false;
    const DmaOff dof = make_dma(g, 8192);
    int j = 4 * qb + 3, bank = 0, slot = 0;
    for (int step = 0;; ++step) {
        if (step > 0 && j >= 1) WAIT_VM(4); else WAIT_VM(0);
        RAW_BAR();
        if (SB_EARLY_EXIT && step > 0) { unsigned all = 1u;
#pragma unroll
            for (int w = 0; w < 8; ++w) all &= DONE[bank * 8 + w];
            bank ^= 1;
            if (__builtin_amdgcn_readfirstlane(all)) break; }
        if (j >= 2) dma_tile(lds, slot >= 1 ? slot - 1 : 2, Kp, Vp, 8192, 64 * (j - 2), dof, g);
        const int kb = 64 * j;
        const bool active = (kb <= tw0 + 30) && !wdone;
        if (active) {
            f32x16 p0, p1;
            qkt(p0, p1, lds, slot, g, qr);
            const bool needmask = (kb + 63 >= tw0);
            const int dq = t - kb - 4 * g.hi;
            constexpr float ZS = SM_SCALE * LOG2E;
            float rr0[16], rr1[16];
#pragma unroll
            for (int r = 0; r < 16; ++r) { const int c = (r & 3) + 8 * (r >> 2);
                float e0 = fast_exp2(fminf(p0[r] * ZS, 64.0f)), e1 = fast_exp2(fminf(p1[r] * ZS, 64.0f));
                if (needmask) { e0 = (dq - c > 0) ? e0 : 0.f; e1 = (dq - c - 32 > 0) ? e1 : 0.f; }
                p0[r] = e0; p1[r] = e1; rr0[r] = fast_rcp(1.0f + e0); rr1[r] = fast_rcp(1.0f + e1); }
            float tot[8];
#pragma unroll
            for (int i = 0; i < 4; ++i) {
                rr0[4 * i + 2] *= rr0[4 * i + 3]; rr0[4 * i + 1] *= rr0[4 * i + 2]; rr0[4 * i] *= rr0[4 * i + 1]; tot[i] = rr0[4 * i];
                rr1[4 * i + 2] *= rr1[4 * i + 3]; rr1[4 * i + 1] *= rr1[4 * i + 2]; rr1[4 * i] *= rr1[4 * i + 1]; tot[4 + i] = rr1[4 * i];
            }
            float off[8]; float suf = PR;
#pragma unroll
            for (int idx = 7; idx >= 0; --idx) { float t0_, t1_; pair_vals(tot[idx], t0_, t1_);
                const float oh1 = suf; suf *= t1_; const float oh0 = suf; suf *= t0_; off[idx] = g.hi ? oh1 : oh0; }
            PR = suf;
#pragma unroll
            for (int r = 0; r < 16; ++r) { p0[r] *= rr0[r] * off[r >> 2]; p1[r] *= rr1[r] * off[4 + (r >> 2)]; }
            bf16x8 pa0, pa1, pa2, pa3; pack_p(p0, p1, pa0, pa1, pa2, pa3);
            pv_tile(o, g.vb0 + slot * SHM_V, pa0, pa1, pa2, pa3);
            if (SB_EARLY_EXIT) wdone = __all(PR < SB_PCUT);
        }
        if (SB_EARLY_EXIT && g.lane == 0) DONE[bank * 8 + g.wid] = wdone ? 1u : 0u;
        if (j == 0) break;
        --j; slot = slot == 2 ? 0 : slot + 1;
    }
    WAIT_VM(0);
    RAW_BAR();
    if (has_next) sb_issue(lds, A, UN, g);
    emit_tile<false, false>(lds, o, 1.0f, A.QZ + (size_t)(b * SEQ + tw0) * 8192 + 4096 + h * 128, 8192, A.MIX + (size_t)(b * SEQ + tw0) * DM + h * 128, (LAS float*)(lds + OFF_WS), g);
}
__device__ __forceinline__ void sb_phase(LAS unsigned char* lds, const SbT& A) {
    const int G = gridDim.x, first = 2 * (int)blockIdx.x;
    if (first >= 2048) return;
    { const Geo g = make_geo(lds); sb_issue(lds, A, sb_decode(first), g); }
#pragma unroll 1
    for (int u = first; u < 2048; u = (u & 1) ? u + 2 * G - 1 : u + 1) {
        const int un = (u & 1) ? u + 2 * G - 1 : u + 1; const bool has_next = un < 2048;
        sb_unit(lds, A, sb_decode(u), has_next, sb_decode(has_next ? un : u));
    }
    VM_WAIT();
    __syncthreads();
}
}

constexpr int NPHASES = 16;
__global__ void __launch_bounds__(512, 2) yoco_fwd(Params P) {
    extern __shared__ __attribute__((aligned(16))) unsigned char lds_raw[];
    LAS unsigned char* lds = (LAS unsigned char*)lds_raw;
    const int G = gridDim.x;
    volatile LAS unsigned* MISC = (volatile LAS unsigned*)(lds + MISC_OFF);
    { const int t0_ = tid_now(); if (t0_ < 64) MISC[t0_] = 0u; }
    __syncthreads();
    unsigned char* ws = P.ws;
    XcdBarrier bar = xcd_barrier_post((unsigned*)(ws + WS_CTL), MISC + 8);
    const int lo = P.ph_lo, hi = P.ph_hi;
#define IN(k) (lo <= (k) && (k) < hi)
#define SEAM(k) do { if (IN(k) && IN((k) + 1)) xcd_barrier(bar); } while (0)
    bf16_t* HN = (bf16_t*)(ws + WS_HN); bf16_t* XB = (bf16_t*)(ws + WS_XB); float* SS = (float*)(ws + WS_SS); float* SSP = (float*)(ws + WS_SSP);

    if (IN(0)) phase_prologue(P, lds);
    SEAM(0);

#pragma unroll
    for (int l = 0; l < 2; ++l) {
        const int pb = 1 + 4 * l;
        if (IN(pb)) {
            pg8::Gemm g{XB, (const bf16_t*)(ws + WS_WAIN + l * WAIN_BYTES), MTOK, NSA_N, DM}; pg8::StaticOrder S; S.init(MTOK, NSA_N, G, (int)blockIdx.x);
            const int fm = 8 * ((int)blockIdx.x & 7); LAS float* RS = (LAS float*)(lds + 131072);
            const float* ssrc = l == 0 ? SS : SSP; const int np = l == 0 ? 1 : SS_NP;
            { const int i4 = tid_now() * 4; f32x4 s4 = {0.f, 0.f, 0.f, 0.f};
#pragma unroll 8
              for (int p = 0; p < np; ++p) s4 += *(const f32x4*)(ssrc + (size_t)p * MTOK + fm * 256 + i4);
#pragma unroll
              for (int k = 0; k < 4; ++k) RS[i4 + k] = 1.0f / sqrtf(s4[k] * (1.0f / DM) + RMS_EPS); }
            __syncthreads();
            pg8::EpiSplit E{(bf16_t*)(ws + WS_Q), DM, 16, (bf16_t*)(ws + WS_KV), KVW, 28, (bf16_t*)(ws + WS_Z), ZW, ssrc, RS, fm, np};
            pg8::gemm_phase<pg8::EpiSplit, pg8::StaticOrder, true, true>(lds, g, S, E);
        }
        SEAM(pb);
        if (IN(pb + 1)) {
            for (int u = blockIdx.x; u < 256; u += G) { compress_unit(P, l, u, lds); gate_unit(P, l, u, lds); }
        }
        SEAM(pb + 1);
        if (IN(pb + 2)) {
            att::NsaT A{(const bf16_t*)(ws + WS_Q), (const bf16_t*)(ws + WS_KV), (const bf16_t*)(ws + WS_Z), (const float*)(ws + WS_G),
                        (const bf16_t*)(ws + WS_KC), (const bf16_t*)(ws + WS_VC), HN, P.in[1]};
            att::nsa_phase(lds, A);
        }
        SEAM(pb + 2);
        if (IN(pb + 3)) {
            pg8::Gemm g{HN, (const bf16_t*)(ws + WS_WAOUT + l * WOUT_BYTES), MTOK, DM, DM}; pg8::StaticOrder S; S.init(MTOK, DM, G, (int)blockIdx.x);
            pg8::EpiRes E{XB, P.out, DM, SSP, 0};
            pg8::gemm_phase<pg8::EpiRes, pg8::StaticOrder, true, true>(lds, g, S, E);
        }
        SEAM(pb + 3);
    }

#pragma unroll
    for (int l = 2; l < 4; ++l) {
        const int pb = 9 + 3 * (l - 2);
        if (IN(pb)) {
            const int N = (l == 2) ? 16384 : 8192;
            pg8::Gemm g{XB, (const bf16_t*)(ws + (l == 2 ? WS_WKVQ : WS_WB3)), MTOK, N, DM}; pg8::StaticOrder S; S.init(MTOK, N, G, (int)blockIdx.x);
            const int fm = 8 * ((int)blockIdx.x & 7); LAS float* RS = (LAS float*)(lds + 131072);
            const float* ssrc = SSP; const int np = SS_NP;
            { const int i4 = tid_now() * 4; f32x4 s4 = {0.f, 0.f, 0.f, 0.f};
#pragma unroll 8
              for (int p = 0; p < np; ++p) s4 += *(const f32x4*)(ssrc + (size_t)p * MTOK + fm * 256 + i4);
#pragma unroll
              for (int k = 0; k < 4; ++k) RS[i4 + k] = 1.0f / sqrtf(s4[k] * (1.0f / DM) + RMS_EPS); }
            __syncthreads();
            pg8::EpiSplit E{(bf16_t*)(ws + (l == 2 ? WS_KVSH : WS_QZ)), 8192, 32, (bf16_t*)(ws + WS_QZ), 8192, 1 << 20, nullptr, 0, ssrc, RS, fm, np};
            pg8::gemm_phase<pg8::EpiSplit, pg8::StaticOrder, true, true>(lds, g, S, E);
        }
        SEAM(pb);
        if (IN(pb + 1)) {
            att::SbT A{(const bf16_t*)(ws + WS_QZ), (const bf16_t*)(ws + WS_KVSH), HN};
            att::sb_phase(lds, A);
        }
        SEAM(pb + 1);
        if (IN(pb + 2)) {
            pg8::Gemm g{HN, (const bf16_t*)(ws + WS_WBOUT + (l - 2) * WOUT_BYTES), MTOK, DM, DM}; pg8::StaticOrder S; S.init(MTOK, DM, G, (int)blockIdx.x);
            pg8::EpiRes E{XB, P.out, DM, SSP, 0};
            pg8::gemm_phase<pg8::EpiRes, pg8::StaticOrder, true, true>(lds, g, S, E);
        }
        SEAM(pb + 2);
    }
    if (IN(15)) phase_final_norm(XB, P.out, P.in[26], SSP, lds);
#undef IN
#undef SEAM
}

extern "C" void kernel_launch(void* const* d_in, const int* in_sizes, int n_in, void* d_out, int out_size, void* d_ws, size_t ws_size, hipStream_t stream) {
    static int grid = 0;
    if (grid == 0) {
        if (n_in != 27 || out_size != MTOK * DM || ws_size < WS_END) { fprintf(stderr, "kernel_launch: unexpected shapes (n_in %d, out %d, ws %zu < %zu)\n", n_in, out_size, ws_size, (size_t)WS_END); grid = -1; return; }
        int dev = 0, cus = 0, per_cu = 0;
        if (hipGetDevice(&dev) != hipSuccess || hipDeviceGetAttribute(&cus, hipDeviceAttributeMultiprocessorCount, dev) != hipSuccess || cus <= 0) { grid = -1; return; }
        if (hipFuncSetAttribute((const void*)yoco_fwd, hipFuncAttributeMaxDynamicSharedMemorySize, LDS_BYTES) != hipSuccess) { fprintf(stderr, "kernel_launch: hipFuncSetAttribute failed\n"); grid = -1; return; }
        if (hipOccupancyMaxActiveBlocksPerMultiprocessor(&per_cu, (const void*)yoco_fwd, 512, LDS_BYTES) != hipSuccess || per_cu < 1) { fprintf(stderr, "kernel_launch: occupancy query says %d\n", per_cu); }
        (void)hipGetLastError();
        grid = cus;
    }
    if (grid < 0) return;
    (void)hipMemsetAsync((char*)d_ws + WS_CTL, 0, CTL_ZERO_BYTES, stream);
    Params p{};
    for (int i = 0; i < 27; ++i) p.in[i] = (const float*)d_in[i];
    p.out = (float*)d_out; p.ws = (unsigned char*)d_ws;
    p.ph_lo = 0; p.ph_hi = NPHASES;
    hipLaunchKernelGGL(yoco_fwd, dim3(grid), dim3(512), LDS_BYTES, stream, p);
}
```

```cpp
#include <hip/hip_runtime.h>
#include <cstdio>
#include <cstdint>

#define LAS __attribute__((address_space(3)))
#define GAS __attribute__((address_space(1)))
typedef unsigned short bf16_t;
typedef short bf16x8 __attribute__((ext_vector_type(8)));
typedef short s16x4 __attribute__((ext_vector_type(4)));
typedef float f32x4 __attribute__((ext_vector_type(4)));
typedef float f32x16 __attribute__((ext_vector_type(16)));
typedef unsigned u32x4 __attribute__((ext_vector_type(4)));
typedef unsigned u32x2 __attribute__((ext_vector_type(2)));

constexpr int BATCH = 8, SEQ = 2048, DM = 4096, NH = 32, HD = 128, NGRP = 4, GSZ = 8;
constexpr int MTOK = BATCH * SEQ;
constexpr int NSA_N = 19456;
constexpr int KVW = 3072, ZW = 12288, NGATE = 96;
constexpr int NCMP = 127;
constexpr float RMS_EPS = 1e-6f;
constexpr float SM_SCALE = 0.08838834764831845f;
constexpr float LOG2E = 1.4426950408889634f;
constexpr float LN2 = 0.6931471805599453f;

constexpr size_t MiB = 1u << 20;
constexpr size_t WS_CTL = 0, CTL_ZERO_BYTES = 512 * 1024;
constexpr size_t WS_SS = 64 * 1024;
constexpr size_t WS_C1 = 1 * MiB;
constexpr size_t WS_KC = 2 * MiB;
constexpr size_t WS_VC = 3 * MiB;
constexpr size_t WS_W2T = 4 * MiB;
constexpr size_t WS_W1T = 8 * MiB;
constexpr size_t WS_SSP = 12 * MiB;
constexpr int SS_NP = 64;
constexpr size_t WS_WG = 16 * MiB;
constexpr size_t WS_WAIN = 20 * MiB;
constexpr size_t WAIN_BYTES = (size_t)NSA_N * DM * 2;
constexpr size_t WS_WAOUT = WS_WAIN + 2 * WAIN_BYTES;
constexpr size_t WOUT_BYTES = (size_t)DM * DM * 2;
constexpr size_t WS_WKVQ = WS_WAOUT + 2 * WOUT_BYTES;
constexpr size_t WS_WB3 = WS_WKVQ + (size_t)16384 * DM * 2;
constexpr size_t WS_WBOUT = WS_WB3 + (size_t)8192 * DM * 2;
constexpr size_t WS_HN = WS_WBOUT + 2 * WOUT_BYTES;
constexpr size_t WS_PROJ = WS_HN + (size_t)MTOK * DM * 2;
constexpr size_t WS_Q = WS_PROJ;
constexpr size_t WS_KV = WS_Q + (size_t)MTOK * DM * 2;
constexpr size_t WS_Z = WS_KV + (size_t)MTOK * KVW * 2;
constexpr size_t WS_G = WS_Z + (size_t)MTOK * ZW * 2;
constexpr size_t WS_KVSH = WS_PROJ;
constexpr size_t WS_QZ = WS_KVSH + (size_t)MTOK * 8192 * 2;
constexpr size_t WS_XB = WS_G + (size_t)MTOK * NGATE * 4;
constexpr size_t WS_END = WS_XB + (size_t)MTOK * DM * 2;
static_assert(WS_END <= (size_t)1515 * MiB, "d_ws map must fit the guaranteed workspace (sum of inputs = 1515 MiB)");
static_assert(WS_QZ + (size_t)MTOK * 8192 * 2 <= WS_XB, "SB overlay");
static_assert(WS_SS + 5 * 16384 * 4 <= CTL_ZERO_BYTES, "SS inside the memset region");

constexpr int LDS_BYTES = 151552;
constexpr int MISC_OFF = LDS_BYTES - 256;

__device__ __forceinline__ float row_sumsq(const float* ss, int np, int row) {
    float s = 0.f;
#pragma unroll 8
    for (int p = 0; p < np; ++p) s += ss[(size_t)p * MTOK + row];
    return s;
}
namespace pg8 {
#define PG8_LAS __attribute__((address_space(3)))
typedef unsigned short bf16_t;
typedef short bf16x8 __attribute__((ext_vector_type(8)));
typedef float f32x4 __attribute__((ext_vector_type(4)));
typedef unsigned u32x4 __attribute__((ext_vector_type(4)));
constexpr int BM = 256, BK = 64, HALF = 128, HTB = HALF * BK * 2  , STAGE_BYTES = 8 * HTB, NXCD = 8, WGM = 8;

__host__ __device__ __forceinline__ int lds_byte(int r, int c) { const int st = (r >> 4) * 2 + (c >> 5), rr = r & 15, cc = c & 31, ob = rr * 64 + cc * 2; return st * 1024 + (ob ^ (((ob >> 9) & 1) << 5)); }
__host__ __device__ __forceinline__ void stage_rc(int b, int& R, int& C) { const int st = b / 1024, sb = b % 1024, swz = sb ^ (((sb >> 9) & 1) << 5); R = (st >> 1) * 16 + swz / 64; C = (st & 1) * 32 + (swz % 64) / 2; }
__host__ __device__ __forceinline__ int perm32(int rho) { const int n = rho >> 4, i = rho & 15; return 8 * (i >> 2) + 4 * n + (i & 3); }

struct Unit { int pm, pn; };
struct Gemm { const bf16_t* A; const bf16_t* Bt; int M, N, K; };

struct StaticOrder {
    int nM, nN, nwg, G, c;
    __host__ __device__ void init(int M, int N, int G_, int c_) { nM = M / BM; nN = N / BM; nwg = nM * nN; G = G_; c = c_; }
    __host__ __device__ bool next(int i, Unit& u) const {
        const long L = (long)i * G + c; if (L >= nwg) return false;
        int wgid = (int)L; { const int q = nwg / NXCD, r = nwg % NXCD, xcd = wgid % NXCD, off = wgid / NXCD; wgid = (xcd < r ? xcd * (q + 1) : r * (q + 1) + (xcd - r) * q) + off; }
        const int nig = WGM * nN, gid = wgid / nig, fm = gid * WGM, gsz = (nM - fm) < WGM ? (nM - fm) : WGM;
        u.pm = fm + ((wgid % nig) % gsz); u.pn = (wgid % nig) / gsz; return true;
    }
    __device__ __forceinline__ void a_ready(const Unit&) const {}
    __device__ __forceinline__ void done(const Unit&) const {}
};


__device__ __forceinline__ unsigned cvt_pk_bf16(float lo, float hi) { unsigned r; asm volatile("v_cvt_pk_bf16_f32 %0, %1, %2" : "=v"(r) : "v"(lo), "v"(hi)); return r; }

struct EpiSplit {
    static constexpr bool PERM = true, AFTER_DRAIN = false;
    bf16_t* O0; int ld0; int t1; bf16_t* O1; int ld1; int t2; bf16_t* O2; int ld2; const float* ss; const PG8_LAS float* rs_lds; int fm; int np;
    __device__ __forceinline__ void operator()(const f32x4 (&acc)[2][2][4][2], const Unit& u, int wr, int wc, int fr, int fq) const {
        const int row0 = u.pm * BM + wr * 64 + fr;
        bf16_t* base; int ldc, ct;
        if (u.pn < t1) { base = O0; ldc = ld0; ct = u.pn; } else if (u.pn < t2) { base = O1; ldc = ld1; ct = u.pn - t1; } else { base = O2; ldc = ld2; ct = u.pn - t2; }
        const int col0 = ct * BM + wc * 32 + 8 * fq;
#pragma unroll
        for (int ai = 0; ai < 2; ++ai)
#pragma unroll
            for (int m = 0; m < 4; ++m) { bf16_t* rowp = base + (size_t)(row0 + ai * HALF + m * 16) * ldc + col0;
                const unsigned pl = (unsigned)(u.pm - fm);
                const float rs = pl < 8u ? rs_lds[pl * BM + wr * 64 + fr + ai * HALF + m * 16] : 1.0f / sqrtf(row_sumsq(ss, np, row0 + ai * HALF + m * 16) * (1.0f / 4096.0f) + 1e-6f);
#pragma unroll
                for (int bj = 0; bj < 2; ++bj) { const f32x4 v0 = acc[ai][bj][m][0] * rs, v1 = acc[ai][bj][m][1] * rs;
                    u32x4 w; w.x = cvt_pk_bf16(v0[0], v0[1]); w.y = cvt_pk_bf16(v0[2], v0[3]); w.z = cvt_pk_bf16(v1[0], v1[1]); w.w = cvt_pk_bf16(v1[2], v1[3]);
                    *(u32x4*)(rowp + bj * HALF) = w; } }
    }
};
struct EpiRes {
    static constexpr bool PERM = true, AFTER_DRAIN = false;
    bf16_t* xb; float* out; int ldc; float* ssp; int last;
    __device__ __forceinline__ void operator()(const f32x4 (&acc)[2][2][4][2], const Unit& u, int wr, int wc, int fr, int fq) const {
        const int row0 = u.pm * BM + wr * 64 + fr, col0 = u.pn * BM + wc * 32 + 8 * fq;
        float* sp = ssp + (size_t)(u.pn * 4 + wc) * MTOK;
#pragma unroll
        for (int ai = 0; ai < 2; ++ai) {
            u32x4 r[4][2];
#pragma unroll
            for (int m = 0; m < 4; ++m) { const size_t off = (size_t)(row0 + ai * HALF + m * 16) * ldc + col0;
#pragma unroll
                for (int bj = 0; bj < 2; ++bj) r[m][bj] = *(const u32x4*)(xb + off + bj * HALF); }
#pragma unroll
            for (int m = 0; m < 4; ++m) { const size_t off = (size_t)(row0 + ai * HALF + m * 16) * ldc + col0;
                float sq = 0.f;
#pragma unroll
                for (int bj = 0; bj < 2; ++bj) { const u32x4 rv = r[m][bj];
                    const f32x4 o0 = (f32x4){__uint_as_float(rv.x << 16), __uint_as_float(rv.x & 0xffff0000u), __uint_as_float(rv.y << 16), __uint_as_float(rv.y & 0xffff0000u)} + acc[ai][bj][m][0];
                    const f32x4 o1 = (f32x4){__uint_as_float(rv.z << 16), __uint_as_float(rv.z & 0xffff0000u), __uint_as_float(rv.w << 16), __uint_as_float(rv.w & 0xffff0000u)} + acc[ai][bj][m][1];
                    sq += ((o0[0] * o0[0] + o0[1] * o0[1]) + (o0[2] * o0[2] + o0[3] * o0[3])) + ((o1[0] * o1[0] + o1[1] * o1[1]) + (o1[2] * o1[2] + o1[3] * o1[3]));
                    if (last) { *(f32x4*)(out + off + bj * HALF) = o0; *(f32x4*)(out + off + bj * HALF + 4) = o1; }
                    else { u32x4 w; w.x = cvt_pk_bf16(o0[0], o0[1]); w.y = cvt_pk_bf16(o0[2], o0[3]); w.z = cvt_pk_bf16(o1[0], o1[1]); w.w = cvt_pk_bf16(o1[2], o1[3]); *(u32x4*)(xb + off + bj * HALF) = w; } }
                sq += __shfl_xor(sq, 16); sq += __shfl_xor(sq, 32);
                if (fq == 0) sp[row0 + ai * HALF + m * 16] = sq; }
            asm volatile("" ::: "memory");
        }
    }
};
template <class Epi, class Sched, bool ALIGN_EPI = false, bool SP2 = false>
__device__ __forceinline__ void gemm_phase(PG8_LAS unsigned char* lds, const Gemm g, const Sched& S, const Epi& E) {
    int tid_ = (int)threadIdx.x; asm volatile("" : "+v"(tid_));
    const int tid = tid_, wid = __builtin_amdgcn_readfirstlane(tid >> 6), lane = tid & 63, wr = wid >> 2, wc = wid & 3, fr = lane & 15, fq = lane >> 4;
    const int K = g.K, nt = K / BK;
    unsigned voffA[2], voffB[2];
#pragma unroll
    for (int i = 0; i < 2; ++i) { int R, C; stage_rc(tid * 16 + i * 8192, R, C); const int Rb = Epi::PERM ? ((R & ~31) + perm32(R & 31)) : R;
        voffA[i] = (unsigned)(R * K + C) * 2u; voffB[i] = (unsigned)(Rb * K + C) * 2u; }
    asm volatile("" : "+v"(voffA[0]), "+v"(voffA[1]), "+v"(voffB[0]), "+v"(voffB[1]));
    const size_t kstep = (size_t)(BK * 2);
    const size_t hstep = (size_t)HALF * K * 2;
    const size_t tstep = 2 * hstep;
    const unsigned ldsw = (unsigned)wid * 1024u;
    const int aoff = lds_byte(wr * 64 + fr, fq * 8), boff = lds_byte(wc * 32 + fr, fq * 8);
#define PG8_SA(b, h) (((b) * 2 + (h)) * HTB)
#define PG8_SB(b, h) ((4 + (b) * 2 + (h)) * HTB)
#define PG8_STAGE(bufoff, gbase, voff) do { _Pragma("unroll") for (int _i = 0; _i < 2; ++_i) \
        __builtin_amdgcn_global_load_lds((const unsigned*)((const char*)(gbase) + (voff)[_i]), (PG8_LAS unsigned*)(lds + (bufoff) + ldsw + _i * 8192), 16, 0, 0); } while (0)
#define PG8_LDA(dst, b, h) do { _Pragma("unroll") for (int m = 0; m < 4; ++m) _Pragma("unroll") for (int k = 0; k < 2; ++k) dst[m][k] = *(const PG8_LAS bf16x8*)(lds + PG8_SA(b, h) + aoff + m * 2048 + k * 1024); } while (0)
#define PG8_LDB(dst, b, h) do { _Pragma("unroll") for (int n = 0; n < 2; ++n) _Pragma("unroll") for (int k = 0; k < 2; ++k) dst[n][k] = *(const PG8_LAS bf16x8*)(lds + PG8_SB(b, h) + boff + n * 2048 + k * 1024); } while (0)
#define PG8_MMA(ai, bj, At, Bt) do { __builtin_amdgcn_s_setprio(1); _Pragma("unroll") for (int m = 0; m < 4; ++m) _Pragma("unroll") for (int n = 0; n < 2; ++n) _Pragma("unroll") for (int k = 0; k < 2; ++k) \
        acc[ai][bj][m][n] = __builtin_amdgcn_mfma_f32_16x16x32_bf16(Bt[n][k], At[m][k], acc[ai][bj][m][n], 0, 0, 0); __builtin_amdgcn_s_setprio(0); } while (0)
#define PG8_WAIT_V(n) asm volatile("s_waitcnt vmcnt(" #n ")" ::: "memory")
#define PG8_WAIT_L(n) asm volatile("s_waitcnt lgkmcnt(" #n ")" ::: "memory")
#define PG8_BAR __builtin_amdgcn_s_barrier()
#define PG8_SCHED __builtin_amdgcn_sched_barrier(0)
    Unit cur, nxt; int ui = 0;
    if (!S.next(0, cur)) return;
    f32x4 acc[2][2][4][2];
#pragma unroll
    for (int a = 0; a < 2; ++a)
#pragma unroll
        for (int b = 0; b < 2; ++b)
#pragma unroll
            for (int m = 0; m < 4; ++m)
#pragma unroll
                for (int n = 0; n < 2; ++n) acc[a][b][m][n] = (f32x4){0.f, 0.f, 0.f, 0.f};
    bf16x8 At[4][2], B0[2][2], B1[2][2];
    const char* cA = (const char*)g.A + (size_t)cur.pm * tstep; const char* cB = (const char*)g.Bt + (size_t)cur.pn * tstep;
    S.a_ready(cur);
    if constexpr (SP2) {
        PG8_STAGE(PG8_SB(0, 0), cB, voffB); PG8_STAGE(PG8_SB(0, 1), cB + hstep, voffB); PG8_STAGE(PG8_SA(0, 0), cA, voffA); PG8_STAGE(PG8_SA(0, 1), cA + hstep, voffA);
        if (wr == 1) PG8_BAR;
        PG8_WAIT_V(2); PG8_BAR;
        PG8_STAGE(PG8_SB(1, 0), cB + kstep, voffB); PG8_STAGE(PG8_SA(1, 0), cA + kstep, voffA); PG8_STAGE(PG8_SB(1, 1), cB + hstep + kstep, voffB);
        PG8_WAIT_V(6); PG8_BAR;
    } else {
        PG8_STAGE(PG8_SB(0, 0), cB, voffB); PG8_STAGE(PG8_SA(0, 0), cA, voffA); PG8_STAGE(PG8_SB(0, 1), cB + hstep, voffB); PG8_STAGE(PG8_SA(0, 1), cA + hstep, voffA);
        if (wr == 1) PG8_BAR;
        PG8_WAIT_V(4); PG8_BAR;
        PG8_STAGE(PG8_SB(1, 0), cB + kstep, voffB); PG8_STAGE(PG8_SA(1, 0), cA + kstep, voffA); PG8_STAGE(PG8_SB(1, 1), cB + hstep + kstep, voffB);
        PG8_WAIT_V(6); PG8_BAR;
    }
    for (;;) {
        const bool has_next = S.next(ui + 1, nxt);
        const char* nA = has_next ? (const char*)g.A + (size_t)nxt.pm * tstep : cA; const char* nB = has_next ? (const char*)g.Bt + (size_t)nxt.pn * tstep : cB;
        for (int t = 0; t < nt; t += 2) {
            const bool last = (t == nt - 2);
            const char* a1 = cA + (size_t)(t + 1) * kstep;
            const char* a2 = last ? nA : cA + (size_t)(t + 2) * kstep; const char* b2 = last ? nB : cB + (size_t)(t + 2) * kstep;
            const char* a3 = a2 + kstep; const char* b3 = b2 + kstep;
            if (last && has_next) S.a_ready(nxt);
            if constexpr (SP2) {
            PG8_LDB(B0, 0, 0); PG8_LDB(B1, 0, 1); PG8_SCHED; PG8_LDA(At, 0, 0); PG8_STAGE(PG8_SA(1, 1), a1 + hstep, voffA);
            PG8_WAIT_V(8); PG8_WAIT_L(0); PG8_BAR; PG8_MMA(0, 0, At, B0); PG8_MMA(0, 1, At, B1); PG8_BAR; PG8_SCHED;
            PG8_LDA(At, 0, 1); PG8_STAGE(PG8_SB(0, 0), b2, voffB); PG8_STAGE(PG8_SB(0, 1), b2 + hstep, voffB); PG8_STAGE(PG8_SA(0, 0), a2, voffA);
            PG8_WAIT_V(8); PG8_WAIT_L(0); PG8_BAR; PG8_MMA(1, 0, At, B0); PG8_MMA(1, 1, At, B1); PG8_BAR; PG8_SCHED;
            PG8_LDB(B0, 1, 0); PG8_LDB(B1, 1, 1); PG8_SCHED; PG8_LDA(At, 1, 0); PG8_STAGE(PG8_SA(0, 1), a2 + hstep, voffA);
            PG8_WAIT_V(8); PG8_WAIT_L(0); PG8_BAR; PG8_MMA(0, 0, At, B0); PG8_MMA(0, 1, At, B1); PG8_BAR; PG8_SCHED;
            PG8_LDA(At, 1, 1); PG8_STAGE(PG8_SB(1, 0), b3, voffB); PG8_STAGE(PG8_SB(1, 1), b3 + hstep, voffB); PG8_STAGE(PG8_SA(1, 0), a3, voffA);
            PG8_WAIT_V(8); PG8_WAIT_L(0); PG8_BAR; PG8_MMA(1, 0, At, B0); PG8_MMA(1, 1, At, B1); PG8_BAR; PG8_SCHED;
            } else {
            PG8_LDB(B0, 0, 0); PG8_SCHED; PG8_LDA(At, 0, 0); PG8_STAGE(PG8_SA(1, 1), a1 + hstep, voffA);
            PG8_WAIT_L(8); PG8_BAR; PG8_WAIT_L(0); PG8_MMA(0, 0, At, B0); PG8_BAR; PG8_SCHED;
            PG8_LDB(B1, 0, 1); PG8_STAGE(PG8_SB(0, 0), b2, voffB);
            PG8_BAR; PG8_WAIT_L(0); PG8_MMA(0, 1, At, B1); PG8_BAR;
            PG8_LDA(At, 0, 1); PG8_STAGE(PG8_SA(0, 0), a2, voffA);
            PG8_BAR; PG8_WAIT_L(0); PG8_MMA(1, 0, At, B0); PG8_BAR; PG8_SCHED;
            PG8_STAGE(PG8_SB(0, 1), b2 + hstep, voffB);
            PG8_WAIT_V(6); PG8_BAR; PG8_MMA(1, 1, At, B1); PG8_BAR;
            PG8_LDB(B0, 1, 0); PG8_SCHED; PG8_LDA(At, 1, 0); PG8_STAGE(PG8_SA(0, 1), a2 + hstep, voffA);
            PG8_WAIT_L(8); PG8_BAR; PG8_WAIT_L(0); PG8_MMA(0, 0, At, B0); PG8_BAR; PG8_SCHED;
            PG8_LDB(B1, 1, 1); PG8_STAGE(PG8_SB(1, 0), b3, voffB);
            PG8_BAR; PG8_WAIT_L(0); PG8_MMA(0, 1, At, B1); PG8_BAR;
            PG8_LDA(At, 1, 1); PG8_STAGE(PG8_SA(1, 0), a3, voffA);
            PG8_BAR; PG8_WAIT_L(0); PG8_MMA(1, 0, At, B0); PG8_BAR; PG8_SCHED;
            PG8_STAGE(PG8_SB(1, 1), b3 + hstep, voffB);
            PG8_WAIT_V(6); PG8_BAR; PG8_MMA(1, 1, At, B1); PG8_BAR;
            }
        }
        if constexpr (ALIGN_EPI) { if (wr == 0) PG8_BAR; }
        if constexpr (!Epi::AFTER_DRAIN) { E(acc, cur, wr, wc, fr, fq); S.done(cur); }
        if (!has_next) break;
#pragma unroll
        for (int a = 0; a < 2; ++a)
#pragma unroll
            for (int b = 0; b < 2; ++b)
#pragma unroll
                for (int m = 0; m < 4; ++m)
#pragma unroll
                    for (int n = 0; n < 2; ++n) acc[a][b][m][n] = (f32x4){0.f, 0.f, 0.f, 0.f};
        cur = nxt; cA = nA; cB = nB; ++ui;
        if constexpr (ALIGN_EPI) { if (wr == 1) PG8_BAR; }
    }
    PG8_WAIT_V(0);
    if constexpr (!ALIGN_EPI) { if (wr == 0) PG8_BAR; }
    PG8_BAR;
    if constexpr (Epi::AFTER_DRAIN) { E.fused(acc, cur, wr, wc, fr, fq, lds, wid, lane); S.done(cur); }
#undef PG8_SA
#undef PG8_SB
#undef PG8_STAGE
#undef PG8_LDA
#undef PG8_LDB
#undef PG8_MMA
#undef PG8_WAIT_V
#undef PG8_WAIT_L
#undef PG8_BAR
#undef PG8_SCHED
}
}
#define XB_TMO      128
#define XB_XCNT(j)  (256  + 64 * (j))
#define XB_XSUB(j)  (1280 + 64 * (j))
#define XB_XGEN(j)  (2304 + 64 * (j))
#define XB_TOP      3328
#define XB_TOPGEN   3392
#define XCD_BAR_WORDS 3456
#define XB_SPIN_CAP (1u << 18)

__device__ __forceinline__ unsigned xb_ld(unsigned* p)              { return __hip_atomic_load(p, __ATOMIC_RELAXED, __HIP_MEMORY_SCOPE_AGENT); }
__device__ __forceinline__ unsigned xb_add(unsigned* p, unsigned v) { return __hip_atomic_fetch_add(p, v, __ATOMIC_RELAXED, __HIP_MEMORY_SCOPE_AGENT); }
__device__ __forceinline__ unsigned xb_xcc_id() { return (unsigned)__builtin_amdgcn_s_getreg((3 << 11) | 20) & 0xFu; }
#define XB_SPIN(cond, bar) do { unsigned _sp = 0; while (cond) { __builtin_amdgcn_s_sleep(1); \
    if ((++_sp & 255u) == 0u) { if (xb_ld(&(bar)[XB_TMO])) break; if (_sp > XB_SPIN_CAP) { atomicAdd(&(bar)[XB_TMO], 1u); break; } } } } while (0)

struct XcdBarrier {
    unsigned* bar; unsigned x;
    volatile LAS unsigned* st;
};

__device__ __forceinline__ XcdBarrier xcd_barrier_post(unsigned* bar, volatile LAS unsigned* st) {
    XcdBarrier b; b.bar = bar; b.x = xb_xcc_id(); b.st = st;
    if (threadIdx.x == 0) (void)xb_add(&bar[XB_XCNT(b.x)], 1u);
    return b;
}
__device__ __forceinline__ void xcd_barrier_complete(unsigned* bar, unsigned x, unsigned& nloc, unsigned& nx) {
    const unsigned G = gridDim.x * gridDim.y * gridDim.z;
    unsigned sum, cnt, mine, sp = 0u;
    for (;;) {
        sum = 0u; cnt = 0u; mine = 0u;
#pragma unroll
        for (unsigned j = 0; j < 16; ++j) { const unsigned c = xb_ld(&bar[XB_XCNT(j)]); sum += c; cnt += (c > 0u) ? 1u : 0u; mine = (j == x) ? c : mine; }
        if (sum == G) break;
        __builtin_amdgcn_s_sleep(1);
        if ((++sp & 255u) == 0u) { if (xb_ld(&bar[XB_TMO])) break; if (sp > XB_SPIN_CAP) { atomicAdd(&bar[XB_TMO], 1u); break; } }
    }
    nloc = mine > 0u ? mine : 1u; nx = cnt > 0u ? cnt : 1u;
}

__device__ __forceinline__ void xcd_barrier(const XcdBarrier& b) {
    asm volatile("s_waitcnt vmcnt(0)" ::: "memory");
    __syncthreads();
    if (threadIdx.x == 0) {
        unsigned* bar = b.bar;
        __builtin_amdgcn_s_waitcnt(0);
        unsigned nloc = b.st[0], nx = b.st[1];
        if (nloc == 0u) { xcd_barrier_complete(bar, b.x, nloc, nx); b.st[0] = nloc; b.st[1] = nx; }
        const unsigned old = xb_add(&bar[XB_XSUB(b.x)], 1u);
        const unsigned gen = old / nloc;
        if (old + 1u == (gen + 1u) * nloc) {
            __builtin_amdgcn_fence(__ATOMIC_RELEASE, "agent");
            asm volatile("s_waitcnt vmcnt(0)" ::: "memory");
            const unsigned og = xb_add(&bar[XB_TOP], 1u);
            const unsigned tg = og / nx;
            if (og + 1u == (tg + 1u) * nx) xb_add(&bar[XB_TOPGEN], 1u);
            else XB_SPIN(xb_ld(&bar[XB_TOPGEN]) == tg, bar);
            __builtin_amdgcn_fence(__ATOMIC_ACQUIRE, "agent");
            xb_add(&bar[XB_XGEN(b.x)], 1u);
            asm volatile("s_waitcnt vmcnt(0)" ::: "memory");
        } else {
            XB_SPIN(xb_ld(&bar[XB_XGEN(b.x)]) == gen, bar);
            __builtin_amdgcn_fence(__ATOMIC_ACQUIRE, "agent");
            asm volatile("s_waitcnt vmcnt(0)" ::: "memory");
        }
    }
    __syncthreads();
}

#define LDS_WAIT() asm volatile("s_waitcnt lgkmcnt(0)" ::: "memory")
#define VM_WAIT() asm volatile("s_waitcnt vmcnt(0)" ::: "memory")
#define SBAR() __builtin_amdgcn_sched_barrier(0)
__device__ __forceinline__ unsigned cvtpk(float lo, float hi) { unsigned r; asm volatile("v_cvt_pk_bf16_f32 %0, %1, %2" : "=v"(r) : "v"(lo), "v"(hi)); return r; }
__device__ __forceinline__ float bf_lo(unsigned w) { return __uint_as_float(w << 16); }
__device__ __forceinline__ float bf_hi(unsigned w) { return __uint_as_float(w & 0xffff0000u); }
__device__ __forceinline__ float bf2f(bf16_t h) { return __uint_as_float(((unsigned)h) << 16); }
__device__ __forceinline__ float wave_sum(float v) {
#pragma unroll
    for (int o = 1; o < 64; o <<= 1) v += __shfl_xor(v, o);
    return v;
}
__device__ __forceinline__ float fast_exp2(float x) { return __builtin_amdgcn_exp2f(x); }
__device__ __forceinline__ float fast_log2(float x) { return __builtin_amdgcn_logf(x); }
__device__ __forceinline__ float fast_rcp(float x) { return __builtin_amdgcn_rcpf(x); }

__device__ __forceinline__ int tid_now() { int t = (int)threadIdx.x; asm volatile("" : "+v"(t)); return t; }

struct Params { const float* in[27]; float* out; unsigned char* ws; int ph_lo, ph_hi; };

struct TrJob { int src, N, c0, ncols, K, gain, r0; size_t dst; };
__device__ __forceinline__ void tr_item(const float* W, int N, int c0, int ncols, int K, const float* gain, bf16_t* WT, int r0, int kb, int nb, LAS float* scr, int lane) {
    const int k0 = kb * 64, n0 = nb * 64;
    const float* src = W + (size_t)k0 * N + c0 + n0 + lane;
#pragma unroll 16
    for (int i = 0; i < 64; ++i) scr[i * 65 + lane] = src[(size_t)i * N];
    LDS_WAIT(); asm volatile("" ::: "memory");
    const int c = lane & 7;
    float gv[8];
#pragma unroll
    for (int e = 0; e < 8; ++e) gv[e] = gain ? gain[k0 + 8 * c + e] : 1.0f;
#pragma unroll
    for (int j = 0; j < 8; ++j) { const int n = (lane >> 3) + 8 * j; const LAS float* s = scr + (8 * c) * 65 + n;
        u32x4 o; o.x = cvtpk(s[0 * 65] * gv[0], s[1 * 65] * gv[1]); o.y = cvtpk(s[2 * 65] * gv[2], s[3 * 65] * gv[3]); o.z = cvtpk(s[4 * 65] * gv[4], s[5 * 65] * gv[5]); o.w = cvtpk(s[6 * 65] * gv[6], s[7 * 65] * gv[7]);
        if (n0 + n >= ncols) o = (u32x4){0u, 0u, 0u, 0u};
        *(u32x4*)(WT + (size_t)(r0 + n0 + n) * K + k0 + 8 * c) = o; }
    LDS_WAIT(); asm volatile("" ::: "memory");
}
constexpr int NJOBS = 21;
__device__ __forceinline__ TrJob get_job(int id) {
    TrJob j{};
    if (id < 16) { const int l = id >> 3, k = id & 7, ib = 2 + 8 * l;
        switch (k) {
        case 0: j = TrJob{ib + 1, 19552, 0, 7168, 4096, ib, 0, WS_WAIN + l * WAIN_BYTES}; break;
        case 1: j = TrJob{ib + 1, 19552, 7264, 12288, 4096, ib, 7168, WS_WAIN + l * WAIN_BYTES}; break;
        case 2: j = TrJob{ib + 1, 19552, 7168, 96, 4096, ib, 0, WS_WG + (size_t)l * 128 * 4096 * 2}; break;
        case 3: j = TrJob{ib + 7, 4096, 0, 4096, 4096, -1, 0, WS_WAOUT + l * WOUT_BYTES}; break;
        case 4: j = TrJob{ib + 3, 128, 0, 128, 4096, -1, 0, WS_W1T + (size_t)(l * 2 + 0) * 128 * 4096 * 2}; break;
        case 5: j = TrJob{ib + 5, 128, 0, 128, 4096, -1, 0, WS_W1T + (size_t)(l * 2 + 1) * 128 * 4096 * 2}; break;
        case 6: j = TrJob{ib + 4, 128, 0, 128, 128, -1, 0, WS_W2T + (size_t)(l * 2 + 0) * 128 * 128 * 2}; break;
        default: j = TrJob{ib + 6, 128, 0, 128, 128, -1, 0, WS_W2T + (size_t)(l * 2 + 1) * 128 * 128 * 2}; break;
        }
    } else {
        switch (id) {
        case 16: j = TrJob{19, 8192, 0, 8192, 4096, 18, 0, WS_WKVQ}; break;
        case 17: j = TrJob{21, 8192, 0, 8192, 4096, 20, 8192, WS_WKVQ}; break;
        case 18: j = TrJob{22, 4096, 0, 4096, 4096, -1, 0, WS_WBOUT}; break;
        case 19: j = TrJob{24, 8192, 0, 8192, 4096, 23, 0, WS_WB3}; break;
        default: j = TrJob{25, 4096, 0, 4096, 4096, -1, 0, WS_WBOUT + WOUT_BYTES}; break;
        }
    }
    return j;
}
__device__ __forceinline__ int job_items(const TrJob& j) { return (j.K / 64) * ((j.ncols + 63) / 64); }

__device__ __forceinline__ void phase_x_to_bf16(const float* x, bf16_t* xb, float* ss) {
    const int tid = tid_now(), lane = tid & 63, gw = blockIdx.x * 8 + __builtin_amdgcn_readfirstlane(tid >> 6), ngw = gridDim.x * 8;
    for (int m = gw; m < MTOK; m += ngw) {
        const f32x4* xr = (const f32x4*)(x + (size_t)m * DM) + lane; u32x2* o8 = (u32x2*)(xb + (size_t)m * DM) + lane;
        f32x4 v[16]; float s = 0.f;
#pragma unroll
        for (int j = 0; j < 16; ++j) { v[j] = xr[64 * j]; s += (v[j].x * v[j].x + v[j].y * v[j].y) + (v[j].z * v[j].z + v[j].w * v[j].w); }
#pragma unroll
        for (int j = 0; j < 16; ++j) { u32x2 w; w.x = cvtpk(v[j].x, v[j].y); w.y = cvtpk(v[j].z, v[j].w); o8[64 * j] = w; }
        s = wave_sum(s);
        if (lane == 0) ss[m] = s;
    }
}
__device__ __forceinline__ void phase_final_norm(const bf16_t* xb, float* out, const float* g, const float* ss, LAS unsigned char* lds) {
    const int tid = tid_now(), lane = tid & 63, wave = __builtin_amdgcn_readfirstlane(tid >> 6);
    LAS float* RSF = (LAS float*)lds;
    for (int r0 = blockIdx.x * 64; r0 < MTOK; r0 += gridDim.x * 64) {
        __syncthreads();
        if (tid < 64) RSF[tid] = 1.0f / sqrtf(row_sumsq(ss, SS_NP, r0 + tid) * (1.0f / DM) + RMS_EPS);
        __syncthreads();
        for (int k = 0; k < 8; ++k) { const int m = r0 + wave * 8 + k;
            const u32x4* xr = (const u32x4*)(xb + (size_t)m * DM) + lane; f32x4* orow = (f32x4*)(out + (size_t)m * DM) + 2 * lane; const f32x4* gr = (const f32x4*)g + 2 * lane;
            const float rstd = RSF[wave * 8 + k];
#pragma unroll
            for (int j = 0; j < 8; ++j) { const u32x4 v = xr[64 * j];
                const f32x4 lo = (f32x4){__uint_as_float(v.x << 16), __uint_as_float(v.x & 0xffff0000u), __uint_as_float(v.y << 16), __uint_as_float(v.y & 0xffff0000u)};
                const f32x4 hi = (f32x4){__uint_as_float(v.z << 16), __uint_as_float(v.z & 0xffff0000u), __uint_as_float(v.w << 16), __uint_as_float(v.w & 0xffff0000u)};
                orow[128 * j] = lo * rstd * gr[128 * j]; orow[128 * j + 1] = hi * rstd * gr[128 * j + 1]; } }
    }
}

__device__ __forceinline__ void phase_prologue(const Params& P, LAS unsigned char* lds) {
    const int tid = tid_now(), lane = tid & 63, wave = __builtin_amdgcn_readfirstlane(tid >> 6), G = gridDim.x;
    LAS float* scr = (LAS float*)(lds + wave * 16640);
    const int gw = blockIdx.x * 8 + wave, ngw = G * 8;
    int base = 0;
    for (int id = 0; id < NJOBS; ++id) {
        const TrJob j = get_job(id); const int ni = job_items(j), nbn = (j.ncols + 63) / 64;
        int it = gw - (base % ngw); if (it < 0) it += ngw;
        const float* W = P.in[j.src]; const float* gain = j.gain >= 0 ? P.in[j.gain] : nullptr; bf16_t* WT = (bf16_t*)(P.ws + j.dst);
        for (; it < ni; it += ngw) tr_item(W, j.N, j.c0, j.ncols, j.K, gain, WT, j.r0, it / nbn, it % nbn, scr, lane);
        base += ni;
    }
    __syncthreads();
    for (int item = blockIdx.x; item < 64; item += G) {
        const int lk = item >> 4, kp = item & 15, l = lk >> 1, kv = lk & 1, ib = 2 + 8 * l;
        const float* pos = P.in[ib + 2]; const float* w1 = P.in[ib + 3 + 2 * kv];
        const int col = tid & 127, part = tid >> 7, kbeg = kp * 256 + part * 64; float s = 0.f;
#pragma unroll 8
        for (int k = kbeg; k < kbeg + 64; ++k) s += pos[k] * w1[(size_t)k * 128 + col];
        LAS float* red = (LAS float*)lds;
        red[part * 128 + col] = s; __syncthreads();
        if (tid < 128) ((float*)(P.ws + WS_C1))[item * 128 + tid] = (red[tid] + red[128 + tid]) + (red[256 + tid] + red[384 + tid]);
        __syncthreads();
    }
    phase_x_to_bf16(P.in[0], (bf16_t*)(P.ws + WS_XB), (float*)(P.ws + WS_SS));
}

__device__ __forceinline__ bf16x8 ld8(const bf16_t* p) { return *(const bf16x8*)p; }
__device__ __forceinline__ void compress_unit(const Params& P, int l, int cu, LAS unsigned char* lds) {
    const int tid = tid_now(), lane = tid & 63, wave = __builtin_amdgcn_readfirstlane(tid >> 6);
    const int rt = cu & 3, kv = (cu >> 2) & 1, bg = cu >> 3, b = bg >> 2, g = bg & 3;
    const bf16_t* raw = (const bf16_t*)(P.ws + WS_KV) + (size_t)(b * SEQ) * KVW + kv * 512 + g * 128;
    const bf16_t* w1t = (const bf16_t*)(P.ws + WS_W1T) + (size_t)(l * 2 + kv) * 128 * 4096;
    const bf16_t* w2t = (const bf16_t*)(P.ws + WS_W2T) + (size_t)(l * 2 + kv) * 128 * 128;
    const float* c1p = (const float*)(P.ws + WS_C1) + (size_t)(l * 2 + kv) * 16 * 128;
    bf16_t* outp = (bf16_t*)(P.ws + (kv ? WS_VC : WS_KC)) + (size_t)bg * 128 * 128;
    const int fr = lane & 15, fq = lane >> 4;
    LAS float* PART = (LAS float*)lds;
    LAS bf16_t* H = (LAS bf16_t*)(lds + 131072);
    {
        int n0 = rt * 32 + fr, n1 = n0 + 16; n0 = n0 > 126 ? 126 : n0; n1 = n1 > 126 ? 126 : n1;
        const bf16_t* ap0 = raw + (size_t)(16 * n0 + wave * 4) * KVW + fq * 8; const bf16_t* ap1 = raw + (size_t)(16 * n1 + wave * 4) * KVW + fq * 8;
        const bf16_t* bp = w1t + (size_t)fr * 4096 + wave * 512 + fq * 8;
        f32x4 acc[2][8];
#pragma unroll
        for (int i = 0; i < 2; ++i)
#pragma unroll
            for (int c = 0; c < 8; ++c) acc[i][c] = (f32x4){0.f, 0.f, 0.f, 0.f};
#pragma unroll 4
        for (int ks = 0; ks < 16; ++ks) {
            const bf16x8 a0 = ld8(ap0 + (size_t)(ks >> 2) * KVW + (ks & 3) * 32), a1 = ld8(ap1 + (size_t)(ks >> 2) * KVW + (ks & 3) * 32);
            bf16x8 bb[8];
#pragma unroll
            for (int c = 0; c < 8; ++c) bb[c] = ld8(bp + (size_t)c * 16 * 4096 + ks * 32);
#pragma unroll
            for (int c = 0; c < 8; ++c) { acc[0][c] = __builtin_amdgcn_mfma_f32_16x16x32_bf16(a0, bb[c], acc[0][c], 0, 0, 0); acc[1][c] = __builtin_amdgcn_mfma_f32_16x16x32_bf16(a1, bb[c], acc[1][c], 0, 0, 0); }
        }
#pragma unroll
        for (int i = 0; i < 2; ++i)
#pragma unroll
            for (int c = 0; c < 8; ++c)
#pragma unroll
                for (int r = 0; r < 4; ++r) PART[(wave * 32 + i * 16 + fq * 4 + r) * 128 + c * 16 + fr] = acc[i][c][r];
    }
    __syncthreads();
    { const int col = tid & 127; float cc = 0.f;
#pragma unroll
      for (int kp = 0; kp < 16; ++kp) cc += c1p[kp * 128 + col];
#pragma unroll
      for (int e = 0; e < 8; ++e) { const int row = (tid >> 7) * 8 + e; float v = cc;
#pragma unroll
          for (int w = 0; w < 8; ++w) v += PART[(w * 32 + row) * 128 + col];
          const float sv = v * fast_rcp(1.0f + fast_exp2(-v * LOG2E));
          H[row * 136 + col] = (bf16_t)(cvtpk(sv, 0.f) & 0xffffu); } }
    __syncthreads();
    const int rtile = wave & 1, ct0 = (wave >> 1) * 2;
    f32x4 o0 = {0.f, 0.f, 0.f, 0.f}, o1 = {0.f, 0.f, 0.f, 0.f};
#pragma unroll
    for (int ks = 0; ks < 4; ++ks) {
        const bf16x8 a = *(const LAS bf16x8*)(H + (rtile * 16 + fr) * 136 + ks * 32 + fq * 8);
        const bf16x8 b0 = ld8(w2t + (size_t)(ct0 * 16 + fr) * 128 + ks * 32 + fq * 8), b1 = ld8(w2t + (size_t)((ct0 + 1) * 16 + fr) * 128 + ks * 32 + fq * 8);
        o0 = __builtin_amdgcn_mfma_f32_16x16x32_bf16(a, b0, o0, 0, 0, 0);
        o1 = __builtin_amdgcn_mfma_f32_16x16x32_bf16(a, b1, o1, 0, 0, 0);
    }
#pragma unroll
    for (int c = 0; c < 2; ++c) { const int col = (ct0 + c) * 16 + fr;
#pragma unroll
        for (int r = 0; r < 4; ++r) { const int nr = rt * 32 + rtile * 16 + fq * 4 + r; const float v = nr < NCMP ? (c ? o1[r] : o0[r]) : 0.f;
            outp[(size_t)nr * 128 + col] = (bf16_t)(cvtpk(v, 0.f) & 0xffffu); } }
    __syncthreads();
}
__device__ __forceinline__ void gate_unit(const Params& P, int l, int gu, LAS unsigned char* lds) {
    const int tid = tid_now(), lane = tid & 63, wave = __builtin_amdgcn_readfirstlane(tid >> 6);
    const bf16_t* xb = (const bf16_t*)(P.ws + WS_XB); const bf16_t* wg = (const bf16_t*)(P.ws + WS_WG) + (size_t)l * 128 * 4096;
    const float* ss = l == 0 ? (const float*)(P.ws + WS_SS) : (const float*)(P.ws + WS_SSP); const int np = l == 0 ? 1 : SS_NP;
    float* Gt = (float*)(P.ws + WS_G);
    const int fr = lane & 15, fq = lane >> 4, kq = wave & 3, rh = wave >> 2;
    LAS float* PART = (LAS float*)lds;
    {
        const bf16_t* ap = xb + (size_t)(gu * 64 + rh * 32 + fr) * DM + kq * 1024 + fq * 8;
        const bf16_t* bp = wg + (size_t)fr * DM + kq * 1024 + fq * 8;
        f32x4 acc[2][6];
#pragma unroll
        for (int i = 0; i < 2; ++i)
#pragma unroll
            for (int c = 0; c < 6; ++c) acc[i][c] = (f32x4){0.f, 0.f, 0.f, 0.f};
#pragma unroll 4
        for (int ks = 0; ks < 32; ++ks) {
            const bf16x8 a0 = ld8(ap + ks * 32), a1 = ld8(ap + (size_t)16 * DM + ks * 32);
            bf16x8 bb[6];
#pragma unroll
            for (int c = 0; c < 6; ++c) bb[c] = ld8(bp + (size_t)c * 16 * DM + ks * 32);
#pragma unroll
            for (int c = 0; c < 6; ++c) { acc[0][c] = __builtin_amdgcn_mfma_f32_16x16x32_bf16(a0, bb[c], acc[0][c], 0, 0, 0); acc[1][c] = __builtin_amdgcn_mfma_f32_16x16x32_bf16(a1, bb[c], acc[1][c], 0, 0, 0); }
        }
#pragma unroll
        for (int i = 0; i < 2; ++i)
#pragma unroll
            for (int c = 0; c < 6; ++c)
#pragma unroll
                for (int r = 0; r < 4; ++r) PART[(kq * 64 + rh * 32 + i * 16 + fq * 4 + r) * 96 + c * 16 + fr] = acc[i][c][r];
    }
    LAS float* RSG = (LAS float*)(lds + 98304);
    if (tid < 64) RSG[tid] = 1.0f / sqrtf(row_sumsq(ss, np, gu * 64 + tid) * (1.0f / DM) + RMS_EPS);
    __syncthreads();
    for (int e = tid; e < 64 * 96; e += 512) { const int row = e / 96, col = e - row * 96;
        const float v = (PART[row * 96 + col] + PART[(64 + row) * 96 + col]) + (PART[(128 + row) * 96 + col] + PART[(192 + row) * 96 + col]);
        const float lg = v * RSG[row];
        Gt[(size_t)(gu * 64 + row) * NGATE + col] = fast_rcp(1.0f + fast_exp2(-lg * LOG2E)); }
    __syncthreads();
}

namespace att {
constexpr int SHM_K = 16384, SHM_V = 16384, NSLOT = 3;
constexpr int OFF_V = 0, OFF_K = NSLOT * SHM_V;
constexpr int OFF_IMP = NSLOT * (SHM_V + SHM_K);
constexpr int OFF_FIN = OFF_IMP + 8 * 32 * 33 * 4;
constexpr int OFF_SELM = OFF_FIN + 32 * 33 * 4;
constexpr int BT_NEG = 64, BT_LD = 288;
constexpr int OFF_BT = OFF_SELM + 128;
constexpr int OFF_WS = OFF_BT + 8 * BT_LD * 4;
constexpr int OFF_DONE = OFF_WS + 8 * 64 * 4;
constexpr int ATT_LDS_END = OFF_DONE + 64;
static_assert(ATT_LDS_END <= MISC_OFF, "attention LDS map");

#define KSWZ(row, colB) ((row) * 256 + ((colB) ^ (((row) & 7) << 4)))
__device__ __forceinline__ int v_st(int k, int c) { const int kk = (k & ~0xC) | ((k & 4) << 1) | ((k & 8) >> 1); return ((kk >> 3) * 4 + (c >> 5)) * 512 + ((kk & 7) * 32 + (c & 31)) * 2; }
__device__ __forceinline__ int v_rd_base(int lane) { return ((lane & 3) << 3) | (((lane >> 2) & 3) << 6) | (((lane >> 4) & 1) << 5) | (((lane >> 5) & 1) << 8); }
constexpr int v_rd_off(int d0, int ks, int half) { return d0 * 512 + ks * 4096 + half * 2048; }
__device__ __forceinline__ int crow(int r, int hi) { return (r & 3) + 8 * (r >> 2) + 4 * hi; }

struct Geo { int tid, wid, lane, r32, hi, vb0; };
__device__ __forceinline__ Geo make_geo(LAS unsigned char* lds) {
    Geo g; g.tid = tid_now(); g.wid = __builtin_amdgcn_readfirstlane(g.tid >> 6); g.lane = g.tid & 63; g.r32 = g.lane & 31; g.hi = g.lane >> 5;
    g.vb0 = (int)(uintptr_t)(lds + OFF_V) + v_rd_base(g.lane);
    return g;
}
struct DmaOff { unsigned k[2], v[2]; };
__device__ __forceinline__ DmaOff make_dma(const Geo& g, int ld) {
    DmaOff d;
#pragma unroll
    for (int i = 0; i < 2; ++i) { const int ch = g.wid + 8 * i;
        const int krow = 4 * ch + (g.lane >> 4), kc = (g.lane & 15) ^ (krow & 7);
        d.k[i] = (unsigned)(krow * ld * 2 + kc * 16);
        const int sub = 2 * ch + (g.lane >> 5), kk = 8 * (sub >> 2) + ((g.lane & 31) >> 2), key = (kk & ~0xC) | ((kk & 4) << 1) | ((kk & 8) >> 1);
        d.v[i] = (unsigned)(key * ld * 2 + ((sub & 3) * 32 + (g.lane & 3) * 8) * 2); }
    return d;
}
__device__ __forceinline__ void dma_tile(LAS unsigned char* lds, int slot, const bf16_t* Kp, const bf16_t* Vp, size_t ld, int key0, DmaOff d, const Geo& g) {
    asm volatile("" : "+v"(d.k[0]), "+v"(d.k[1]), "+v"(d.v[0]), "+v"(d.v[1]));
    const char* kb = (const char*)Kp + (size_t)key0 * ld * 2; const char* vb = (const char*)Vp + (size_t)key0 * ld * 2;
#pragma unroll
    for (int i = 0; i < 2; ++i) {
        __builtin_amdgcn_global_load_lds((const unsigned*)(kb + d.k[i]), (LAS unsigned*)(lds + OFF_K + slot * SHM_K + (g.wid + 8 * i) * 1024), 16, 0, 0);
        __builtin_amdgcn_global_load_lds((const unsigned*)(vb + d.v[i]), (LAS unsigned*)(lds + OFF_V + slot * SHM_V + (g.wid + 8 * i) * 1024), 16, 0, 0); }
}
#define WAIT_VM(n) asm volatile("s_waitcnt vmcnt(" #n ")" ::: "memory")
#define RAW_BAR() do { asm volatile("s_waitcnt lgkmcnt(0)" ::: "memory"); __builtin_amdgcn_s_barrier(); asm volatile("" ::: "memory"); } while (0)
__device__ __forceinline__ void qkt(f32x16& p0, f32x16& p1, LAS unsigned char* lds, int buf, const Geo& g, const bf16x8* qr) {
    p0 = f32x16{}; p1 = f32x16{};
    LAS unsigned char* kb[4];
#pragma unroll
    for (int dd = 0; dd < 4; ++dd) kb[dd] = lds + OFF_K + buf * SHM_K + KSWZ(g.r32, (dd * 16 + g.hi * 8) * 2);
#pragma unroll
    for (int d0 = 0; d0 < 8; ++d0) { LAS unsigned char* a = kb[d0 & 3] + (d0 >> 2) * 128;
        const bf16x8 b0 = *(const LAS bf16x8*)a, b1 = *(const LAS bf16x8*)(a + 32 * 256);
        p0 = __builtin_amdgcn_mfma_f32_32x32x16_bf16(b0, qr[d0], p0, 0, 0, 0);
        p1 = __builtin_amdgcn_mfma_f32_32x32x16_bf16(b1, qr[d0], p1, 0, 0, 0); }
    asm volatile("s_nop 7\n\ts_nop 7" : "+v"(p0), "+v"(p1));
}
__device__ __forceinline__ void pv_tile(f32x16* o, int vb, bf16x8 pa0, bf16x8 pa1, bf16x8 pa2, bf16x8 pa3) {
#define TRRD(dst, off) asm volatile("ds_read_b64_tr_b16 %0, %1 offset:%2" : "=&v"(dst) : "v"(vb), "i"(off) : "memory")
#define PV_D0(d0) do { s16x4 l0, l1, l2, l3, h0, h1, h2, h3; constexpr int b_ = v_rd_off(d0, 0, 0); \
        TRRD(l0, b_); TRRD(h0, b_ + 2048); TRRD(l1, b_ + 4096); TRRD(h1, b_ + 6144); TRRD(l2, b_ + 8192); TRRD(h2, b_ + 10240); TRRD(l3, b_ + 12288); TRRD(h3, b_ + 14336); \
        asm volatile("s_waitcnt lgkmcnt(0)" ::: "memory"); SBAR(); \
        o[d0] = __builtin_amdgcn_mfma_f32_32x32x16_bf16(pa0, (bf16x8){l0[0], l0[1], l0[2], l0[3], h0[0], h0[1], h0[2], h0[3]}, o[d0], 0, 0, 0); \
        o[d0] = __builtin_amdgcn_mfma_f32_32x32x16_bf16(pa1, (bf16x8){l1[0], l1[1], l1[2], l1[3], h1[0], h1[1], h1[2], h1[3]}, o[d0], 0, 0, 0); \
        o[d0] = __builtin_amdgcn_mfma_f32_32x32x16_bf16(pa2, (bf16x8){l2[0], l2[1], l2[2], l2[3], h2[0], h2[1], h2[2], h2[3]}, o[d0], 0, 0, 0); \
        o[d0] = __builtin_amdgcn_mfma_f32_32x32x16_bf16(pa3, (bf16x8){l3[0], l3[1], l3[2], l3[3], h3[0], h3[1], h3[2], h3[3]}, o[d0], 0, 0, 0); } while (0)
    PV_D0(0); PV_D0(1); PV_D0(2); PV_D0(3);
#undef PV_D0
#undef TRRD
}
__device__ __forceinline__ void pack_p(const f32x16& p0, const f32x16& p1, bf16x8& pa0, bf16x8& pa1, bf16x8& pa2, bf16x8& pa3) {
#define PK4(P, B_, OUT) do { unsigned a0 = cvtpk(P[B_+0], P[B_+1]), a1 = cvtpk(P[B_+2], P[B_+3]); \
        unsigned b0 = cvtpk(P[B_+4], P[B_+5]), b1 = cvtpk(P[B_+6], P[B_+7]); \
        auto r0 = __builtin_amdgcn_permlane32_swap(a0, b0, false, false); auto r1 = __builtin_amdgcn_permlane32_swap(a1, b1, false, false); \
        u32x4 w = {r0[0], r1[0], r0[1], r1[1]}; OUT = *reinterpret_cast<bf16x8*>(&w); } while (0)
    PK4(p0, 0, pa0); PK4(p0, 8, pa1); PK4(p1, 0, pa2); PK4(p1, 8, pa3);
#undef PK4
}
__device__ __forceinline__ void pair_vals(float x, float& lo, float& hi) {
    auto rr = __builtin_amdgcn_permlane32_swap(__float_as_uint(x), __float_as_uint(x), false, false);
    lo = __uint_as_float(rr[0]); hi = __uint_as_float(rr[1]);
}
__device__ __forceinline__ float pair_max(float x) { float a, b; pair_vals(x, a, b); return fmaxf(a, b); }
__device__ __forceinline__ float pair_sum(float x) { float a, b; pair_vals(x, a, b); return a + b; }

constexpr float SM_THR = 8.0f;
__device__ __forceinline__ void rescale_o(f32x16* o, float alpha, LAS float* al_l, const Geo& g) {
    if (g.hi == 0) al_l[g.r32] = alpha;
    LDS_WAIT();
#pragma unroll
    for (int r = 0; r < 16; ++r) { const float a = al_l[crow(r, g.hi)];
#pragma unroll
        for (int d = 0; d < 4; ++d) o[d][r] *= a; }
}
__device__ __forceinline__ void softmax_step(f32x16& p0, f32x16& p1, float mulc, float badd, bool ok, float& m_reg, float& l_reg, f32x16* o, LAS float* al_l, const Geo& g) {
    const float NEG = -__builtin_inff();
    float xmax = fmaxf(p0[0], p1[0]);
#pragma unroll
    for (int r = 1; r < 16; ++r) xmax = fmaxf(xmax, fmaxf(p0[r], p1[r]));
    xmax = pair_max(xmax);
    const float smax = ok ? fmaf(xmax, mulc, badd) : NEG;
    float mn = m_reg, alpha = 1.0f;
    if (!__all(smax - m_reg <= SM_THR)) { mn = fmaxf(m_reg, smax); alpha = fast_exp2(m_reg - mn); m_reg = mn; rescale_o(o, alpha, al_l, g); }
    const float addc = ok ? (badd - mn) : NEG;
    float ps = 0.f;
#pragma unroll
    for (int r = 0; r < 16; ++r) { p0[r] = fast_exp2(fmaf(p0[r], mulc, addc)); ps += p0[r]; }
#pragma unroll
    for (int r = 0; r < 16; ++r) { p1[r] = fast_exp2(fmaf(p1[r], mulc, addc)); ps += p1[r]; }
    ps = pair_sum(ps);
    l_reg = l_reg * alpha + ps;
}

struct NsaT { const bf16_t* Q; const bf16_t* KV; const bf16_t* Z; const float* Gt; const bf16_t* KC; const bf16_t* VC; bf16_t* MIX; const float* rel_bias; };

constexpr int EMIT_ROWB = 144, EMIT_TILE = 32 * EMIT_ROWB;
static_assert(8 * EMIT_TILE <= OFF_SELM - OFF_IMP, "emit tiles fit the IMP + FIN region");
__device__ __forceinline__ void silu2_mul(unsigned ov, unsigned zv, float& lo, float& hi) {
    const float z0 = bf_lo(zv), z1 = bf_hi(zv);
    lo = bf_lo(ov) * z0 * fast_rcp(1.0f + fast_exp2(-z0 * LOG2E)); hi = bf_hi(ov) * z1 * fast_rcp(1.0f + fast_exp2(-z1 * LOG2E));
}
__device__ __forceinline__ float lane_xor1(float x) { return __int_as_float(__builtin_amdgcn_update_dpp(0, __float_as_int(x), 0xB1, 0xF, 0xF, true)); }
template <bool RMW, bool SCALE>
__device__ __forceinline__ void emit_tile(LAS unsigned char* lds, const f32x16* o, float f, const bf16_t* zb  , size_t zld,
                                          bf16_t* mb  , LAS float* li_l, const Geo& g) {
    const int row = g.lane >> 1, half = g.lane & 1;
    unsigned zoff = (unsigned)(row * (int)zld + half * 32), moff = (unsigned)(row * DM + half * 32);
    asm volatile("" : "+v"(zoff), "+v"(moff));
    u32x4 zv[2][4]; u32x4 old[2][4];
#pragma unroll
    for (int c = 0; c < 2; ++c)
#pragma unroll
        for (int q = 0; q < 4; ++q) zv[c][q] = *(const u32x4*)(zb + zoff + 64 * c + q * 8);
    if (RMW) {
#pragma unroll
        for (int c = 0; c < 2; ++c)
#pragma unroll
            for (int q = 0; q < 4; ++q) { const unsigned long long* ap = (const unsigned long long*)(mb + moff + 64 * c + q * 8);
                const unsigned long long a0 = __hip_atomic_load(ap, __ATOMIC_RELAXED, __HIP_MEMORY_SCOPE_AGENT), a1 = __hip_atomic_load(ap + 1, __ATOMIC_RELAXED, __HIP_MEMORY_SCOPE_AGENT);
                old[c][q] = (u32x4){(unsigned)a0, (unsigned)(a0 >> 32), (unsigned)a1, (unsigned)(a1 >> 32)}; }
    }
    float fr[16];
    if (SCALE) { if (g.hi == 0) li_l[g.r32] = f;
        LDS_WAIT();
#pragma unroll
        for (int r = 0; r < 16; ++r) fr[r] = li_l[(r & 3) + 8 * (r >> 2) + 4 * g.hi]; }
    LAS unsigned char* T = lds + OFF_IMP + g.wid * EMIT_TILE;
    const LAS unsigned char* trow = T + row * EMIT_ROWB + half * 64;
#pragma unroll
    for (int c = 0; c < 2; ++c) {
#pragma unroll
        for (int r = 0; r < 16; ++r) { const int rc = (r & 3) + 8 * (r >> 2);
#pragma unroll
            for (int dd = 0; dd < 2; ++dd) { const float v = SCALE ? o[2 * c + dd][r] * fr[r] : o[2 * c + dd][r]; const float vn = lane_xor1(v);
                if ((g.r32 & 1) == 0) *(LAS unsigned*)(T + (rc + 4 * g.hi) * EMIT_ROWB + (dd * 32 + g.r32) * 2) = cvtpk(v, vn); } }
        LDS_WAIT();
#pragma unroll
        for (int q = 0; q < 4; ++q) { const u32x4 ov = *(const LAS u32x4*)(trow + q * 16); u32x4 w;
#pragma unroll
            for (int e = 0; e < 4; ++e) { float lo, hi; silu2_mul(ov[e], zv[c][q][e], lo, hi);
                if (RMW) { lo += bf_lo(old[c][q][e]); hi += bf_hi(old[c][q][e]); }
                w[e] = cvtpk(lo, hi); }
            *(u32x4*)(mb + moff + 64 * c + q * 8) = w; }
        asm volatile("" ::: "memory");
    }
}

template <int MODE>
__device__ __forceinline__ void tile_softmax(f32x16& p0, f32x16& p1, int kb, int t0, bool selbit, const LAS float* btw, float& m_reg, float& l_reg, f32x16* o, LAS float* al_l, const Geo& g) {
    constexpr float C2 = SM_SCALE * LOG2E; const float NEG = -__builtin_inff();
    const bool near = (kb + 63 + 128 > t0);
    const bool wedge = (MODE == 2) && (t0 + 31 - kb >= 512);
    bool ok = (MODE == 1) ? selbit : true; float mulc = C2, badd = btw[128];
    if (near) {
        const int dq = t0 + g.r32 - kb - 4 * g.hi;
        const LAS float* bp = btw + (dq - 63);
#pragma unroll
        for (int r = 0; r < 16; ++r) { const int c = (r & 3) + 8 * (r >> 2);
            float v0 = fmaf(p0[r], C2, bp[63 - c]), v1 = fmaf(p1[r], C2, bp[31 - c]);
            asm volatile("" : "+v"(v0), "+v"(v1));
            p0[r] = ok ? v0 : NEG; p1[r] = ok ? v1 : NEG; }
        mulc = 1.0f; badd = 0.f; ok = true;
    } else if (wedge) {
        const int dq = t0 + g.r32 - kb - 4 * g.hi;
#pragma unroll
        for (int r = 0; r < 16; ++r) { const int c = (r & 3) + 8 * (r >> 2);
            const unsigned d0 = (unsigned)(dq - c), d1 = (unsigned)(dq - c - 32);
            p0[r] = (d0 < 512u) ? fmaf(p0[r], C2, badd) : NEG; p1[r] = (d1 < 512u) ? fmaf(p1[r], C2, badd) : NEG; }
        mulc = 1.0f; badd = 0.f; ok = true;
    }
    softmax_step(p0, p1, mulc, badd, ok, m_reg, l_reg, o, al_l, g);
}

struct TileIter { unsigned rem; int nxt, j_hi, j, j1, j2; };
template <int MODE> __device__ __forceinline__ void ti_next(TileIter& it, int& dst) {
    if (MODE == 1) { dst = it.rem ? __builtin_ctz(it.rem) : -1; it.rem &= it.rem - 1u; } else { dst = (it.nxt <= it.j_hi) ? it.nxt : -1; ++it.nxt; } }
template <int MODE> __device__ __forceinline__ TileIter ti_init(unsigned umask, int j_lo, int j_hi) {
    TileIter it; it.rem = umask; it.nxt = j_lo; it.j_hi = j_hi; ti_next<MODE>(it, it.j); ti_next<MODE>(it, it.j1); ti_next<MODE>(it, it.j2); return it; }
__device__ __forceinline__ void branch_issue(LAS unsigned char* lds, const TileIter& it, const bf16_t* Kp, const bf16_t* Vp, size_t ld, const DmaOff& dof, const Geo& g) {
    dma_tile(lds, 0, Kp, Vp, ld, 64 * it.j, dof, g);
    if (it.j1 >= 0) dma_tile(lds, 1, Kp, Vp, ld, 64 * it.j1, dof, g);
}
template <int MODE>
__device__ __forceinline__ void branch_run(f32x16* o, float& l_out, LAS unsigned char* lds, TileIter it, const bf16_t* Kp, const bf16_t* Vp, size_t ld, const DmaOff& dof, const bf16x8* qr,
                                           unsigned selword, int t0, const LAS float* btw, LAS float* al_l, const Geo& g) {
    float m_reg = -1e30f, l_reg = 0.f;
#pragma unroll
    for (int d = 0; d < 4; ++d) o[d] = f32x16{};
    int slot = 0; bool first = true;
    for (;;) {
        if (first || it.j1 < 0) WAIT_VM(0); else WAIT_VM(4);
        first = false;
        RAW_BAR();
        if (it.j2 >= 0) dma_tile(lds, slot >= 1 ? slot - 1 : 2, Kp, Vp, ld, 64 * it.j2, dof, g);
        f32x16 p0, p1;
        qkt(p0, p1, lds, slot, g, qr);
        tile_softmax<MODE>(p0, p1, 64 * it.j, t0, ((selword >> it.j) & 1u) != 0u, btw, m_reg, l_reg, o, al_l, g);
        bf16x8 pa0, pa1, pa2, pa3; pack_p(p0, p1, pa0, pa1, pa2, pa3);
        pv_tile(o, g.vb0 + slot * SHM_V, pa0, pa1, pa2, pa3);
        if (it.j1 < 0) break;
        it.j = it.j1; it.j1 = it.j2; ti_next<MODE>(it, it.j2); slot = slot == 2 ? 0 : slot + 1;
    }
    RAW_BAR();
    l_out = l_reg;
}

__device__ __forceinline__ int t5_bucket(int d) {
    if (d < 16) return d;
    const float lr = logf((float)d / 16.0f);
    int large = 16 + (int)(lr / 2.0794415416798357f * 16.0f);
    return large < 31 ? large : 31;
}


struct NsaUnit { int b, grp, t0; };
__device__ __forceinline__ NsaUnit nsa_decode(int u) {
    const int p = u >> 1, s2 = u & 1, k = p >> 8, w = p & 255, bg = (w & 7) + 8 * k, i = ((w >> 3) + 8 * k) & 31;
    NsaUnit r; r.b = bg >> 2; r.grp = bg & 3; r.t0 = s2 ? 32 * i : 32 * (63 - i); return r; }
__device__ __forceinline__ void nsa_issue_cmp(LAS unsigned char* lds, const NsaT& A, const NsaUnit& U, const Geo& g) {
    const bf16_t* Kc = A.KC + (size_t)(U.b * NGRP + U.grp) * 128 * 128; const bf16_t* Vc = A.VC + (size_t)(U.b * NGRP + U.grp) * 128 * 128;
    const DmaOff dc = make_dma(g, 128);
    dma_tile(lds, 0, Kc, Vc, 128, 0, dc, g); dma_tile(lds, 1, Kc, Vc, 128, 64, dc, g);
}
__device__ __forceinline__ void nsa_unit(LAS unsigned char* lds, const NsaT& A, const NsaUnit U, bool build_bt) {
    const Geo g = make_geo(lds);
    __syncthreads();
    nsa_issue_cmp(lds, A, U, g);
    const int b = U.b, grp = U.grp, t0 = U.t0, h = grp * 8 + g.wid;
    LAS float* IMP = (LAS float*)(lds + OFF_IMP); LAS float* FIN = (LAS float*)(lds + OFF_FIN); LAS unsigned* SELM = (LAS unsigned*)(lds + OFF_SELM);
    LAS float* BT = (LAS float*)(lds + OFF_BT); LAS float* wsl = (LAS float*)(lds + OFF_WS) + g.wid * 64;
    const LAS float* btw = BT + g.wid * BT_LD + BT_NEG;
    float gates[3];
    { const float* gp = A.Gt + (size_t)(b * SEQ + t0) * NGATE + h + (unsigned)(g.r32 * NGATE);
#pragma unroll
      for (int br = 0; br < 3; ++br) gates[br] = gp[br * 32]; }
    bf16x8 qr[8];
    { const bf16_t* qp = A.Q + (size_t)(b * SEQ + t0) * DM + h * 128 + (unsigned)(g.r32 * DM + g.hi * 8);
#pragma unroll
      for (int d0 = 0; d0 < 8; ++d0) qr[d0] = *(const bf16x8*)(qp + d0 * 16); }
    if (build_bt) for (int e = g.tid; e < 8 * BT_LD; e += 512) { const int r = e / BT_LD, d = e - r * BT_LD - BT_NEG;
        BT[e] = d < 0 ? -__builtin_inff() : A.rel_bias[t5_bucket(d < 128 ? d : 128) * NH + grp * 8 + r] * LOG2E; }
    const bf16_t* Ks = A.KV + (size_t)(b * SEQ) * KVW + 1024 + grp * 128; const bf16_t* Vs = Ks + 512;
    const bf16_t* Kw = Ks + 1024; const bf16_t* Vw = Kw + 512;
    const DmaOff dof = make_dma(g, KVW);
    f32x16 o[4]; float l_reg;
    unsigned selword, um;
    WAIT_VM(0);
    __syncthreads();
    {
        f32x16 pA0, pA1, pB0, pB1;
        qkt(pA0, pA1, lds, 0, g, qr); qkt(pB0, pB1, lds, 1, g, qr);
        constexpr float C2 = SM_SCALE * LOG2E; const float NEG = -__builtin_inff();
        const int dbase = t0 + g.r32 - 31 - 64 * g.hi;
        float pmax = NEG;
#pragma unroll
        for (int r = 0; r < 16; ++r) { const int c = (r & 3) + 8 * (r >> 2);
#define CSC(P, NL) do { const int dist = dbase - 16 * (NL); const unsigned ud = (unsigned)dist; const float bb = btw[ud < 128u ? ud : 128u]; \
            P[r] = dist >= 0 ? fmaf(P[r], C2, bb) : NEG; pmax = fmaxf(pmax, P[r]); } while (0)
            CSC(pA0, c); CSC(pA1, c + 32); CSC(pB0, c + 64); CSC(pB1, c + 96);
#undef CSC
        }
        pmax = pair_max(pmax);
        const float mref = (pmax == NEG) ? 0.f : pmax;
        float ps = 0.f;
#pragma unroll
        for (int r = 0; r < 16; ++r) { pA0[r] = fast_exp2(pA0[r] - mref); pA1[r] = fast_exp2(pA1[r] - mref); pB0[r] = fast_exp2(pB0[r] - mref); pB1[r] = fast_exp2(pB1[r] - mref);
            ps += (pA0[r] + pA1[r]) + (pB0[r] + pB1[r]); }
        ps = pair_sum(ps);
        l_reg = ps;
        const float inv = ps > 0.f ? 1.0f / ps : 0.f;
        float qs[16], e3[16];
#pragma unroll
        for (int i = 0; i < 4; ++i) {
            qs[0 + i] = ((pA0[4 * i] + pA0[4 * i + 1]) + (pA0[4 * i + 2] + pA0[4 * i + 3])) * inv; e3[0 + i] = pA0[4 * i + 3] * inv;
            qs[4 + i] = ((pA1[4 * i] + pA1[4 * i + 1]) + (pA1[4 * i + 2] + pA1[4 * i + 3])) * inv; e3[4 + i] = pA1[4 * i + 3] * inv;
            qs[8 + i] = ((pB0[4 * i] + pB0[4 * i + 1]) + (pB0[4 * i + 2] + pB0[4 * i + 3])) * inv; e3[8 + i] = pB0[4 * i + 3] * inv;
            qs[12 + i] = ((pB1[4 * i] + pB1[4 * i + 1]) + (pB1[4 * i + 2] + pB1[4 * i + 3])) * inv; e3[12 + i] = pB1[4 * i + 3] * inv;
        }
        { LAS float* ip = IMP + (g.wid * 32 + g.r32) * 33;
          float prev_hi1 = 0.f;
#pragma unroll
          for (int idx = 0; idx < 16; ++idx) { float lo, hi1; pair_vals(e3[idx], lo, hi1);
              const float add = g.hi ? lo : prev_hi1;
              ip[2 * idx + g.hi] = qs[idx] + add; prev_hi1 = hi1; } }
        bf16x8 a0, a1, a2, a3, c0, c1, c2, c3;
        pack_p(pA0, pA1, a0, a1, a2, a3); pack_p(pB0, pB1, c0, c1, c2, c3);
#pragma unroll
        for (int d = 0; d < 4; ++d) o[d] = f32x16{};
        pv_tile(o, g.vb0, a0, a1, a2, a3); pv_tile(o, g.vb0 + SHM_V, c0, c1, c2, c3);
    }
    LDS_WAIT();
    __syncthreads();
    dma_tile(lds, 0, Ks, Vs, KVW, 0, dof, g);
    {
        const int tl = g.tid >> 4, j0 = (g.tid & 15) * 2, tok = t0 + tl, cur = tok >> 6;
        float v2[2];
#pragma unroll
        for (int e = 0; e < 2; ++e) { const int j = j0 + e; float v = 0.f;
#pragma unroll
            for (int r = 0; r < 8; ++r) v += IMP[(r * 32 + tl) * 33 + j];
            const bool forced = (j == 0) || (j == cur) || (j == cur - 1), valid = (64 * j <= tok);
            v = forced ? 1.0e6f : (valid ? v : -1.0f); v2[e] = v; FIN[tl * 33 + j] = v; }
        LDS_WAIT();
        __syncthreads();
        unsigned bits = 0u;
#pragma unroll
        for (int e = 0; e < 2; ++e) { const int j = j0 + e; int cnt = 0;
#pragma unroll
            for (int i = 0; i < 32; ++i) { const float w = FIN[tl * 33 + i]; cnt += (w > v2[e] || (w == v2[e] && i < j)) ? 1 : 0; }
            if (cnt < 16) bits |= 1u << j; }
        bits |= (unsigned)__builtin_amdgcn_update_dpp(0, (int)bits, 0xB1, 0xF, 0xF, true);
        bits |= (unsigned)__builtin_amdgcn_update_dpp(0, (int)bits, 0x4E, 0xF, 0xF, true);
        bits |= (unsigned)__builtin_amdgcn_update_dpp(0, (int)bits, 0x141, 0xF, 0xF, true);
        bits |= (unsigned)__builtin_amdgcn_update_dpp(0, (int)bits, 0x140, 0xF, 0xF, true);
        if ((g.tid & 15) == 0) SELM[tl] = bits;
        LDS_WAIT();
        __syncthreads();
        selword = SELM[g.r32]; um = selword;
        um |= __shfl_xor(um, 1); um |= __shfl_xor(um, 2); um |= __shfl_xor(um, 4); um |= __shfl_xor(um, 8); um |= __shfl_xor(um, 16);
        const int jmax = (t0 + 31) >> 6;
        um = __builtin_amdgcn_readfirstlane(um) & (jmax >= 31 ? 0xffffffffu : ((2u << jmax) - 1u));
    }
    TileIter its = ti_init<1>(um, 0, 0);
    if (its.j1 >= 0) dma_tile(lds, 1, Ks, Vs, KVW, 64 * its.j1, dof, g);
    const bf16_t* zb = A.Z + (size_t)(b * SEQ + t0) * ZW + h * 128;
    bf16_t* mb = A.MIX + (size_t)(b * SEQ + t0) * DM + h * 128;
    emit_tile<false, true>(lds, o, (l_reg > 0.f ? 1.0f / l_reg : 0.f) * gates[0], zb, ZW, mb, wsl, g);
    branch_run<1>(o, l_reg, lds, its, Ks, Vs, KVW, dof, qr, selword, t0, btw, wsl + 32, g);
    const int lowk = t0 - 511;
    TileIter itw = ti_init<2>(0u, lowk > 0 ? lowk >> 6 : 0, (t0 + 31) >> 6);
    branch_issue(lds, itw, Kw, Vw, KVW, dof, g);
    emit_tile<true, true>(lds, o, (1.0f / l_reg) * gates[1], zb + 4096, ZW, mb, wsl, g);
    branch_run<2>(o, l_reg, lds, itw, Kw, Vw, KVW, dof, qr, 0u, t0, btw, wsl + 32, g);
    emit_tile<true, true>(lds, o, (1.0f / l_reg) * gates[2], zb + 8192, ZW, mb, wsl, g);
}
__device__ __forceinline__ void nsa_phase(LAS unsigned char* lds, const NsaT& A) {
    const int G = gridDim.x, first = 2 * (int)blockIdx.x;
    if (first >= 2048) return;
    int prev_grp = -1;
#pragma unroll 1
    for (int u = first; u < 2048; u = (u & 1) ? u + 2 * G - 1 : u + 1) {
        const NsaUnit U = nsa_decode(u);
        nsa_unit(lds, A, U, U.grp != prev_grp);
        prev_grp = U.grp;
    }
    VM_WAIT();
    __syncthreads();
}

constexpr bool SB_EARLY_EXIT = true;
constexpr float SB_PCUT = 1.0e-37f;
struct SbT { const bf16_t* QZ; const bf16_t* KVSH; bf16_t* MIX; };
struct SbUnit { int b, h, qb; };
__device__ __forceinline__ SbUnit sb_decode(int u) {
    const int p = u >> 1, s2 = u & 1, k = p >> 8, w = p & 255, bh = k * 64 + (w & 7) * 8 + (w >> 5), pi = ((w >> 3) + k) & 3;
    SbUnit r; r.b = bh >> 5; r.h = bh & 31; r.qb = s2 ? pi : 7 - pi; return r; }
__device__ __forceinline__ void sb_issue(LAS unsigned char* lds, const SbT& A, const SbUnit& U, const Geo& g) {
    const bf16_t* Kp = A.KVSH + (size_t)(U.b * SEQ) * 8192 + U.h * 128; const bf16_t* Vp = Kp + 4096;
    const DmaOff dof = make_dma(g, 8192); const int j = 4 * U.qb + 3;
    dma_tile(lds, 0, Kp, Vp, 8192, 64 * j, dof, g); dma_tile(lds, 1, Kp, Vp, 8192, 64 * (j - 1), dof, g);
}
__device__ __forceinline__ void sb_unit(LAS unsigned char* lds, const SbT& A, const SbUnit U, bool has_next, const SbUnit UN) {
    const Geo g = make_geo(lds);
    const int b = U.b, h = U.h, qb = U.qb;
    LAS unsigned* DONE = (LAS unsigned*)(lds + OFF_DONE);
    const int tw0 = qb * 256 + g.wid * 32, t = tw0 + g.r32;
    bf16x8 qr[8];
    { const bf16_t* qp = A.QZ + (size_t)(b * SEQ + tw0) * 8192 + h * 128 + (unsigned)(g.r32 * 8192 + g.hi * 8);
#pragma unroll
      for (int d0 = 0; d0 < 8; ++d0) qr[d0] = *(const bf16x8*)(qp + d0 * 16); }
    const bf16_t* Kp = A.KVSH + (size_t)(b * SEQ) * 8192 + h * 128; const bf16_t* Vp = Kp + 4096;
    f32x16 o[4];
#pragma unroll
    for (int d = 0; d < 4; ++d) o[d] = f32x16{};
    float PR = 1.0f; bool wdone = false;
    const DmaOff dof = make_dma(g, 8192);
    int j = 4 * qb + 3, bank = 0, slot = 0;
    for (int step = 0;; ++step) {
        if (step > 0 && j >= 1) WAIT_VM(4); else WAIT_VM(0);
        RAW_BAR();
        if (SB_EARLY_EXIT && step > 0) { unsigned all = 1u;
#pragma unroll
            for (int w = 0; w < 8; ++w) all &= DONE[bank * 8 + w];
            bank ^= 1;
            if (__builtin_amdgcn_readfirstlane(all)) break; }
        if (j >= 2) dma_tile(lds, slot >= 1 ? slot - 1 : 2, Kp, Vp, 8192, 64 * (j - 2), dof, g);
        const int kb = 64 * j;
        const bool active = (kb <= tw0 + 30) && !wdone;
        if (active) {
            f32x16 p0, p1;
            qkt(p0, p1, lds, slot, g, qr);
            const bool needmask = (kb + 63 >= tw0);
            const int dq = t - kb - 4 * g.hi;
            constexpr float ZS = SM_SCALE * LOG2E;
            float rr0[16], rr1[16];
#pragma unroll
            for (int r = 0; r < 16; ++r) { const int c = (r & 3) + 8 * (r >> 2);
                float e0 = fast_exp2(fminf(p0[r] * ZS, 64.0f)), e1 = fast_exp2(fminf(p1[r] * ZS, 64.0f));
                if (needmask) { e0 = (dq - c > 0) ? e0 : 0.f; e1 = (dq - c - 32 > 0) ? e1 : 0.f; }
                p0[r] = e0; p1[r] = e1; rr0[r] = fast_rcp(1.0f + e0); rr1[r] = fast_rcp(1.0f + e1); }
            float tot[8];
#pragma unroll
            for (int i = 0; i < 4; ++i) {
                rr0[4 * i + 2] *= rr0[4 * i + 3]; rr0[4 * i + 1] *= rr0[4 * i + 2]; rr0[4 * i] *= rr0[4 * i + 1]; tot[i] = rr0[4 * i];
                rr1[4 * i + 2] *= rr1[4 * i + 3]; rr1[4 * i + 1] *= rr1[4 * i + 2]; rr1[4 * i] *= rr1[4 * i + 1]; tot[4 + i] = rr1[4 * i];
            }
            float off[8]; float suf = PR;
#pragma unroll
            for (int idx = 7; idx >= 0; --idx) { float t0_, t1_; pair_vals(tot[idx], t0_, t1_);
                const float oh1 = suf; suf *= t1_; const float oh0 = suf; suf *= t0_; off[idx] = g.hi ? oh1 : oh0; }
            PR = suf;
#pragma unroll
            for (int r = 0; r < 16; ++r) { p0[r] *= rr0[r] * off[r >> 2]; p1[r] *= rr1[r] * off[4 + (r >> 2)]; }
            bf16x8 pa0, pa1, pa2, pa3; pack_p(p0, p1, pa0, pa1, pa2, pa3);
            pv_tile(o, g.vb0 + slot * SHM_V, pa0, pa1, pa2, pa3);
            if (SB_EARLY_EXIT) wdone = __all(PR < SB_PCUT);
        }
        if (SB_EARLY_EXIT && g.lane == 0) DONE[bank * 8 + g.wid] = wdone ? 1u : 0u;
        if (j == 0) break;
        --j; slot = slot == 2 ? 0 : slot + 1;
    }
    WAIT_VM(0);
    RAW_BAR();
    if (has_next) sb_issue(lds, A, UN, g);
    emit_tile<false, false>(lds, o, 1.0f, A.QZ + (size_t)(b * SEQ + tw0) * 8192 + 4096 + h * 128, 8192, A.MIX + (size_t)(b * SEQ + tw0) * DM + h * 128, (LAS float*)(lds + OFF_WS), g);
}
__device__ __forceinline__ void sb_phase(LAS unsigned char* lds, const SbT& A) {
    const int G = gridDim.x, first = 2 * (int)blockIdx.x;
    if (first >= 2048) return;
    { const Geo g = make_geo(lds); sb_issue(lds, A, sb_decode(first), g); }
#pragma unroll 1
    for (int u = first; u < 2048; u = (u & 1) ? u + 2 * G - 1 : u + 1) {
        const int un = (u & 1) ? u + 2 * G - 1 : u + 1; const bool has_next = un < 2048;
        sb_unit(lds, A, sb_decode(u), has_next, sb_decode(has_next ? un : u));
    }
    VM_WAIT();
    __syncthreads();
}
}

constexpr int NPHASES = 16;
__global__ void __launch_bounds__(512, 2) yoco_fwd(Params P) {
    extern __shared__ __attribute__((aligned(16))) unsigned char lds_raw[];
    LAS unsigned char* lds = (LAS unsigned char*)lds_raw;
    const int G = gridDim.x;
    volatile LAS unsigned* MISC = (volatile LAS unsigned*)(lds + MISC_OFF);
    { const int t0_ = tid_now(); if (t0_ < 64) MISC[t0_] = 0u; }
    __syncthreads();
    unsigned char* ws = P.ws;
    XcdBarrier bar = xcd_barrier_post((unsigned*)(ws + WS_CTL), MISC + 8);
    const int lo = P.ph_lo, hi = P.ph_hi;
#define IN(k) (lo <= (k) && (k) < hi)
#define SEAM(k) do { if (IN(k) && IN((k) + 1)) xcd_barrier(bar); } while (0)
    bf16_t* HN = (bf16_t*)(ws + WS_HN); bf16_t* XB = (bf16_t*)(ws + WS_XB); float* SS = (float*)(ws + WS_SS); float* SSP = (float*)(ws + WS_SSP);

    if (IN(0)) phase_prologue(P, lds);
    SEAM(0);

#pragma unroll
    for (int l = 0; l < 2; ++l) {
        const int pb = 1 + 4 * l;
        if (IN(pb)) {
            pg8::Gemm g{XB, (const bf16_t*)(ws + WS_WAIN + l * WAIN_BYTES), MTOK, NSA_N, DM}; pg8::StaticOrder S; S.init(MTOK, NSA_N, G, (int)blockIdx.x);
            const int fm = 8 * ((int)blockIdx.x & 7); LAS float* RS = (LAS float*)(lds + 131072);
            const float* ssrc = l == 0 ? SS : SSP; const int np = l == 0 ? 1 : SS_NP;
            { const int i4 = tid_now() * 4; f32x4 s4 = {0.f, 0.f, 0.f, 0.f};
#pragma unroll 8
              for (int p = 0; p < np; ++p) s4 += *(const f32x4*)(ssrc + (size_t)p * MTOK + fm * 256 + i4);
#pragma unroll
              for (int k = 0; k < 4; ++k) RS[i4 + k] = 1.0f / sqrtf(s4[k] * (1.0f / DM) + RMS_EPS); }
            __syncthreads();
            pg8::EpiSplit E{(bf16_t*)(ws + WS_Q), DM, 16, (bf16_t*)(ws + WS_KV), KVW, 28, (bf16_t*)(ws + WS_Z), ZW, ssrc, RS, fm, np};
            pg8::gemm_phase<pg8::EpiSplit, pg8::StaticOrder, true, true>(lds, g, S, E);
        }
        SEAM(pb);
        if (IN(pb + 1)) {
            for (int u = blockIdx.x; u < 256; u += G) { compress_unit(P, l, u, lds); gate_unit(P, l, u, lds); }
        }
        SEAM(pb + 1);
        if (IN(pb + 2)) {
            att::NsaT A{(const bf16_t*)(ws + WS_Q), (const bf16_t*)(ws + WS_KV), (const bf16_t*)(ws + WS_Z), (const float*)(ws + WS_G),
                        (const bf16_t*)(ws + WS_KC), (const bf16_t*)(ws + WS_VC), HN, P.in[1]};
            att::nsa_phase(lds, A);
        }
        SEAM(pb + 2);
        if (IN(pb + 3)) {
            pg8::Gemm g{HN, (const bf16_t*)(ws + WS_WAOUT + l * WOUT_BYTES), MTOK, DM, DM}; pg8::StaticOrder S; S.init(MTOK, DM, G, (int)blockIdx.x);
            pg8::EpiRes E{XB, P.out, DM, SSP, 0};
            pg8::gemm_phase<pg8::EpiRes, pg8::StaticOrder, true, true>(lds, g, S, E);
        }
        SEAM(pb + 3);
    }

#pragma unroll
    for (int l = 2; l < 4; ++l) {
        const int pb = 9 + 3 * (l - 2);
        if (IN(pb)) {
            const int N = (l == 2) ? 16384 : 8192;
            pg8::Gemm g{XB, (const bf16_t*)(ws + (l == 2 ? WS_WKVQ : WS_WB3)), MTOK, N, DM}; pg8::StaticOrder S; S.init(MTOK, N, G, (int)blockIdx.x);
            const int fm = 8 * ((int)blockIdx.x & 7); LAS float* RS = (LAS float*)(lds + 131072);
            const float* ssrc = SSP; const int np = SS_NP;
            { const int i4 = tid_now() * 4; f32x4 s4 = {0.f, 0.f, 0.f, 0.f};
#pragma unroll 8
              for (int p = 0; p < np; ++p) s4 += *(const f32x4*)(ssrc + (size_t)p * MTOK + fm * 256 + i4);
#pragma unroll
              for (int k = 0; k < 4; ++k) RS[i4 + k] = 1.0f / sqrtf(s4[k] * (1.0f / DM) + RMS_EPS); }
            __syncthreads();
            pg8::EpiSplit E{(bf16_t*)(ws + (l == 2 ? WS_KVSH : WS_QZ)), 8192, 32, (bf16_t*)(ws + WS_QZ), 8192, 1 << 20, nullptr, 0, ssrc, RS, fm, np};
            pg8::gemm_phase<pg8::EpiSplit, pg8::StaticOrder, true, true>(lds, g, S, E);
        }
        SEAM(pb);
        if (IN(pb + 1)) {
            att::SbT A{(const bf16_t*)(ws + WS_QZ), (const bf16_t*)(ws + WS_KVSH), HN};
            att::sb_phase(lds, A);
        }
        SEAM(pb + 1);
        if (IN(pb + 2)) {
            pg8::Gemm g{HN, (const bf16_t*)(ws + WS_WBOUT + (l - 2) * WOUT_BYTES), MTOK, DM, DM}; pg8::StaticOrder S; S.init(MTOK, DM, G, (int)blockIdx.x);
            pg8::EpiRes E{XB, P.out, DM, SSP, 0};
            pg8::gemm_phase<pg8::EpiRes, pg8::StaticOrder, true, true>(lds, g, S, E);
        }
        SEAM(pb + 2);
    }
    if (IN(15)) phase_final_norm(XB, P.out, P.in[26], SSP, lds);
#undef IN
#undef SEAM
}

extern "C" void kernel_launch(void* const* d_in, const int* in_sizes, int n_in, void* d_out, int out_size, void* d_ws, size_t ws_size, hipStream_t stream) {
    static int grid = 0;
    if (grid == 0) {
        if (n_in != 27 || out_size != MTOK * DM || ws_size < WS_END) { fprintf(stderr, "kernel_launch: unexpected shapes (n_in %d, out %d, ws %zu < %zu)\n", n_in, out_size, ws_size, (size_t)WS_END); grid = -1; return; }
        int dev = 0, cus = 0, per_cu = 0;
        if (hipGetDevice(&dev) != hipSuccess || hipDeviceGetAttribute(&cus, hipDeviceAttributeMultiprocessorCount, dev) != hipSuccess || cus <= 0) { grid = -1; return; }
        if (hipFuncSetAttribute((const void*)yoco_fwd, hipFuncAttributeMaxDynamicSharedMemorySize, LDS_BYTES) != hipSuccess) { fprintf(stderr, "kernel_launch: hipFuncSetAttribute failed\n"); grid = -1; return; }
        if (hipOccupancyMaxActiveBlocksPerMultiprocessor(&per_cu, (const void*)yoco_fwd, 512, LDS_BYTES) != hipSuccess || per_cu < 1) { fprintf(stderr, "kernel_launch: occupancy query says %d\n", per_cu); }
        (void)hipGetLastError();
        grid = cus;
    }
    if (grid < 0) return;
    (void)hipMemsetAsync((char*)d_ws + WS_CTL, 0, CTL_ZERO_BYTES, stream);
    Params p{};
    for (int i = 0; i < 27; ++i) p.in[i] = (const float*)d_in[i];
    p.out = (float*)d_out; p.ws = (unsigned char*)d_ws;
    p.ph_lo = 0; p.ph_hi = NPHASES;
    hipLaunchKernelGGL(yoco_fwd, dim3(grid), dim3(512), LDS_BYTES, stream, p);
}
```

```cpp
#include <hip/hip_runtime.h>
#include <cstdio>
#include <cstdint>

#define LAS __attribute__((address_space(3)))
#define GAS __attribute__((address_space(1)))
typedef unsigned short bf16_t;
typedef short bf16x8 __attribute__((ext_vector_type(8)));
typedef short s16x4 __attribute__((ext_vector_type(4)));
typedef float f32x4 __attribute__((ext_vector_type(4)));
typedef float f32x16 __attribute__((ext_vector_type(16)));
typedef unsigned u32x4 __attribute__((ext_vector_type(4)));
typedef unsigned u32x2 __attribute__((ext_vector_type(2)));

constexpr int BATCH = 8, SEQ = 2048, DM = 4096, NH = 32, HD = 128, NGRP = 4, GSZ = 8;
constexpr int MTOK = BATCH * SEQ;
constexpr int NSA_N = 19456;
constexpr int KVW = 3072, ZW = 12288, NGATE = 96;
constexpr int NCMP = 127;
constexpr float RMS_EPS = 1e-6f;
constexpr float SM_SCALE = 0.08838834764831845f;
constexpr float LOG2E = 1.4426950408889634f;
constexpr float LN2 = 0.6931471805599453f;

constexpr size_t MiB = 1u << 20;
constexpr size_t WS_CTL = 0, CTL_ZERO_BYTES = 512 * 1024;
constexpr size_t WS_SS = 64 * 1024;
constexpr size_t WS_C1 = 1 * MiB;
constexpr size_t WS_KC = 2 * MiB;
constexpr size_t WS_VC = 3 * MiB;
constexpr size_t WS_W2T = 4 * MiB;
constexpr size_t WS_W1T = 8 * MiB;
constexpr size_t WS_SSP = 12 * MiB;
constexpr int SS_NP = 64;
constexpr size_t WS_WG = 16 * MiB;
constexpr size_t WS_WAIN = 20 * MiB;
constexpr size_t WAIN_BYTES = (size_t)NSA_N * DM * 2;
constexpr size_t WS_WAOUT = WS_WAIN + 2 * WAIN_BYTES;
constexpr size_t WOUT_BYTES = (size_t)DM * DM * 2;
constexpr size_t WS_WKVQ = WS_WAOUT + 2 * WOUT_BYTES;
constexpr size_t WS_WB3 = WS_WKVQ + (size_t)16384 * DM * 2;
constexpr size_t WS_WBOUT = WS_WB3 + (size_t)8192 * DM * 2;
constexpr size_t WS_HN = WS_WBOUT + 2 * WOUT_BYTES;
constexpr size_t WS_PROJ = WS_HN + (size_t)MTOK * DM * 2;
constexpr size_t WS_Q = WS_PROJ;
constexpr size_t WS_KV = WS_Q + (size_t)MTOK * DM * 2;
constexpr size_t WS_Z = WS_KV + (size_t)MTOK * KVW * 2;
constexpr size_t WS_G = WS_Z + (size_t)MTOK * ZW * 2;
constexpr size_t WS_KVSH = WS_PROJ;
constexpr size_t WS_QZ = WS_KVSH + (size_t)MTOK * 8192 * 2;
constexpr size_t WS_XB = WS_G + (size_t)MTOK * NGATE * 4;
constexpr size_t WS_END = WS_XB + (size_t)MTOK * DM * 2;
static_assert(WS_END <= (size_t)1515 * MiB, "d_ws map must fit the guaranteed workspace (sum of inputs = 1515 MiB)");
static_assert(WS_QZ + (size_t)MTOK * 8192 * 2 <= WS_XB, "SB overlay");
static_assert(WS_SS + 5 * 16384 * 4 <= CTL_ZERO_BYTES, "SS inside the memset region");

constexpr int LDS_BYTES = 147456;
constexpr int MISC_OFF = LDS_BYTES - 256;

__device__ __forceinline__ float row_sumsq(const float* ss, int np, int row) {
    float s = 0.f;
#pragma unroll 8
    for (int p = 0; p < np; ++p) s += ss[(size_t)p * MTOK + row];
    return s;
}
namespace pg8 {
#define PG8_LAS __attribute__((address_space(3)))
typedef unsigned short bf16_t;
typedef short bf16x8 __attribute__((ext_vector_type(8)));
typedef float f32x4 __attribute__((ext_vector_type(4)));
typedef unsigned u32x4 __attribute__((ext_vector_type(4)));
constexpr int BM = 256, BK = 64, HALF = 128, HTB = HALF * BK * 2  , STAGE_BYTES = 8 * HTB, NXCD = 8, WGM = 8;

__host__ __device__ __forceinline__ int lds_byte(int r, int c) { const int st = (r >> 4) * 2 + (c >> 5), rr = r & 15, cc = c & 31, ob = rr * 64 + cc * 2; return st * 1024 + (ob ^ (((ob >> 9) & 1) << 5)); }
__host__ __device__ __forceinline__ void stage_rc(int b, int& R, int& C) { const int st = b / 1024, sb = b % 1024, swz = sb ^ (((sb >> 9) & 1) << 5); R = (st >> 1) * 16 + swz / 64; C = (st & 1) * 32 + (swz % 64) / 2; }
__host__ __device__ __forceinline__ int perm32(int rho) { const int n = rho >> 4, i = rho & 15; return 8 * (i >> 2) + 4 * n + (i & 3); }

struct Unit { int pm, pn; };
struct Gemm { const bf16_t* A; const bf16_t* Bt; int M, N, K; };

struct StaticOrder {
    int nM, nN, nwg, G, c;
    __host__ __device__ void init(int M, int N, int G_, int c_) { nM = M / BM; nN = N / BM; nwg = nM * nN; G = G_; c = c_; }
    __host__ __device__ bool next(int i, Unit& u) const {
        const long L = (long)i * G + c; if (L >= nwg) return false;
        int wgid = (int)L; { const int q = nwg / NXCD, r = nwg % NXCD, xcd = wgid % NXCD, off = wgid / NXCD; wgid = (xcd < r ? xcd * (q + 1) : r * (q + 1) + (xcd - r) * q) + off; }
        const int nig = WGM * nN, gid = wgid / nig, fm = gid * WGM, gsz = (nM - fm) < WGM ? (nM - fm) : WGM;
        u.pm = fm + ((wgid % nig) % gsz); u.pn = (wgid % nig) / gsz; return true;
    }
    __device__ __forceinline__ void a_ready(const Unit&) const {}
    __device__ __forceinline__ void done(const Unit&) const {}
};


__device__ __forceinline__ unsigned cvt_pk_bf16(float lo, float hi) { unsigned r; asm volatile("v_cvt_pk_bf16_f32 %0, %1, %2" : "=v"(r) : "v"(lo), "v"(hi)); return r; }

struct EpiSplit {
    static constexpr bool PERM = true, AFTER_DRAIN = false;
    bf16_t* O0; int ld0; int t1; bf16_t* O1; int ld1; int t2; bf16_t* O2; int ld2; const float* ss; const PG8_LAS float* rs_lds; int fm; int np;
    __device__ __forceinline__ void operator()(const f32x4 (&acc)[2][2][4][2], const Unit& u, int wr, int wc, int fr, int fq) const {
        const int row0 = u.pm * BM + wr * 64 + fr;
        bf16_t* base; int ldc, ct;
        if (u.pn < t1) { base = O0; ldc = ld0; ct = u.pn; } else if (u.pn < t2) { base = O1; ldc = ld1; ct = u.pn - t1; } else { base = O2; ldc = ld2; ct = u.pn - t2; }
        const int col0 = ct * BM + wc * 32 + 8 * fq;
#pragma unroll
        for (int ai = 0; ai < 2; ++ai)
#pragma unroll
            for (int m = 0; m < 4; ++m) { bf16_t* rowp = base + (size_t)(row0 + ai * HALF + m * 16) * ldc + col0;
                const unsigned pl = (unsigned)(u.pm - fm);
                const float rs = pl < 8u ? rs_lds[pl * BM + wr * 64 + fr + ai * HALF + m * 16] : 1.0f / sqrtf(row_sumsq(ss, np, row0 + ai * HALF + m * 16) * (1.0f / 4096.0f) + 1e-6f);
#pragma unroll
                for (int bj = 0; bj < 2; ++bj) { const f32x4 v0 = acc[ai][bj][m][0] * rs, v1 = acc[ai][bj][m][1] * rs;
                    u32x4 w; w.x = cvt_pk_bf16(v0[0], v0[1]); w.y = cvt_pk_bf16(v0[2], v0[3]); w.z = cvt_pk_bf16(v1[0], v1[1]); w.w = cvt_pk_bf16(v1[2], v1[3]);
                    *(u32x4*)(rowp + bj * HALF) = w; } }
    }
};
struct EpiRes {
    static constexpr bool PERM = true, AFTER_DRAIN = false;
    bf16_t* xb; float* out; int ldc; float* ssp; int last;
    __device__ __forceinline__ void operator()(const f32x4 (&acc)[2][2][4][2], const Unit& u, int wr, int wc, int fr, int fq) const {
        const int row0 = u.pm * BM + wr * 64 + fr, col0 = u.pn * BM + wc * 32 + 8 * fq;
        float* sp = ssp + (size_t)(u.pn * 4 + wc) * MTOK;
        u32x4 r[2][4][2];
#pragma unroll
        for (int ai = 0; ai < 2; ++ai)
#pragma unroll
            for (int m = 0; m < 4; ++m) { const size_t off = (size_t)(row0 + ai * HALF + m * 16) * ldc + col0;
#pragma unroll
                for (int bj = 0; bj < 2; ++bj) r[ai][m][bj] = *(const u32x4*)(xb + off + bj * HALF); }
#pragma unroll
        for (int ai = 0; ai < 2; ++ai) {
#pragma unroll
            for (int m = 0; m < 4; ++m) { const size_t off = (size_t)(row0 + ai * HALF + m * 16) * ldc + col0;
                float sq = 0.f;
#pragma unroll
                for (int bj = 0; bj < 2; ++bj) { const u32x4 rv = r[ai][m][bj];
                    const f32x4 o0 = (f32x4){__uint_as_float(rv.x << 16), __uint_as_float(rv.x & 0xffff0000u), __uint_as_float(rv.y << 16), __uint_as_float(rv.y & 0xffff0000u)} + acc[ai][bj][m][0];
                    const f32x4 o1 = (f32x4){__uint_as_float(rv.z << 16), __uint_as_float(rv.z & 0xffff0000u), __uint_as_float(rv.w << 16), __uint_as_float(rv.w & 0xffff0000u)} + acc[ai][bj][m][1];
                    sq += ((o0[0] * o0[0] + o0[1] * o0[1]) + (o0[2] * o0[2] + o0[3] * o0[3])) + ((o1[0] * o1[0] + o1[1] * o1[1]) + (o1[2] * o1[2] + o1[3] * o1[3]));
                    if (last) { *(f32x4*)(out + off + bj * HALF) = o0; *(f32x4*)(out + off + bj * HALF + 4) = o1; }
                    else { u32x4 w; w.x = cvt_pk_bf16(o0[0], o0[1]); w.y = cvt_pk_bf16(o0[2], o0[3]); w.z = cvt_pk_bf16(o1[0], o1[1]); w.w = cvt_pk_bf16(o1[2], o1[3]); *(u32x4*)(xb + off + bj * HALF) = w; } }
                sq += __shfl_xor(sq, 16); sq += __shfl_xor(sq, 32);
                if (fq == 0) sp[row0 + ai * HALF + m * 16] = sq; }
            asm volatile("" ::: "memory");
        }
    }
};
template <class Epi, class Sched, bool ALIGN_EPI = false, bool SP2 = false>
__device__ __forceinline__ void gemm_phase(PG8_LAS unsigned char* lds, const Gemm g, const Sched& S, const Epi& E) {
    int tid_ = (int)threadIdx.x; asm volatile("" : "+v"(tid_));
    const int tid = tid_, wid = __builtin_amdgcn_readfirstlane(tid >> 6), lane = tid & 63, wr = wid >> 2, wc = wid & 3, fr = lane & 15, fq = lane >> 4;
    const int K = g.K, nt = K / BK;
    unsigned voffA[2], voffB[2];
#pragma unroll
    for (int i = 0; i < 2; ++i) { int R, C; stage_rc(tid * 16 + i * 8192, R, C); const int Rb = Epi::PERM ? ((R & ~31) + perm32(R & 31)) : R;
        voffA[i] = (unsigned)(R * K + C) * 2u; voffB[i] = (unsigned)(Rb * K + C) * 2u; }
    asm volatile("" : "+v"(voffA[0]), "+v"(voffA[1]), "+v"(voffB[0]), "+v"(voffB[1]));
    const size_t kstep = (size_t)(BK * 2);
    const size_t hstep = (size_t)HALF * K * 2;
    const size_t tstep = 2 * hstep;
    const unsigned ldsw = (unsigned)wid * 1024u;
    const int aoff = lds_byte(wr * 64 + fr, fq * 8), boff = lds_byte(wc * 32 + fr, fq * 8);
#define PG8_SA(b, h) (((b) * 2 + (h)) * HTB)
#define PG8_SB(b, h) ((4 + (b) * 2 + (h)) * HTB)
#define PG8_STAGE(bufoff, gbase, voff) do { _Pragma("unroll") for (int _i = 0; _i < 2; ++_i) \
        __builtin_amdgcn_global_load_lds((const unsigned*)((const char*)(gbase) + (voff)[_i]), (PG8_LAS unsigned*)(lds + (bufoff) + ldsw + _i * 8192), 16, 0, 0); } while (0)
#define PG8_LDA(dst, b, h) do { _Pragma("unroll") for (int m = 0; m < 4; ++m) _Pragma("unroll") for (int k = 0; k < 2; ++k) dst[m][k] = *(const PG8_LAS bf16x8*)(lds + PG8_SA(b, h) + aoff + m * 2048 + k * 1024); } while (0)
#define PG8_LDB(dst, b, h) do { _Pragma("unroll") for (int n = 0; n < 2; ++n) _Pragma("unroll") for (int k = 0; k < 2; ++k) dst[n][k] = *(const PG8_LAS bf16x8*)(lds + PG8_SB(b, h) + boff + n * 2048 + k * 1024); } while (0)
#define PG8_MMA(ai, bj, At, Bt) do { __builtin_amdgcn_s_setprio(1); _Pragma("unroll") for (int m = 0; m < 4; ++m) _Pragma("unroll") for (int n = 0; n < 2; ++n) _Pragma("unroll") for (int k = 0; k < 2; ++k) \
        acc[ai][bj][m][n] = __builtin_amdgcn_mfma_f32_16x16x32_bf16(Bt[n][k], At[m][k], acc[ai][bj][m][n], 0, 0, 0); __builtin_amdgcn_s_setprio(0); } while (0)
#define PG8_WAIT_V(n) asm volatile("s_waitcnt vmcnt(" #n ")" ::: "memory")
#define PG8_WAIT_L(n) asm volatile("s_waitcnt lgkmcnt(" #n ")" ::: "memory")
#define PG8_BAR __builtin_amdgcn_s_barrier()
#define PG8_SCHED __builtin_amdgcn_sched_barrier(0)
    Unit cur, nxt; int ui = 0;
    if (!S.next(0, cur)) return;
    f32x4 acc[2][2][4][2];
#pragma unroll
    for (int a = 0; a < 2; ++a)
#pragma unroll
        for (int b = 0; b < 2; ++b)
#pragma unroll
            for (int m = 0; m < 4; ++m)
#pragma unroll
                for (int n = 0; n < 2; ++n) acc[a][b][m][n] = (f32x4){0.f, 0.f, 0.f, 0.f};
    bf16x8 At[4][2], B0[2][2], B1[2][2];
    const char* cA = (const char*)g.A + (size_t)cur.pm * tstep; const char* cB = (const char*)g.Bt + (size_t)cur.pn * tstep;
    S.a_ready(cur);
    if constexpr (SP2) {
        PG8_STAGE(PG8_SB(0, 0), cB, voffB); PG8_STAGE(PG8_SB(0, 1), cB + hstep, voffB); PG8_STAGE(PG8_SA(0, 0), cA, voffA); PG8_STAGE(PG8_SA(0, 1), cA + hstep, voffA);
        if (wr == 1) PG8_BAR;
        PG8_WAIT_V(2); PG8_BAR;
        PG8_STAGE(PG8_SB(1, 0), cB + kstep, voffB); PG8_STAGE(PG8_SA(1, 0), cA + kstep, voffA); PG8_STAGE(PG8_SB(1, 1), cB + hstep + kstep, voffB);
        PG8_WAIT_V(6); PG8_BAR;
    } else {
        PG8_STAGE(PG8_SB(0, 0), cB, voffB); PG8_STAGE(PG8_SA(0, 0), cA, voffA); PG8_STAGE(PG8_SB(0, 1), cB + hstep, voffB); PG8_STAGE(PG8_SA(0, 1), cA + hstep, voffA);
        if (wr == 1) PG8_BAR;
        PG8_WAIT_V(4); PG8_BAR;
        PG8_STAGE(PG8_SB(1, 0), cB + kstep, voffB); PG8_STAGE(PG8_SA(1, 0), cA + kstep, voffA); PG8_STAGE(PG8_SB(1, 1), cB + hstep + kstep, voffB);
        PG8_WAIT_V(6); PG8_BAR;
    }
    for (;;) {
        const bool has_next = S.next(ui + 1, nxt);
        const char* nA = has_next ? (const char*)g.A + (size_t)nxt.pm * tstep : cA; const char* nB = has_next ? (const char*)g.Bt + (size_t)nxt.pn * tstep : cB;
        for (int t = 0; t < nt; t += 2) {
            const bool last = (t == nt - 2);
            const char* a1 = cA + (size_t)(t + 1) * kstep;
            const char* a2 = last ? nA : cA + (size_t)(t + 2) * kstep; const char* b2 = last ? nB : cB + (size_t)(t + 2) * kstep;
            const char* a3 = a2 + kstep; const char* b3 = b2 + kstep;
            if (last && has_next) S.a_ready(nxt);
            if constexpr (SP2) {
            PG8_LDB(B0, 0, 0); PG8_LDB(B1, 0, 1); PG8_SCHED; PG8_LDA(At, 0, 0); PG8_STAGE(PG8_SA(1, 1), a1 + hstep, voffA);
            PG8_WAIT_V(8); PG8_WAIT_L(0); PG8_BAR; PG8_MMA(0, 0, At, B0); PG8_MMA(0, 1, At, B1); PG8_BAR; PG8_SCHED;
            PG8_LDA(At, 0, 1); PG8_STAGE(PG8_SB(0, 0), b2, voffB); PG8_STAGE(PG8_SB(0, 1), b2 + hstep, voffB); PG8_STAGE(PG8_SA(0, 0), a2, voffA);
            PG8_WAIT_V(8); PG8_WAIT_L(0); PG8_BAR; PG8_MMA(1, 0, At, B0); PG8_MMA(1, 1, At, B1); PG8_BAR; PG8_SCHED;
            PG8_LDB(B0, 1, 0); PG8_LDB(B1, 1, 1); PG8_SCHED; PG8_LDA(At, 1, 0); PG8_STAGE(PG8_SA(0, 1), a2 + hstep, voffA);
            PG8_WAIT_V(8); PG8_WAIT_L(0); PG8_BAR; PG8_MMA(0, 0, At, B0); PG8_MMA(0, 1, At, B1); PG8_BAR; PG8_SCHED;
            PG8_LDA(At, 1, 1); PG8_STAGE(PG8_SB(1, 0), b3, voffB); PG8_STAGE(PG8_SB(1, 1), b3 + hstep, voffB); PG8_STAGE(PG8_SA(1, 0), a3, voffA);
            PG8_WAIT_V(8); PG8_WAIT_L(0); PG8_BAR; PG8_MMA(1, 0, At, B0); PG8_MMA(1, 1, At, B1); PG8_BAR; PG8_SCHED;
            } else {
            PG8_LDB(B0, 0, 0); PG8_SCHED; PG8_LDA(At, 0, 0); PG8_STAGE(PG8_SA(1, 1), a1 + hstep, voffA);
            PG8_WAIT_L(8); PG8_BAR; PG8_WAIT_L(0); PG8_MMA(0, 0, At, B0); PG8_BAR; PG8_SCHED;
            PG8_LDB(B1, 0, 1); PG8_STAGE(PG8_SB(0, 0), b2, voffB);
            PG8_BAR; PG8_WAIT_L(0); PG8_MMA(0, 1, At, B1); PG8_BAR;
            PG8_LDA(At, 0, 1); PG8_STAGE(PG8_SA(0, 0), a2, voffA);
            PG8_BAR; PG8_WAIT_L(0); PG8_MMA(1, 0, At, B0); PG8_BAR; PG8_SCHED;
            PG8_STAGE(PG8_SB(0, 1), b2 + hstep, voffB);
            PG8_WAIT_V(6); PG8_BAR; PG8_MMA(1, 1, At, B1); PG8_BAR;
            PG8_LDB(B0, 1, 0); PG8_SCHED; PG8_LDA(At, 1, 0); PG8_STAGE(PG8_SA(0, 1), a2 + hstep, voffA);
            PG8_WAIT_L(8); PG8_BAR; PG8_WAIT_L(0); PG8_MMA(0, 0, At, B0); PG8_BAR; PG8_SCHED;
            PG8_LDB(B1, 1, 1); PG8_STAGE(PG8_SB(1, 0), b3, voffB);
            PG8_BAR; PG8_WAIT_L(0); PG8_MMA(0, 1, At, B1); PG8_BAR;
            PG8_LDA(At, 1, 1); PG8_STAGE(PG8_SA(1, 0), a3, voffA);
            PG8_BAR; PG8_WAIT_L(0); PG8_MMA(1, 0, At, B0); PG8_BAR; PG8_SCHED;
            PG8_STAGE(PG8_SB(1, 1), b3 + hstep, voffB);
            PG8_WAIT_V(6); PG8_BAR; PG8_MMA(1, 1, At, B1); PG8_BAR;
            }
        }
        if constexpr (ALIGN_EPI) { if (wr == 0) PG8_BAR; }
        if constexpr (!Epi::AFTER_DRAIN) { E(acc, cur, wr, wc, fr, fq); S.done(cur); }
        if (!has_next) break;
#pragma unroll
        for (int a = 0; a < 2; ++a)
#pragma unroll
            for (int b = 0; b < 2; ++b)
#pragma unroll
                for (int m = 0; m < 4; ++m)
#pragma unroll
                    for (int n = 0; n < 2; ++n) acc[a][b][m][n] = (f32x4){0.f, 0.f, 0.f, 0.f};
        cur = nxt; cA = nA; cB = nB; ++ui;
        if constexpr (ALIGN_EPI) { if (wr == 1) PG8_BAR; }
    }
    PG8_WAIT_V(0);
    if constexpr (!ALIGN_EPI) { if (wr == 0) PG8_BAR; }
    PG8_BAR;
    if constexpr (Epi::AFTER_DRAIN) { E.fused(acc, cur, wr, wc, fr, fq, lds, wid, lane); S.done(cur); }
#undef PG8_SA
#undef PG8_SB
#undef PG8_STAGE
#undef PG8_LDA
#undef PG8_LDB
#undef PG8_MMA
#undef PG8_WAIT_V
#undef PG8_WAIT_L
#undef PG8_BAR
#undef PG8_SCHED
}
}
#define XB_TMO      128
#define XB_XCNT(j)  (256  + 64 * (j))
#define XB_XSUB(j)  (1280 + 64 * (j))
#define XB_XGEN(j)  (2304 + 64 * (j))
#define XB_TOP      3328
#define XB_TOPGEN   3392
#define XCD_BAR_WORDS 3456
#define XB_SPIN_CAP (1u << 18)

__device__ __forceinline__ unsigned xb_ld(unsigned* p)              { return __hip_atomic_load(p, __ATOMIC_RELAXED, __HIP_MEMORY_SCOPE_AGENT); }
__device__ __forceinline__ unsigned xb_add(unsigned* p, unsigned v) { return __hip_atomic_fetch_add(p, v, __ATOMIC_RELAXED, __HIP_MEMORY_SCOPE_AGENT); }
__device__ __forceinline__ unsigned xb_xcc_id() { return (unsigned)__builtin_amdgcn_s_getreg((3 << 11) | 20) & 0xFu; }
#define XB_SPIN(cond, bar) do { unsigned _sp = 0; while (cond) { __builtin_amdgcn_s_sleep(1); \
    if ((++_sp & 255u) == 0u) { if (xb_ld(&(bar)[XB_TMO])) break; if (_sp > XB_SPIN_CAP) { atomicAdd(&(bar)[XB_TMO], 1u); break; } } } } while (0)

struct XcdBarrier {
    unsigned* bar; unsigned x;
    volatile LAS unsigned* st;
};

__device__ __forceinline__ XcdBarrier xcd_barrier_post(unsigned* bar, volatile LAS unsigned* st) {
    XcdBarrier b; b.bar = bar; b.x = xb_xcc_id(); b.st = st;
    if (threadIdx.x == 0) (void)xb_add(&bar[XB_XCNT(b.x)], 1u);
    return b;
}
__device__ __forceinline__ void xcd_barrier_complete(unsigned* bar, unsigned x, unsigned& nloc, unsigned& nx) {
    const unsigned G = gridDim.x * gridDim.y * gridDim.z;
    unsigned sum, cnt, mine, sp = 0u;
    for (;;) {
        sum = 0u; cnt = 0u; mine = 0u;
#pragma unroll
        for (unsigned j = 0; j < 16; ++j) { const unsigned c = xb_ld(&bar[XB_XCNT(j)]); sum += c; cnt += (c > 0u) ? 1u : 0u; mine = (j == x) ? c : mine; }
        if (sum == G) break;
        __builtin_amdgcn_s_sleep(1);
        if ((++sp & 255u) == 0u) { if (xb_ld(&bar[XB_TMO])) break; if (sp > XB_SPIN_CAP) { atomicAdd(&bar[XB_TMO], 1u); break; } }
    }
    nloc = mine > 0u ? mine : 1u; nx = cnt > 0u ? cnt : 1u;
}

__device__ __forceinline__ void xcd_barrier(const XcdBarrier& b) {
    asm volatile("s_waitcnt vmcnt(0)" ::: "memory");
    __syncthreads();
    if (threadIdx.x == 0) {
        unsigned* bar = b.bar;
        __builtin_amdgcn_s_waitcnt(0);
        unsigned nloc = b.st[0], nx = b.st[1];
        if (nloc == 0u) { xcd_barrier_complete(bar, b.x, nloc, nx); b.st[0] = nloc; b.st[1] = nx; }
        const unsigned old = xb_add(&bar[XB_XSUB(b.x)], 1u);
        const unsigned gen = old / nloc;
        if (old + 1u == (gen + 1u) * nloc) {
            __builtin_amdgcn_fence(__ATOMIC_RELEASE, "agent");
            asm volatile("s_waitcnt vmcnt(0)" ::: "memory");
            const unsigned og = xb_add(&bar[XB_TOP], 1u);
            const unsigned tg = og / nx;
            if (og + 1u == (tg + 1u) * nx) xb_add(&bar[XB_TOPGEN], 1u);
            else XB_SPIN(xb_ld(&bar[XB_TOPGEN]) == tg, bar);
            __builtin_amdgcn_fence(__ATOMIC_ACQUIRE, "agent");
            xb_add(&bar[XB_XGEN(b.x)], 1u);
            asm volatile("s_waitcnt vmcnt(0)" ::: "memory");
        } else {
            XB_SPIN(xb_ld(&bar[XB_XGEN(b.x)]) == gen, bar);
            __builtin_amdgcn_fence(__ATOMIC_ACQUIRE, "agent");
            asm volatile("s_waitcnt vmcnt(0)" ::: "memory");
        }
    }
    __syncthreads();
}

#define LDS_WAIT() asm volatile("s_waitcnt lgkmcnt(0)" ::: "memory")
#define VM_WAIT() asm volatile("s_waitcnt vmcnt(0)" ::: "memory")
#define SBAR() __builtin_amdgcn_sched_barrier(0)
__device__ __forceinline__ unsigned cvtpk(float lo, float hi) { unsigned r; asm volatile("v_cvt_pk_bf16_f32 %0, %1, %2" : "=v"(r) : "v"(lo), "v"(hi)); return r; }
__device__ __forceinline__ float bf_lo(unsigned w) { return __uint_as_float(w << 16); }
__device__ __forceinline__ float bf_hi(unsigned w) { return __uint_as_float(w & 0xffff0000u); }
__device__ __forceinline__ float bf2f(bf16_t h) { return __uint_as_float(((unsigned)h) << 16); }
__device__ __forceinline__ float wave_sum(float v) {
#pragma unroll
    for (int o = 1; o < 64; o <<= 1) v += __shfl_xor(v, o);
    return v;
}
__device__ __forceinline__ float fast_exp2(float x) { return __builtin_amdgcn_exp2f(x); }
__device__ __forceinline__ float fast_log2(float x) { return __builtin_amdgcn_logf(x); }
__device__ __forceinline__ float fast_rcp(float x) { return __builtin_amdgcn_rcpf(x); }

__device__ __forceinline__ int tid_now() { int t = (int)threadIdx.x; asm volatile("" : "+v"(t)); return t; }

struct Params { const float* in[27]; float* out; unsigned char* ws; int ph_lo, ph_hi; };

struct TrJob { int src, N, c0, ncols, K, gain, r0; size_t dst; };
__device__ __forceinline__ void tr_item(const float* W, int N, int c0, int ncols, int K, const float* gain, bf16_t* WT, int r0, int kb, int nb, LAS float* scr, int lane) {
    const int k0 = kb * 64, n0 = nb * 64;
    const float* src = W + (size_t)k0 * N + c0 + n0 + lane;
#pragma unroll 16
    for (int i = 0; i < 64; ++i) scr[i * 65 + lane] = src[(size_t)i * N];
    LDS_WAIT(); asm volatile("" ::: "memory");
    const int c = lane & 7;
    float gv[8];
#pragma unroll
    for (int e = 0; e < 8; ++e) gv[e] = gain ? gain[k0 + 8 * c + e] : 1.0f;
#pragma unroll
    for (int j = 0; j < 8; ++j) { const int n = (lane >> 3) + 8 * j; const LAS float* s = scr + (8 * c) * 65 + n;
        u32x4 o; o.x = cvtpk(s[0 * 65] * gv[0], s[1 * 65] * gv[1]); o.y = cvtpk(s[2 * 65] * gv[2], s[3 * 65] * gv[3]); o.z = cvtpk(s[4 * 65] * gv[4], s[5 * 65] * gv[5]); o.w = cvtpk(s[6 * 65] * gv[6], s[7 * 65] * gv[7]);
        if (n0 + n >= ncols) o = (u32x4){0u, 0u, 0u, 0u};
        *(u32x4*)(WT + (size_t)(r0 + n0 + n) * K + k0 + 8 * c) = o; }
    LDS_WAIT(); asm volatile("" ::: "memory");
}
constexpr int NJOBS = 21;
__device__ __forceinline__ TrJob get_job(int id) {
    TrJob j{};
    if (id < 16) { const int l = id >> 3, k = id & 7, ib = 2 + 8 * l;
        switch (k) {
        case 0: j = TrJob{ib + 1, 19552, 0, 7168, 4096, ib, 0, WS_WAIN + l * WAIN_BYTES}; break;
        case 1: j = TrJob{ib + 1, 19552, 7264, 12288, 4096, ib, 7168, WS_WAIN + l * WAIN_BYTES}; break;
        case 2: j = TrJob{ib + 1, 19552, 7168, 96, 4096, ib, 0, WS_WG + (size_t)l * 128 * 4096 * 2}; break;
        case 3: j = TrJob{ib + 7, 4096, 0, 4096, 4096, -1, 0, WS_WAOUT + l * WOUT_BYTES}; break;
        case 4: j = TrJob{ib + 3, 128, 0, 128, 4096, -1, 0, WS_W1T + (size_t)(l * 2 + 0) * 128 * 4096 * 2}; break;
        case 5: j = TrJob{ib + 5, 128, 0, 128, 4096, -1, 0, WS_W1T + (size_t)(l * 2 + 1) * 128 * 4096 * 2}; break;
        case 6: j = TrJob{ib + 4, 128, 0, 128, 128, -1, 0, WS_W2T + (size_t)(l * 2 + 0) * 128 * 128 * 2}; break;
        default: j = TrJob{ib + 6, 128, 0, 128, 128, -1, 0, WS_W2T + (size_t)(l * 2 + 1) * 128 * 128 * 2}; break;
        }
    } else {
        switch (id) {
        case 16: j = TrJob{19, 8192, 0, 8192, 4096, 18, 0, WS_WKVQ}; break;
        case 17: j = TrJob{21, 8192, 0, 8192, 4096, 20, 8192, WS_WKVQ}; break;
        case 18: j = TrJob{22, 4096, 0, 4096, 4096, -1, 0, WS_WBOUT}; break;
        case 19: j = TrJob{24, 8192, 0, 8192, 4096, 23, 0, WS_WB3}; break;
        default: j = TrJob{25, 4096, 0, 4096, 4096, -1, 0, WS_WBOUT + WOUT_BYTES}; break;
        }
    }
    return j;
}
__device__ __forceinline__ int job_items(const TrJob& j) { return (j.K / 64) * ((j.ncols + 63) / 64); }

__device__ __forceinline__ void phase_x_to_bf16(const float* x, bf16_t* xb, float* ss) {
    const int tid = tid_now(), lane = tid & 63, gw = blockIdx.x * 8 + __builtin_amdgcn_readfirstlane(tid >> 6), ngw = gridDim.x * 8;
    for (int m = gw; m < MTOK; m += ngw) {
        const f32x4* xr = (const f32x4*)(x + (size_t)m * DM) + lane; u32x2* o8 = (u32x2*)(xb + (size_t)m * DM) + lane;
        f32x4 v[16]; float s = 0.f;
#pragma unroll
        for (int j = 0; j < 16; ++j) { v[j] = xr[64 * j]; s += (v[j].x * v[j].x + v[j].y * v[j].y) + (v[j].z * v[j].z + v[j].w * v[j].w); }
#pragma unroll
        for (int j = 0; j < 16; ++j) { u32x2 w; w.x = cvtpk(v[j].x, v[j].y); w.y = cvtpk(v[j].z, v[j].w); o8[64 * j] = w; }
        s = wave_sum(s);
        if (lane == 0) ss[m] = s;
    }
}
__device__ __forceinline__ void phase_final_norm(const bf16_t* xb, float* out, const float* g, const float* ss, LAS unsigned char* lds) {
    const int tid = tid_now(), lane = tid & 63, wave = __builtin_amdgcn_readfirstlane(tid >> 6);
    LAS float* RSF = (LAS float*)lds;
    for (int r0 = blockIdx.x * 64; r0 < MTOK; r0 += gridDim.x * 64) {
        __syncthreads();
        if (tid < 64) RSF[tid] = 1.0f / sqrtf(row_sumsq(ss, SS_NP, r0 + tid) * (1.0f / DM) + RMS_EPS);
        __syncthreads();
        for (int k = 0; k < 8; ++k) { const int m = r0 + wave * 8 + k;
            const u32x4* xr = (const u32x4*)(xb + (size_t)m * DM) + lane; f32x4* orow = (f32x4*)(out + (size_t)m * DM) + 2 * lane; const f32x4* gr = (const f32x4*)g + 2 * lane;
            const float rstd = RSF[wave * 8 + k];
#pragma unroll
            for (int j = 0; j < 8; ++j) { const u32x4 v = xr[64 * j];
                const f32x4 lo = (f32x4){__uint_as_float(v.x << 16), __uint_as_float(v.x & 0xffff0000u), __uint_as_float(v.y << 16), __uint_as_float(v.y & 0xffff0000u)};
                const f32x4 hi = (f32x4){__uint_as_float(v.z << 16), __uint_as_float(v.z & 0xffff0000u), __uint_as_float(v.w << 16), __uint_as_float(v.w & 0xffff0000u)};
                orow[128 * j] = lo * rstd * gr[128 * j]; orow[128 * j + 1] = hi * rstd * gr[128 * j + 1]; } }
    }
}

__device__ __forceinline__ void phase_prologue(const Params& P, LAS unsigned char* lds) {
    const int tid = tid_now(), lane = tid & 63, wave = __builtin_amdgcn_readfirstlane(tid >> 6), G = gridDim.x;
    LAS float* scr = (LAS float*)(lds + wave * 16640);
    const int gw = blockIdx.x * 8 + wave, ngw = G * 8;
    int base = 0;
    for (int id = 0; id < NJOBS; ++id) {
        const TrJob j = get_job(id); const int ni = job_items(j), nbn = (j.ncols + 63) / 64;
        int it = gw - (base % ngw); if (it < 0) it += ngw;
        const float* W = P.in[j.src]; const float* gain = j.gain >= 0 ? P.in[j.gain] : nullptr; bf16_t* WT = (bf16_t*)(P.ws + j.dst);
        for (; it < ni; it += ngw) tr_item(W, j.N, j.c0, j.ncols, j.K, gain, WT, j.r0, it / nbn, it % nbn, scr, lane);
        base += ni;
    }
    __syncthreads();
    for (int item = blockIdx.x; item < 64; item += G) {
        const int lk = item >> 4, kp = item & 15, l = lk >> 1, kv = lk & 1, ib = 2 + 8 * l;
        const float* pos = P.in[ib + 2]; const float* w1 = P.in[ib + 3 + 2 * kv];
        const int col = tid & 127, part = tid >> 7, kbeg = kp * 256 + part * 64; float s = 0.f;
#pragma unroll 8
        for (int k = kbeg; k < kbeg + 64; ++k) s += pos[k] * w1[(size_t)k * 128 + col];
        LAS float* red = (LAS float*)lds;
        red[part * 128 + col] = s; __syncthreads();
        if (tid < 128) ((float*)(P.ws + WS_C1))[item * 128 + tid] = (red[tid] + red[128 + tid]) + (red[256 + tid] + red[384 + tid]);
        __syncthreads();
    }
    phase_x_to_bf16(P.in[0], (bf16_t*)(P.ws + WS_XB), (float*)(P.ws + WS_SS));
}

__device__ __forceinline__ bf16x8 ld8(const bf16_t* p) { return *(const bf16x8*)p; }
__device__ __forceinline__ void compress_unit(const Params& P, int l, int cu, LAS unsigned char* lds) {
    const int tid = tid_now(), lane = tid & 63, wave = __builtin_amdgcn_readfirstlane(tid >> 6);
    const int rt = cu & 3, kv = (cu >> 2) & 1, bg = cu >> 3, b = bg >> 2, g = bg & 3;
    const bf16_t* raw = (const bf16_t*)(P.ws + WS_KV) + (size_t)(b * SEQ) * KVW + kv * 512 + g * 128;
    const bf16_t* w1t = (const bf16_t*)(P.ws + WS_W1T) + (size_t)(l * 2 + kv) * 128 * 4096;
    const bf16_t* w2t = (const bf16_t*)(P.ws + WS_W2T) + (size_t)(l * 2 + kv) * 128 * 128;
    const float* c1p = (const float*)(P.ws + WS_C1) + (size_t)(l * 2 + kv) * 16 * 128;
    bf16_t* outp = (bf16_t*)(P.ws + (kv ? WS_VC : WS_KC)) + (size_t)bg * 128 * 128;
    const int fr = lane & 15, fq = lane >> 4;
    LAS float* PART = (LAS float*)lds;
    LAS bf16_t* H = (LAS bf16_t*)(lds + 131072);
    {
        int n0 = rt * 32 + fr, n1 = n0 + 16; n0 = n0 > 126 ? 126 : n0; n1 = n1 > 126 ? 126 : n1;
        const bf16_t* ap0 = raw + (size_t)(16 * n0 + wave * 4) * KVW + fq * 8; const bf16_t* ap1 = raw + (size_t)(16 * n1 + wave * 4) * KVW + fq * 8;
        const bf16_t* bp = w1t + (size_t)fr * 4096 + wave * 512 + fq * 8;
        f32x4 acc[2][8];
#pragma unroll
        for (int i = 0; i < 2; ++i)
#pragma unroll
            for (int c = 0; c < 8; ++c) acc[i][c] = (f32x4){0.f, 0.f, 0.f, 0.f};
#pragma unroll 4
        for (int ks = 0; ks < 16; ++ks) {
            const bf16x8 a0 = ld8(ap0 + (size_t)(ks >> 2) * KVW + (ks & 3) * 32), a1 = ld8(ap1 + (size_t)(ks >> 2) * KVW + (ks & 3) * 32);
            bf16x8 bb[8];
#pragma unroll
            for (int c = 0; c < 8; ++c) bb[c] = ld8(bp + (size_t)c * 16 * 4096 + ks * 32);
#pragma unroll
            for (int c = 0; c < 8; ++c) { acc[0][c] = __builtin_amdgcn_mfma_f32_16x16x32_bf16(a0, bb[c], acc[0][c], 0, 0, 0); acc[1][c] = __builtin_amdgcn_mfma_f32_16x16x32_bf16(a1, bb[c], acc[1][c], 0, 0, 0); }
        }
#pragma unroll
        for (int i = 0; i < 2; ++i)
#pragma unroll
            for (int c = 0; c < 8; ++c)
#pragma unroll
                for (int r = 0; r < 4; ++r) PART[(wave * 32 + i * 16 + fq * 4 + r) * 128 + c * 16 + fr] = acc[i][c][r];
    }
    __syncthreads();
    { const int col = tid & 127; float cc = 0.f;
#pragma unroll
      for (int kp = 0; kp < 16; ++kp) cc += c1p[kp * 128 + col];
#pragma unroll
      for (int e = 0; e < 8; ++e) { const int row = (tid >> 7) * 8 + e; float v = cc;
#pragma unroll
          for (int w = 0; w < 8; ++w) v += PART[(w * 32 + row) * 128 + col];
          const float sv = v * fast_rcp(1.0f + fast_exp2(-v * LOG2E));
          H[row * 136 + col] = (bf16_t)(cvtpk(sv, 0.f) & 0xffffu); } }
    __syncthreads();
    const int rtile = wave & 1, ct0 = (wave >> 1) * 2;
    f32x4 o0 = {0.f, 0.f, 0.f, 0.f}, o1 = {0.f, 0.f, 0.f, 0.f};
#pragma unroll
    for (int ks = 0; ks < 4; ++ks) {
        const bf16x8 a = *(const LAS bf16x8*)(H + (rtile * 16 + fr) * 136 + ks * 32 + fq * 8);
        const bf16x8 b0 = ld8(w2t + (size_t)(ct0 * 16 + fr) * 128 + ks * 32 + fq * 8), b1 = ld8(w2t + (size_t)((ct0 + 1) * 16 + fr) * 128 + ks * 32 + fq * 8);
        o0 = __builtin_amdgcn_mfma_f32_16x16x32_bf16(a, b0, o0, 0, 0, 0);
        o1 = __builtin_amdgcn_mfma_f32_16x16x32_bf16(a, b1, o1, 0, 0, 0);
    }
#pragma unroll
    for (int c = 0; c < 2; ++c) { const int col = (ct0 + c) * 16 + fr;
#pragma unroll
        for (int r = 0; r < 4; ++r) { const int nr = rt * 32 + rtile * 16 + fq * 4 + r; const float v = nr < NCMP ? (c ? o1[r] : o0[r]) : 0.f;
            outp[(size_t)nr * 128 + col] = (bf16_t)(cvtpk(v, 0.f) & 0xffffu); } }
    __syncthreads();
}
__device__ __forceinline__ void gate_unit(const Params& P, int l, int gu, LAS unsigned char* lds) {
    const int tid = tid_now(), lane = tid & 63, wave = __builtin_amdgcn_readfirstlane(tid >> 6);
    const bf16_t* xb = (const bf16_t*)(P.ws + WS_XB); const bf16_t* wg = (const bf16_t*)(P.ws + WS_WG) + (size_t)l * 128 * 4096;
    const float* ss = l == 0 ? (const float*)(P.ws + WS_SS) : (const float*)(P.ws + WS_SSP); const int np = l == 0 ? 1 : SS_NP;
    float* Gt = (float*)(P.ws + WS_G);
    const int fr = lane & 15, fq = lane >> 4, kq = wave & 3, rh = wave >> 2;
    LAS float* PART = (LAS float*)lds;
    {
        const bf16_t* ap = xb + (size_t)(gu * 64 + rh * 32 + fr) * DM + kq * 1024 + fq * 8;
        const bf16_t* bp = wg + (size_t)fr * DM + kq * 1024 + fq * 8;
        f32x4 acc[2][6];
#pragma unroll
        for (int i = 0; i < 2; ++i)
#pragma unroll
            for (int c = 0; c < 6; ++c) acc[i][c] = (f32x4){0.f, 0.f, 0.f, 0.f};
#pragma unroll 4
        for (int ks = 0; ks < 32; ++ks) {
            const bf16x8 a0 = ld8(ap + ks * 32), a1 = ld8(ap + (size_t)16 * DM + ks * 32);
            bf16x8 bb[6];
#pragma unroll
            for (int c = 0; c < 6; ++c) bb[c] = ld8(bp + (size_t)c * 16 * DM + ks * 32);
#pragma unroll
            for (int c = 0; c < 6; ++c) { acc[0][c] = __builtin_amdgcn_mfma_f32_16x16x32_bf16(a0, bb[c], acc[0][c], 0, 0, 0); acc[1][c] = __builtin_amdgcn_mfma_f32_16x16x32_bf16(a1, bb[c], acc[1][c], 0, 0, 0); }
        }
#pragma unroll
        for (int i = 0; i < 2; ++i)
#pragma unroll
            for (int c = 0; c < 6; ++c)
#pragma unroll
                for (int r = 0; r < 4; ++r) PART[(kq * 64 + rh * 32 + i * 16 + fq * 4 + r) * 96 + c * 16 + fr] = acc[i][c][r];
    }
    LAS float* RSG = (LAS float*)(lds + 98304);
    if (tid < 64) RSG[tid] = 1.0f / sqrtf(row_sumsq(ss, np, gu * 64 + tid) * (1.0f / DM) + RMS_EPS);
    __syncthreads();
    for (int e = tid; e < 64 * 96; e += 512) { const int row = e / 96, col = e - row * 96;
        const float v = (PART[row * 96 + col] + PART[(64 + row) * 96 + col]) + (PART[(128 + row) * 96 + col] + PART[(192 + row) * 96 + col]);
        const float lg = v * RSG[row];
        Gt[(size_t)(gu * 64 + row) * NGATE + col] = fast_rcp(1.0f + fast_exp2(-lg * LOG2E)); }
    __syncthreads();
}

namespace att {
constexpr int SHM_K = 16384, SHM_V = 16384, NSLOT = 3;
constexpr int OFF_V = 0, OFF_K = NSLOT * SHM_V;
constexpr int OFF_IMP = NSLOT * (SHM_V + SHM_K);
constexpr int OFF_FIN = OFF_IMP + 8 * 32 * 33 * 4;
constexpr int OFF_SELM = OFF_FIN + 32 * 33 * 4;
constexpr int OFF_BT = OFF_SELM + 128;
constexpr int OFF_WS = OFF_BT + 8 * 132 * 4;
constexpr int OFF_DONE = OFF_WS + 8 * 64 * 4;
constexpr int ATT_LDS_END = OFF_DONE + 64;
static_assert(ATT_LDS_END <= MISC_OFF, "attention LDS map");

#define KSWZ(row, colB) ((row) * 256 + ((colB) ^ (((row) & 7) << 4)))
__device__ __forceinline__ int v_st(int k, int c) { const int kk = (k & ~0xC) | ((k & 4) << 1) | ((k & 8) >> 1); return ((kk >> 3) * 4 + (c >> 5)) * 512 + ((kk & 7) * 32 + (c & 31)) * 2; }
__device__ __forceinline__ int v_rd_base(int lane) { return ((lane & 3) << 3) | (((lane >> 2) & 3) << 6) | (((lane >> 4) & 1) << 5) | (((lane >> 5) & 1) << 8); }
constexpr int v_rd_off(int d0, int ks, int half) { return d0 * 512 + ks * 4096 + half * 2048; }
__device__ __forceinline__ int crow(int r, int hi) { return (r & 3) + 8 * (r >> 2) + 4 * hi; }

struct Geo { int tid, wid, lane, r32, hi, vb0; };
__device__ __forceinline__ Geo make_geo(LAS unsigned char* lds) {
    Geo g; g.tid = tid_now(); g.wid = __builtin_amdgcn_readfirstlane(g.tid >> 6); g.lane = g.tid & 63; g.r32 = g.lane & 31; g.hi = g.lane >> 5;
    g.vb0 = (int)(uintptr_t)(lds + OFF_V) + v_rd_base(g.lane);
    return g;
}
struct DmaOff { unsigned k[2], v[2]; };
__device__ __forceinline__ DmaOff make_dma(const Geo& g, int ld) {
    DmaOff d;
#pragma unroll
    for (int i = 0; i < 2; ++i) { const int ch = g.wid + 8 * i;
        const int krow = 4 * ch + (g.lane >> 4), kc = (g.lane & 15) ^ (krow & 7);
        d.k[i] = (unsigned)(krow * ld * 2 + kc * 16);
        const int sub = 2 * ch + (g.lane >> 5), kk = 8 * (sub >> 2) + ((g.lane & 31) >> 2), key = (kk & ~0xC) | ((kk & 4) << 1) | ((kk & 8) >> 1);
        d.v[i] = (unsigned)(key * ld * 2 + ((sub & 3) * 32 + (g.lane & 3) * 8) * 2); }
    return d;
}
__device__ __forceinline__ void dma_tile(LAS unsigned char* lds, int slot, const bf16_t* Kp, const bf16_t* Vp, size_t ld, int key0, DmaOff d, const Geo& g) {
    asm volatile("" : "+v"(d.k[0]), "+v"(d.k[1]), "+v"(d.v[0]), "+v"(d.v[1]));
    const char* kb = (const char*)Kp + (size_t)key0 * ld * 2; const char* vb = (const char*)Vp + (size_t)key0 * ld * 2;
#pragma unroll
    for (int i = 0; i < 2; ++i) {
        __builtin_amdgcn_global_load_lds((const unsigned*)(kb + d.k[i]), (LAS unsigned*)(lds + OFF_K + slot * SHM_K + (g.wid + 8 * i) * 1024), 16, 0, 0);
        __builtin_amdgcn_global_load_lds((const unsigned*)(vb + d.v[i]), (LAS unsigned*)(lds + OFF_V + slot * SHM_V + (g.wid + 8 * i) * 1024), 16, 0, 0); }
}
#define WAIT_VM(n) asm volatile("s_waitcnt vmcnt(" #n ")" ::: "memory")
#define RAW_BAR() do { asm volatile("s_waitcnt lgkmcnt(0)" ::: "memory"); __builtin_amdgcn_s_barrier(); asm volatile("" ::: "memory"); } while (0)
__device__ __forceinline__ void qkt(f32x16& p0, f32x16& p1, LAS unsigned char* lds, int buf, const Geo& g, const bf16x8* qr) {
    p0 = f32x16{}; p1 = f32x16{};
    LAS unsigned char* kb[4];
#pragma unroll
    for (int dd = 0; dd < 4; ++dd) kb[dd] = lds + OFF_K + buf * SHM_K + KSWZ(g.r32, (dd * 16 + g.hi * 8) * 2);
#pragma unroll
    for (int d0 = 0; d0 < 8; ++d0) { LAS unsigned char* a = kb[d0 & 3] + (d0 >> 2) * 128;
        const bf16x8 b0 = *(const LAS bf16x8*)a, b1 = *(const LAS bf16x8*)(a + 32 * 256);
        p0 = __builtin_amdgcn_mfma_f32_32x32x16_bf16(b0, qr[d0], p0, 0, 0, 0);
        p1 = __builtin_amdgcn_mfma_f32_32x32x16_bf16(b1, qr[d0], p1, 0, 0, 0); }
}
__device__ __forceinline__ void pv_tile(f32x16* o, int vb, bf16x8 pa0, bf16x8 pa1, bf16x8 pa2, bf16x8 pa3) {
#define TRRD(dst, off) asm volatile("ds_read_b64_tr_b16 %0, %1 offset:%2" : "=&v"(dst) : "v"(vb), "i"(off) : "memory")
#define PV_D0(d0) do { s16x4 l0, l1, l2, l3, h0, h1, h2, h3; constexpr int b_ = v_rd_off(d0, 0, 0); \
        TRRD(l0, b_); TRRD(h0, b_ + 2048); TRRD(l1, b_ + 4096); TRRD(h1, b_ + 6144); TRRD(l2, b_ + 8192); TRRD(h2, b_ + 10240); TRRD(l3, b_ + 12288); TRRD(h3, b_ + 14336); \
        asm volatile("s_waitcnt lgkmcnt(0)" ::: "memory"); SBAR(); \
        o[d0] = __builtin_amdgcn_mfma_f32_32x32x16_bf16(pa0, (bf16x8){l0[0], l0[1], l0[2], l0[3], h0[0], h0[1], h0[2], h0[3]}, o[d0], 0, 0, 0); \
        o[d0] = __builtin_amdgcn_mfma_f32_32x32x16_bf16(pa1, (bf16x8){l1[0], l1[1], l1[2], l1[3], h1[0], h1[1], h1[2], h1[3]}, o[d0], 0, 0, 0); \
        o[d0] = __builtin_amdgcn_mfma_f32_32x32x16_bf16(pa2, (bf16x8){l2[0], l2[1], l2[2], l2[3], h2[0], h2[1], h2[2], h2[3]}, o[d0], 0, 0, 0); \
        o[d0] = __builtin_amdgcn_mfma_f32_32x32x16_bf16(pa3, (bf16x8){l3[0], l3[1], l3[2], l3[3], h3[0], h3[1], h3[2], h3[3]}, o[d0], 0, 0, 0); } while (0)
    PV_D0(0); PV_D0(1); PV_D0(2); PV_D0(3);
#undef PV_D0
#undef TRRD
}
__device__ __forceinline__ void pack_p(const f32x16& p0, const f32x16& p1, bf16x8& pa0, bf16x8& pa1, bf16x8& pa2, bf16x8& pa3) {
#define PK4(P, B_, OUT) do { unsigned a0 = cvtpk(P[B_+0], P[B_+1]), a1 = cvtpk(P[B_+2], P[B_+3]); \
        unsigned b0 = cvtpk(P[B_+4], P[B_+5]), b1 = cvtpk(P[B_+6], P[B_+7]); \
        auto r0 = __builtin_amdgcn_permlane32_swap(a0, b0, false, false); auto r1 = __builtin_amdgcn_permlane32_swap(a1, b1, false, false); \
        u32x4 w = {r0[0], r1[0], r0[1], r1[1]}; OUT = *reinterpret_cast<bf16x8*>(&w); } while (0)
    PK4(p0, 0, pa0); PK4(p0, 8, pa1); PK4(p1, 0, pa2); PK4(p1, 8, pa3);
#undef PK4
}
__device__ __forceinline__ void pair_vals(float x, float& lo, float& hi) {
    auto rr = __builtin_amdgcn_permlane32_swap(__float_as_uint(x), __float_as_uint(x), false, false);
    lo = __uint_as_float(rr[0]); hi = __uint_as_float(rr[1]);
}
__device__ __forceinline__ float pair_max(float x) { float a, b; pair_vals(x, a, b); return fmaxf(a, b); }
__device__ __forceinline__ float pair_sum(float x) { float a, b; pair_vals(x, a, b); return a + b; }

constexpr float SM_THR = 8.0f;
__device__ __forceinline__ void rescale_o(f32x16* o, float alpha, LAS float* al_l, const Geo& g) {
    if (g.hi == 0) al_l[g.r32] = alpha;
    LDS_WAIT();
#pragma unroll
    for (int r = 0; r < 16; ++r) { const float a = al_l[crow(r, g.hi)];
#pragma unroll
        for (int d = 0; d < 4; ++d) o[d][r] *= a; }
}
__device__ __forceinline__ void softmax_step(f32x16& p0, f32x16& p1, float mulc, float badd, bool ok, float& m_reg, float& l_reg, f32x16* o, LAS float* al_l, const Geo& g) {
    const float NEG = -__builtin_inff();
    float xmax = fmaxf(p0[0], p1[0]);
#pragma unroll
    for (int r = 1; r < 16; ++r) xmax = fmaxf(xmax, fmaxf(p0[r], p1[r]));
    xmax = pair_max(xmax);
    const float smax = ok ? fmaf(xmax, mulc, badd) : NEG;
    float mn = m_reg, alpha = 1.0f;
    if (!__all(smax - m_reg <= SM_THR)) { mn = fmaxf(m_reg, smax); alpha = fast_exp2(m_reg - mn); m_reg = mn; rescale_o(o, alpha, al_l, g); }
    const float addc = ok ? (badd - mn) : NEG;
    float ps = 0.f;
#pragma unroll
    for (int r = 0; r < 16; ++r) { p0[r] = fast_exp2(fmaf(p0[r], mulc, addc)); ps += p0[r]; }
#pragma unroll
    for (int r = 0; r < 16; ++r) { p1[r] = fast_exp2(fmaf(p1[r], mulc, addc)); ps += p1[r]; }
    ps = pair_sum(ps);
    l_reg = l_reg * alpha + ps;
}

struct NsaT { const bf16_t* Q; const bf16_t* KV; const bf16_t* Z; const float* Gt; const bf16_t* KC; const bf16_t* VC; bf16_t* MIX; const float* rel_bias; };

constexpr int EMIT_ROWB = 144, EMIT_TILE = 32 * EMIT_ROWB;
static_assert(8 * EMIT_TILE <= OFF_SELM - OFF_IMP, "emit tiles fit the IMP + FIN region");
__device__ __forceinline__ void silu2_mul(unsigned ov, unsigned zv, float& lo, float& hi) {
    const float z0 = bf_lo(zv), z1 = bf_hi(zv);
    lo = bf_lo(ov) * z0 * fast_rcp(1.0f + fast_exp2(-z0 * LOG2E)); hi = bf_hi(ov) * z1 * fast_rcp(1.0f + fast_exp2(-z1 * LOG2E));
}
__device__ __forceinline__ float lane_xor1(float x) { return __int_as_float(__builtin_amdgcn_update_dpp(0, __float_as_int(x), 0xB1, 0xF, 0xF, true)); }
template <bool RMW, bool SCALE>
__device__ __forceinline__ void emit_tile(LAS unsigned char* lds, const f32x16* o, float f, const bf16_t* zb  , size_t zld,
                                          bf16_t* mb  , LAS float* li_l, const Geo& g) {
    const int row = g.lane >> 1, half = g.lane & 1;
    unsigned zoff = (unsigned)(row * (int)zld + half * 32), moff = (unsigned)(row * DM + half * 32);
    asm volatile("" : "+v"(zoff), "+v"(moff));
    u32x4 zv[2][4]; u32x4 old[2][4];
#pragma unroll
    for (int c = 0; c < 2; ++c)
#pragma unroll
        for (int q = 0; q < 4; ++q) zv[c][q] = *(const u32x4*)(zb + zoff + 64 * c + q * 8);
    if (RMW) {
#pragma unroll
        for (int c = 0; c < 2; ++c)
#pragma unroll
            for (int q = 0; q < 4; ++q) { const unsigned long long* ap = (const unsigned long long*)(mb + moff + 64 * c + q * 8);
                const unsigned long long a0 = __hip_atomic_load(ap, __ATOMIC_RELAXED, __HIP_MEMORY_SCOPE_AGENT), a1 = __hip_atomic_load(ap + 1, __ATOMIC_RELAXED, __HIP_MEMORY_SCOPE_AGENT);
                old[c][q] = (u32x4){(unsigned)a0, (unsigned)(a0 >> 32), (unsigned)a1, (unsigned)(a1 >> 32)}; }
    }
    float fr[16];
    if (SCALE) { if (g.hi == 0) li_l[g.r32] = f;
        LDS_WAIT();
#pragma unroll
        for (int r = 0; r < 16; ++r) fr[r] = li_l[(r & 3) + 8 * (r >> 2) + 4 * g.hi]; }
    LAS unsigned char* T = lds + OFF_IMP + g.wid * EMIT_TILE;
    const LAS unsigned char* trow = T + row * EMIT_ROWB + half * 64;
#pragma unroll
    for (int c = 0; c < 2; ++c) {
#pragma unroll
        for (int r = 0; r < 16; ++r) { const int rc = (r & 3) + 8 * (r >> 2);
#pragma unroll
            for (int dd = 0; dd < 2; ++dd) { const float v = SCALE ? o[2 * c + dd][r] * fr[r] : o[2 * c + dd][r]; const float vn = lane_xor1(v);
                if ((g.r32 & 1) == 0) *(LAS unsigned*)(T + (rc + 4 * g.hi) * EMIT_ROWB + (dd * 32 + g.r32) * 2) = cvtpk(v, vn); } }
        LDS_WAIT();
#pragma unroll
        for (int q = 0; q < 4; ++q) { const u32x4 ov = *(const LAS u32x4*)(trow + q * 16); u32x4 w;
#pragma unroll
            for (int e = 0; e < 4; ++e) { float lo, hi; silu2_mul(ov[e], zv[c][q][e], lo, hi);
                if (RMW) { lo += bf_lo(old[c][q][e]); hi += bf_hi(old[c][q][e]); }
                w[e] = cvtpk(lo, hi); }
            *(u32x4*)(mb + moff + 64 * c + q * 8) = w; }
        asm volatile("" ::: "memory");
    }
}

template <int MODE>
__device__ __forceinline__ void tile_softmax(f32x16& p0, f32x16& p1, int kb, int t0, bool selbit, const LAS float* btw, float& m_reg, float& l_reg, f32x16* o, LAS float* al_l, const Geo& g) {
    constexpr float C2 = SM_SCALE * LOG2E; const float NEG = -__builtin_inff();
    const bool near = (kb + 63 + 128 > t0);
    const bool wedge = (MODE == 2) && (t0 + 31 - kb >= 512);
    bool ok = (MODE == 1) ? selbit : true; float mulc = C2, badd = btw[128];
    if (near || wedge) {
        const int dq = t0 + g.r32 - kb - 4 * g.hi; const unsigned W = (MODE == 2) ? 512u : 0x7fffffffu;
#pragma unroll
        for (int r = 0; r < 16; ++r) { const int c = (r & 3) + 8 * (r >> 2);
            const unsigned d0 = (unsigned)(dq - c), d1 = (unsigned)(dq - c - 32);
            float b0 = btw[d0 < 128u ? d0 : 128u], b1 = btw[d1 < 128u ? d1 : 128u];
            asm volatile("" : "+v"(b0), "+v"(b1));
            p0[r] = (ok && d0 < W) ? fmaf(p0[r], C2, b0) : NEG; p1[r] = (ok && d1 < W) ? fmaf(p1[r], C2, b1) : NEG;
            if ((r & 3) == 3) asm volatile("" ::: "memory"); }
        mulc = 1.0f; badd = 0.f; ok = true;
    }
    softmax_step(p0, p1, mulc, badd, ok, m_reg, l_reg, o, al_l, g);
}

struct TileIter { unsigned rem; int nxt, j_hi, j, j1, j2; };
template <int MODE> __device__ __forceinline__ void ti_next(TileIter& it, int& dst) {
    if (MODE == 1) { dst = it.rem ? __builtin_ctz(it.rem) : -1; it.rem &= it.rem - 1u; } else { dst = (it.nxt <= it.j_hi) ? it.nxt : -1; ++it.nxt; } }
template <int MODE> __device__ __forceinline__ TileIter ti_init(unsigned umask, int j_lo, int j_hi) {
    TileIter it; it.rem = umask; it.nxt = j_lo; it.j_hi = j_hi; ti_next<MODE>(it, it.j); ti_next<MODE>(it, it.j1); ti_next<MODE>(it, it.j2); return it; }
__device__ __forceinline__ void branch_issue(LAS unsigned char* lds, const TileIter& it, const bf16_t* Kp, const bf16_t* Vp, size_t ld, const DmaOff& dof, const Geo& g) {
    dma_tile(lds, 0, Kp, Vp, ld, 64 * it.j, dof, g);
    if (it.j1 >= 0) dma_tile(lds, 1, Kp, Vp, ld, 64 * it.j1, dof, g);
}
template <int MODE>
__device__ __forceinline__ void branch_run(f32x16* o, float& l_out, LAS unsigned char* lds, TileIter it, const bf16_t* Kp, const bf16_t* Vp, size_t ld, const DmaOff& dof, const bf16x8* qr,
                                           unsigned selword, int t0, const LAS float* btw, LAS float* al_l, const Geo& g) {
    float m_reg = -1e30f, l_reg = 0.f;
#pragma unroll
    for (int d = 0; d < 4; ++d) o[d] = f32x16{};
    int slot = 0; bool first = true;
    for (;;) {
        if (first || it.j1 < 0) WAIT_VM(0); else WAIT_VM(4);
        first = false;
        RAW_BAR();
        if (it.j2 >= 0) dma_tile(lds, slot >= 1 ? slot - 1 : 2, Kp, Vp, ld, 64 * it.j2, dof, g);
        f32x16 p0, p1;
        qkt(p0, p1, lds, slot, g, qr);
        tile_softmax<MODE>(p0, p1, 64 * it.j, t0, ((selword >> it.j) & 1u) != 0u, btw, m_reg, l_reg, o, al_l, g);
        bf16x8 pa0, pa1, pa2, pa3; pack_p(p0, p1, pa0, pa1, pa2, pa3);
        pv_tile(o, g.vb0 + slot * SHM_V, pa0, pa1, pa2, pa3);
        if (it.j1 < 0) break;
        it.j = it.j1; it.j1 = it.j2; ti_next<MODE>(it, it.j2); slot = slot == 2 ? 0 : slot + 1;
    }
    RAW_BAR();
    l_out = l_reg;
}

__device__ __forceinline__ int t5_bucket(int d) {
    if (d < 16) return d;
    const float lr = logf((float)d / 16.0f);
    int large = 16 + (int)(lr / 2.0794415416798357f * 16.0f);
    return large < 31 ? large : 31;
}


struct NsaUnit { int b, grp, t0; };
__device__ __forceinline__ NsaUnit nsa_decode(int u) {
    const int p = u >> 1, s2 = u & 1, k = p >> 8, w = p & 255, bg = (w & 7) + 8 * k, i = ((w >> 3) + 8 * k) & 31;
    NsaUnit r; r.b = bg >> 2; r.grp = bg & 3; r.t0 = s2 ? 32 * i : 32 * (63 - i); return r; }
__device__ __forceinline__ void nsa_issue_cmp(LAS unsigned char* lds, const NsaT& A, const NsaUnit& U, const Geo& g) {
    const bf16_t* Kc = A.KC + (size_t)(U.b * NGRP + U.grp) * 128 * 128; const bf16_t* Vc = A.VC + (size_t)(U.b * NGRP + U.grp) * 128 * 128;
    const DmaOff dc = make_dma(g, 128);
    dma_tile(lds, 0, Kc, Vc, 128, 0, dc, g); dma_tile(lds, 1, Kc, Vc, 128, 64, dc, g);
}
__device__ __forceinline__ void nsa_unit(LAS unsigned char* lds, const NsaT& A, const NsaUnit U, bool build_bt) {
    const Geo g = make_geo(lds);
    __syncthreads();
    nsa_issue_cmp(lds, A, U, g);
    const int b = U.b, grp = U.grp, t0 = U.t0, h = grp * 8 + g.wid;
    LAS float* IMP = (LAS float*)(lds + OFF_IMP); LAS float* FIN = (LAS float*)(lds + OFF_FIN); LAS unsigned* SELM = (LAS unsigned*)(lds + OFF_SELM);
    LAS float* BT = (LAS float*)(lds + OFF_BT); LAS float* wsl = (LAS float*)(lds + OFF_WS) + g.wid * 64;
    const LAS float* btw = BT + g.wid * 132;
    float gates[3];
    { const float* gp = A.Gt + (size_t)(b * SEQ + t0) * NGATE + h + (unsigned)(g.r32 * NGATE);
#pragma unroll
      for (int br = 0; br < 3; ++br) gates[br] = gp[br * 32]; }
    bf16x8 qr[8];
    { const bf16_t* qp = A.Q + (size_t)(b * SEQ + t0) * DM + h * 128 + (unsigned)(g.r32 * DM + g.hi * 8);
#pragma unroll
      for (int d0 = 0; d0 < 8; ++d0) qr[d0] = *(const bf16x8*)(qp + d0 * 16); }
    if (build_bt) for (int e = g.tid; e < 8 * 129; e += 512) { const int r = e / 129, d = e - r * 129; BT[r * 132 + d] = A.rel_bias[t5_bucket(d) * NH + grp * 8 + r] * LOG2E; }
    const bf16_t* Ks = A.KV + (size_t)(b * SEQ) * KVW + 1024 + grp * 128; const bf16_t* Vs = Ks + 512;
    const bf16_t* Kw = Ks + 1024; const bf16_t* Vw = Kw + 512;
    const DmaOff dof = make_dma(g, KVW);
    f32x16 o[4]; float l_reg;
    unsigned selword, um;
    WAIT_VM(0);
    __syncthreads();
    {
        f32x16 pA0, pA1, pB0, pB1;
        qkt(pA0, pA1, lds, 0, g, qr); qkt(pB0, pB1, lds, 1, g, qr);
        constexpr float C2 = SM_SCALE * LOG2E; const float NEG = -__builtin_inff();
        const int dbase = t0 + g.r32 - 31 - 64 * g.hi;
        float pmax = NEG;
#pragma unroll
        for (int r = 0; r < 16; ++r) { const int c = (r & 3) + 8 * (r >> 2);
#define CSC(P, NL) do { const int dist = dbase - 16 * (NL); const unsigned ud = (unsigned)dist; const float bb = btw[ud < 128u ? ud : 128u]; \
            P[r] = dist >= 0 ? fmaf(P[r], C2, bb) : NEG; pmax = fmaxf(pmax, P[r]); } while (0)
            CSC(pA0, c); CSC(pA1, c + 32); CSC(pB0, c + 64); CSC(pB1, c + 96);
#undef CSC
        }
        pmax = pair_max(pmax);
        const float mref = (pmax == NEG) ? 0.f : pmax;
        float ps = 0.f;
#pragma unroll
        for (int r = 0; r < 16; ++r) { pA0[r] = fast_exp2(pA0[r] - mref); pA1[r] = fast_exp2(pA1[r] - mref); pB0[r] = fast_exp2(pB0[r] - mref); pB1[r] = fast_exp2(pB1[r] - mref);
            ps += (pA0[r] + pA1[r]) + (pB0[r] + pB1[r]); }
        ps = pair_sum(ps);
        l_reg = ps;
        const float inv = ps > 0.f ? 1.0f / ps : 0.f;
        float qs[16], e3[16];
#pragma unroll
        for (int i = 0; i < 4; ++i) {
            qs[0 + i] = ((pA0[4 * i] + pA0[4 * i + 1]) + (pA0[4 * i + 2] + pA0[4 * i + 3])) * inv; e3[0 + i] = pA0[4 * i + 3] * inv;
            qs[4 + i] = ((pA1[4 * i] + pA1[4 * i + 1]) + (pA1[4 * i + 2] + pA1[4 * i + 3])) * inv; e3[4 + i] = pA1[4 * i + 3] * inv;
            qs[8 + i] = ((pB0[4 * i] + pB0[4 * i + 1]) + (pB0[4 * i + 2] + pB0[4 * i + 3])) * inv; e3[8 + i] = pB0[4 * i + 3] * inv;
            qs[12 + i] = ((pB1[4 * i] + pB1[4 * i + 1]) + (pB1[4 * i + 2] + pB1[4 * i + 3])) * inv; e3[12 + i] = pB1[4 * i + 3] * inv;
        }
        { LAS float* ip = IMP + (g.wid * 32 + g.r32) * 33;
          float prev_hi1 = 0.f;
#pragma unroll
          for (int idx = 0; idx < 16; ++idx) { float lo, hi1; pair_vals(e3[idx], lo, hi1);
              const float add = g.hi ? lo : prev_hi1;
              ip[2 * idx + g.hi] = qs[idx] + add; prev_hi1 = hi1; } }
        bf16x8 a0, a1, a2, a3, c0, c1, c2, c3;
        pack_p(pA0, pA1, a0, a1, a2, a3); pack_p(pB0, pB1, c0, c1, c2, c3);
#pragma unroll
        for (int d = 0; d < 4; ++d) o[d] = f32x16{};
        pv_tile(o, g.vb0, a0, a1, a2, a3); pv_tile(o, g.vb0 + SHM_V, c0, c1, c2, c3);
    }
    LDS_WAIT();
    __syncthreads();
    dma_tile(lds, 0, Ks, Vs, KVW, 0, dof, g);
    {
        const int tl = g.tid >> 4, j0 = (g.tid & 15) * 2, tok = t0 + tl, cur = tok >> 6;
        float v2[2];
#pragma unroll
        for (int e = 0; e < 2; ++e) { const int j = j0 + e; float v = 0.f;
#pragma unroll
            for (int r = 0; r < 8; ++r) v += IMP[(r * 32 + tl) * 33 + j];
            const bool forced = (j == 0) || (j == cur) || (j == cur - 1), valid = (64 * j <= tok);
            v = forced ? 1.0e6f : (valid ? v : -1.0f); v2[e] = v; FIN[tl * 33 + j] = v; }
        LDS_WAIT();
        __syncthreads();
        unsigned bits = 0u;
#pragma unroll
        for (int e = 0; e < 2; ++e) { const int j = j0 + e; int cnt = 0;
#pragma unroll
            for (int i = 0; i < 32; ++i) { const float w = FIN[tl * 33 + i]; cnt += (w > v2[e] || (w == v2[e] && i < j)) ? 1 : 0; }
            if (cnt < 16) bits |= 1u << j; }
        bits |= (unsigned)__builtin_amdgcn_update_dpp(0, (int)bits, 0xB1, 0xF, 0xF, true);
        bits |= (unsigned)__builtin_amdgcn_update_dpp(0, (int)bits, 0x4E, 0xF, 0xF, true);
        bits |= (unsigned)__builtin_amdgcn_update_dpp(0, (int)bits, 0x141, 0xF, 0xF, true);
        bits |= (unsigned)__builtin_amdgcn_update_dpp(0, (int)bits, 0x140, 0xF, 0xF, true);
        if ((g.tid & 15) == 0) SELM[tl] = bits;
        LDS_WAIT();
        __syncthreads();
        selword = SELM[g.r32]; um = selword;
        um |= __shfl_xor(um, 1); um |= __shfl_xor(um, 2); um |= __shfl_xor(um, 4); um |= __shfl_xor(um, 8); um |= __shfl_xor(um, 16);
        const int jmax = (t0 + 31) >> 6;
        um = __builtin_amdgcn_readfirstlane(um) & (jmax >= 31 ? 0xffffffffu : ((2u << jmax) - 1u));
    }
    TileIter its = ti_init<1>(um, 0, 0);
    if (its.j1 >= 0) dma_tile(lds, 1, Ks, Vs, KVW, 64 * its.j1, dof, g);
    const bf16_t* zb = A.Z + (size_t)(b * SEQ + t0) * ZW + h * 128;
    bf16_t* mb = A.MIX + (size_t)(b * SEQ + t0) * DM + h * 128;
    emit_tile<false, true>(lds, o, (l_reg > 0.f ? 1.0f / l_reg : 0.f) * gates[0], zb, ZW, mb, wsl, g);
    branch_run<1>(o, l_reg, lds, its, Ks, Vs, KVW, dof, qr, selword, t0, btw, wsl + 32, g);
    const int lowk = t0 - 511;
    TileIter itw = ti_init<2>(0u, lowk > 0 ? lowk >> 6 : 0, (t0 + 31) >> 6);
    branch_issue(lds, itw, Kw, Vw, KVW, dof, g);
    emit_tile<true, true>(lds, o, (1.0f / l_reg) * gates[1], zb + 4096, ZW, mb, wsl, g);
    branch_run<2>(o, l_reg, lds, itw, Kw, Vw, KVW, dof, qr, 0u, t0, btw, wsl + 32, g);
    emit_tile<true, true>(lds, o, (1.0f / l_reg) * gates[2], zb + 8192, ZW, mb, wsl, g);
}
__device__ __forceinline__ void nsa_phase(LAS unsigned char* lds, const NsaT& A) {
    const int G = gridDim.x, first = 2 * (int)blockIdx.x;
    if (first >= 2048) return;
    int prev_grp = -1;
#pragma unroll 1
    for (int u = first; u < 2048; u = (u & 1) ? u + 2 * G - 1 : u + 1) {
        const NsaUnit U = nsa_decode(u);
        nsa_unit(lds, A, U, U.grp != prev_grp);
        prev_grp = U.grp;
    }
    VM_WAIT();
    __syncthreads();
}

constexpr bool SB_EARLY_EXIT = true;
constexpr float SB_PCUT = 1.0e-37f;
struct SbT { const bf16_t* QZ; const bf16_t* KVSH; bf16_t* MIX; };
struct SbUnit { int b, h, qb; };
__device__ __forceinline__ SbUnit sb_decode(int u) {
    const int p = u >> 1, s2 = u & 1, k = p >> 8, w = p & 255, bh = k * 64 + (w & 7) * 8 + (w >> 5), pi = ((w >> 3) + k) & 3;
    SbUnit r; r.b = bh >> 5; r.h = bh & 31; r.qb = s2 ? pi : 7 - pi; return r; }
__device__ __forceinline__ void sb_issue(LAS unsigned char* lds, const SbT& A, const SbUnit& U, const Geo& g) {
    const bf16_t* Kp = A.KVSH + (size_t)(U.b * SEQ) * 8192 + U.h * 128; const bf16_t* Vp = Kp + 4096;
    const DmaOff dof = make_dma(g, 8192); const int j = 4 * U.qb + 3;
    dma_tile(lds, 0, Kp, Vp, 8192, 64 * j, dof, g); dma_tile(lds, 1, Kp, Vp, 8192, 64 * (j - 1), dof, g);
}
__device__ __forceinline__ void sb_unit(LAS unsigned char* lds, const SbT& A, const SbUnit U, bool has_next, const SbUnit UN) {
    const Geo g = make_geo(lds);
    const int b = U.b, h = U.h, qb = U.qb;
    LAS unsigned* DONE = (LAS unsigned*)(lds + OFF_DONE);
    const int tw0 = qb * 256 + g.wid * 32, t = tw0 + g.r32;
    bf16x8 qr[8];
    { const bf16_t* qp = A.QZ + (size_t)(b * SEQ + tw0) * 8192 + h * 128 + (unsigned)(g.r32 * 8192 + g.hi * 8);
#pragma unroll
      for (int d0 = 0; d0 < 8; ++d0) qr[d0] = *(const bf16x8*)(qp + d0 * 16); }
    const bf16_t* Kp = A.KVSH + (size_t)(b * SEQ) * 8192 + h * 128; const bf16_t* Vp = Kp + 4096;
    f32x16 o[4];
#pragma unroll
    for (int d = 0; d < 4; ++d) o[d] = f32x16{};
    float PR = 1.0f; bool wdone = false;
    const DmaOff dof = make_dma(g, 8192);
    int j = 4 * qb + 3, bank = 0, slot = 0;
    for (int step = 0;; ++step) {
        if (step > 0 && j >= 1) WAIT_VM(4); else WAIT_VM(0);
        RAW_BAR();
        if (SB_EARLY_EXIT && step > 0) { unsigned all = 1u;
#pragma unroll
            for (int w = 0; w < 8; ++w) all &= DONE[bank * 8 + w];
            bank ^= 1;
            if (__builtin_amdgcn_readfirstlane(all)) break; }
        if (j >= 2) dma_tile(lds, slot >= 1 ? slot - 1 : 2, Kp, Vp, 8192, 64 * (j - 2), dof, g);
        const int kb = 64 * j;
        const bool active = (kb <= tw0 + 30) && !wdone;
        if (active) {
            f32x16 p0, p1;
            qkt(p0, p1, lds, slot, g, qr);
            const bool needmask = (kb + 63 >= tw0);
            const int dq = t - kb - 4 * g.hi;
            constexpr float ZS = SM_SCALE * LOG2E;
            float rr0[16], rr1[16];
#pragma unroll
            for (int r = 0; r < 16; ++r) { const int c = (r & 3) + 8 * (r >> 2);
                float e0 = fast_exp2(fminf(p0[r] * ZS, 64.0f)), e1 = fast_exp2(fminf(p1[r] * ZS, 64.0f));
                if (needmask) { e0 = (dq - c > 0) ? e0 : 0.f; e1 = (dq - c - 32 > 0) ? e1 : 0.f; }
                p0[r] = e0; p1[r] = e1; rr0[r] = fast_rcp(1.0f + e0); rr1[r] = fast_rcp(1.0f + e1); }
            float tot[8];
#pragma unroll
            for (int i = 0; i < 4; ++i) {
                rr0[4 * i + 2] *= rr0[4 * i + 3]; rr0[4 * i + 1] *= rr0[4 * i + 2]; rr0[4 * i] *= rr0[4 * i + 1]; tot[i] = rr0[4 * i];
                rr1[4 * i + 2] *= rr1[4 * i + 3]; rr1[4 * i + 1] *= rr1[4 * i + 2]; rr1[4 * i] *= rr1[4 * i + 1]; tot[4 + i] = rr1[4 * i];
            }
            float off[8]; float suf = PR;
#pragma unroll
            for (int idx = 7; idx >= 0; --idx) { float t0_, t1_; pair_vals(tot[idx], t0_, t1_);
                const float oh1 = suf; suf *= t1_; const float oh0 = suf; suf *= t0_; off[idx] = g.hi ? oh1 : oh0; }
            PR = suf;
#pragma unroll
            for (int r = 0; r < 16; ++r) { p0[r] *= rr0[r] * off[r >> 2]; p1[r] *= rr1[r] * off[4 + (r >> 2)]; }
            bf16x8 pa0, pa1, pa2, pa3; pack_p(p0, p1, pa0, pa1, pa2, pa3);
            pv_tile(o, g.vb0 + slot * SHM_V, pa0, pa1, pa2, pa3);
            if (SB_EARLY_EXIT) wdone = __all(PR < SB_PCUT);
        }
        if (SB_EARLY_EXIT && g.lane == 0) DONE[bank * 8 + g.wid] = wdone ? 1u : 0u;
        if (j == 0) break;
        --j; slot = slot == 2 ? 0 : slot + 1;
    }
    WAIT_VM(0);
    RAW_BAR();
    if (has_next) sb_issue(lds, A, UN, g);
    emit_tile<false, false>(lds, o, 1.0f, A.QZ + (size_t)(b * SEQ + tw0) * 8192 + 4096 + h * 128, 8192, A.MIX + (size_t)(b * SEQ + tw0) * DM + h * 128, (LAS float*)(lds + OFF_WS), g);
}
__device__ __forceinline__ void sb_phase(LAS unsigned char* lds, const SbT& A) {
    const int G = gridDim.x, first = 2 * (int)blockIdx.x;
    if (first >= 2048) return;
    { const Geo g = make_geo(lds); sb_issue(lds, A, sb_decode(first), g); }
#pragma unroll 1
    for (int u = first; u < 2048; u = (u & 1) ? u + 2 * G - 1 : u + 1) {
        const int un = (u & 1) ? u + 2 * G - 1 : u + 1; const bool has_next = un < 2048;
        sb_unit(lds, A, sb_decode(u), has_next, sb_decode(has_next ? un : u));
    }
    VM_WAIT();
    __syncthreads();
}
}

constexpr int NPHASES = 16;
__global__ void __launch_bounds__(512, 2) yoco_fwd(Params P) {
    extern __shared__ __attribute__((aligned(16))) unsigned char lds_raw[];
    LAS unsigned char* lds = (LAS unsigned char*)lds_raw;
    const int G = gridDim.x;
    volatile LAS unsigned* MISC = (volatile LAS unsigned*)(lds + MISC_OFF);
    { const int t0_ = tid_now(); if (t0_ < 64) MISC[t0_] = 0u; }
    __syncthreads();
    unsigned char* ws = P.ws;
    XcdBarrier bar = xcd_barrier_post((unsigned*)(ws + WS_CTL), MISC + 8);
    const int lo = P.ph_lo, hi = P.ph_hi;
#define IN(k) (lo <= (k) && (k) < hi)
#define SEAM(k) do { if (IN(k) && IN((k) + 1)) xcd_barrier(bar); } while (0)
    bf16_t* HN = (bf16_t*)(ws + WS_HN); bf16_t* XB = (bf16_t*)(ws + WS_XB); float* SS = (float*)(ws + WS_SS); float* SSP = (float*)(ws + WS_SSP);

    if (IN(0)) phase_prologue(P, lds);
    SEAM(0);

#pragma unroll
    for (int l = 0; l < 2; ++l) {
        const int pb = 1 + 4 * l;
        if (IN(pb)) {
            pg8::Gemm g{XB, (const bf16_t*)(ws + WS_WAIN + l * WAIN_BYTES), MTOK, NSA_N, DM}; pg8::StaticOrder S; S.init(MTOK, NSA_N, G, (int)blockIdx.x);
            const int fm = 8 * ((int)blockIdx.x & 7); LAS float* RS = (LAS float*)(lds + 131072);
            const float* ssrc = l == 0 ? SS : SSP; const int np = l == 0 ? 1 : SS_NP;
            { const int i4 = tid_now() * 4; f32x4 s4 = {0.f, 0.f, 0.f, 0.f};
#pragma unroll 8
              for (int p = 0; p < np; ++p) s4 += *(const f32x4*)(ssrc + (size_t)p * MTOK + fm * 256 + i4);
#pragma unroll
              for (int k = 0; k < 4; ++k) RS[i4 + k] = 1.0f / sqrtf(s4[k] * (1.0f / DM) + RMS_EPS); }
            __syncthreads();
            pg8::EpiSplit E{(bf16_t*)(ws + WS_Q), DM, 16, (bf16_t*)(ws + WS_KV), KVW, 28, (bf16_t*)(ws + WS_Z), ZW, ssrc, RS, fm, np};
            pg8::gemm_phase<pg8::EpiSplit, pg8::StaticOrder, true, true>(lds, g, S, E);
        }
        SEAM(pb);
        if (IN(pb + 1)) {
            for (int u = blockIdx.x; u < 256; u += G) { compress_unit(P, l, u, lds); gate_unit(P, l, u, lds); }
        }
        SEAM(pb + 1);
        if (IN(pb + 2)) {
            att::NsaT A{(const bf16_t*)(ws + WS_Q), (const bf16_t*)(ws + WS_KV), (const bf16_t*)(ws + WS_Z), (const float*)(ws + WS_G),
                        (const bf16_t*)(ws + WS_KC), (const bf16_t*)(ws + WS_VC), HN, P.in[1]};
            att::nsa_phase(lds, A);
        }
        SEAM(pb + 2);
        if (IN(pb + 3)) {
            pg8::Gemm g{HN, (const bf16_t*)(ws + WS_WAOUT + l * WOUT_BYTES), MTOK, DM, DM}; pg8::StaticOrder S; S.init(MTOK, DM, G, (int)blockIdx.x);
            pg8::EpiRes E{XB, P.out, DM, SSP, 0};
            pg8::gemm_phase<pg8::EpiRes, pg8::StaticOrder, true, true>(lds, g, S, E);
        }
        SEAM(pb + 3);
    }

#pragma unroll
    for (int l = 2; l < 4; ++l) {
        const int pb = 9 + 3 * (l - 2);
        if (IN(pb)) {
            const int N = (l == 2) ? 16384 : 8192;
            pg8::Gemm g{XB, (const bf16_t*)(ws + (l == 2 ? WS_WKVQ : WS_WB3)), MTOK, N, DM}; pg8::StaticOrder S; S.init(MTOK, N, G, (int)blockIdx.x);
            const int fm = 8 * ((int)blockIdx.x & 7); LAS float* RS = (LAS float*)(lds + 131072);
            const float* ssrc = SSP; const int np = SS_NP;
            { const int i4 = tid_now() * 4; f32x4 s4 = {0.f, 0.f, 0.f, 0.f};
#pragma unroll 8
              for (int p = 0; p < np; ++p) s4 += *(const f32x4*)(ssrc + (size_t)p * MTOK + fm * 256 + i4);
#pragma unroll
              for (int k = 0; k < 4; ++k) RS[i4 + k] = 1.0f / sqrtf(s4[k] * (1.0f / DM) + RMS_EPS); }
            __syncthreads();
            pg8::EpiSplit E{(bf16_t*)(ws + (l == 2 ? WS_KVSH : WS_QZ)), 8192, 32, (bf16_t*)(ws + WS_QZ), 8192, 1 << 20, nullptr, 0, ssrc, RS, fm, np};
            pg8::gemm_phase<pg8::EpiSplit, pg8::StaticOrder, true, true>(lds, g, S, E);
        }
        SEAM(pb);
        if (IN(pb + 1)) {
            att::SbT A{(const bf16_t*)(ws + WS_QZ), (const bf16_t*)(ws + WS_KVSH), HN};
            att::sb_phase(lds, A);
        }
        SEAM(pb + 1);
        if (IN(pb + 2)) {
            pg8::Gemm g{HN, (const bf16_t*)(ws + WS_WBOUT + (l - 2) * WOUT_BYTES), MTOK, DM, DM}; pg8::StaticOrder S; S.init(MTOK, DM, G, (int)blockIdx.x);
            pg8::EpiRes E{XB, P.out, DM, SSP, 0};
            pg8::gemm_phase<pg8::EpiRes, pg8::StaticOrder, true, true>(lds, g, S, E);
        }
        SEAM(pb + 2);
    }
    if (IN(15)) phase_final_norm(XB, P.out, P.in[26], SSP, lds);
#undef IN
#undef SEAM
}

extern "C" void kernel_launch(void* const* d_in, const int* in_sizes, int n_in, void* d_out, int out_size, void* d_ws, size_t ws_size, hipStream_t stream) {
    static int grid = 0;
    if (grid == 0) {
        if (n_in != 27 || out_size != MTOK * DM || ws_size < WS_END) { fprintf(stderr, "kernel_launch: unexpected shapes (n_in %d, out %d, ws %zu < %zu)\n", n_in, out_size, ws_size, (size_t)WS_END); grid = -1; return; }
        int dev = 0, cus = 0, per_cu = 0;
        if (hipGetDevice(&dev) != hipSuccess || hipDeviceGetAttribute(&cus, hipDeviceAttributeMultiprocessorCount, dev) != hipSuccess || cus <= 0) { grid = -1; return; }
        if (hipFuncSetAttribute((const void*)yoco_fwd, hipFuncAttributeMaxDynamicSharedMemorySize, LDS_BYTES) != hipSuccess) { fprintf(stderr, "kernel_launch: hipFuncSetAttribute failed\n"); grid = -1; return; }
        if (hipOccupancyMaxActiveBlocksPerMultiprocessor(&per_cu, (const void*)yoco_fwd, 512, LDS_BYTES) != hipSuccess || per_cu < 1) { fprintf(stderr, "kernel_launch: occupancy query says %d\n", per_cu); }
        (void)hipGetLastError();
        grid = cus;
    }
    if (grid < 0) return;
    (void)hipMemsetAsync((char*)d_ws + WS_CTL, 0, CTL_ZERO_BYTES, stream);
    Params p{};
    for (int i = 0; i < 27; ++i) p.in[i] = (const float*)d_in[i];
    p.out = (float*)d_out; p.ws = (unsigned char*)d_ws;
    p.ph_lo = 0; p.ph_hi = NPHASES;
    hipLaunchKernelGGL(yoco_fwd, dim3(grid), dim3(512), LDS_BYTES, stream, p);
}
```

```cpp
#include <hip/hip_runtime.h>
#include <cstdio>
#include <cstdint>

#define LAS __attribute__((address_space(3)))
#define GAS __attribute__((address_space(1)))
typedef unsigned short bf16_t;
typedef short bf16x8 __attribute__((ext_vector_type(8)));
typedef short s16x4 __attribute__((ext_vector_type(4)));
typedef float f32x4 __attribute__((ext_vector_type(4)));
typedef float f32x16 __attribute__((ext_vector_type(16)));
typedef unsigned u32x4 __attribute__((ext_vector_type(4)));
typedef unsigned u32x2 __attribute__((ext_vector_type(2)));

constexpr int BATCH = 8, SEQ = 2048, DM = 4096, NH = 32, HD = 128, NGRP = 4, GSZ = 8;
constexpr int MTOK = BATCH * SEQ;
constexpr int NSA_N = 19456;
constexpr int KVW = 3072, ZW = 12288, NGATE = 96;
constexpr int NCMP = 127;
constexpr float RMS_EPS = 1e-6f;
constexpr float SM_SCALE = 0.08838834764831845f;
constexpr float LOG2E = 1.4426950408889634f;
constexpr float LN2 = 0.6931471805599453f;

constexpr size_t MiB = 1u << 20;
constexpr size_t WS_CTL = 0, CTL_ZERO_BYTES = 32 * 1024;
constexpr int XCD_BAR_WORDS_MAX = 3456;
constexpr size_t WS_SS = 64 * 1024;
constexpr size_t WS_C1 = 1 * MiB;
constexpr size_t WS_KC = 2 * MiB;
constexpr size_t WS_VC = 3 * MiB;
constexpr size_t WS_W2T = 4 * MiB;
constexpr size_t WS_W1T = 8 * MiB;
constexpr size_t WS_SSP = 12 * MiB;
constexpr int SS_NP = 64;
constexpr size_t WS_WG = 16 * MiB;
constexpr size_t WS_WAIN = 20 * MiB;
constexpr size_t WAIN_BYTES = (size_t)NSA_N * DM * 2;
constexpr size_t WS_WAOUT = WS_WAIN + 2 * WAIN_BYTES;
constexpr size_t WOUT_BYTES = (size_t)DM * DM * 2;
constexpr size_t WS_WKVQ = WS_WAOUT + 2 * WOUT_BYTES;
constexpr size_t WS_WB3 = WS_WKVQ + (size_t)16384 * DM * 2;
constexpr size_t WS_WBOUT = WS_WB3 + (size_t)8192 * DM * 2;
constexpr size_t WS_HN = WS_WBOUT + 2 * WOUT_BYTES;
constexpr size_t WS_PROJ = WS_HN + (size_t)MTOK * DM * 2;
constexpr size_t WS_Q = WS_PROJ;
constexpr size_t WS_KV = WS_Q + (size_t)MTOK * DM * 2;
constexpr size_t WS_Z = WS_KV + (size_t)MTOK * KVW * 2;
constexpr size_t WS_G = WS_Z + (size_t)MTOK * ZW * 2;
constexpr size_t WS_KVSH = WS_PROJ;
constexpr size_t WS_QZ = WS_KVSH + (size_t)MTOK * 8192 * 2;
constexpr size_t WS_XB = WS_G + (size_t)MTOK * NGATE * 4;
constexpr size_t WS_END = WS_XB + (size_t)MTOK * DM * 2;
static_assert(WS_END <= (size_t)1515 * MiB, "d_ws map must fit the guaranteed workspace (sum of inputs = 1515 MiB)");
static_assert(WS_QZ + (size_t)MTOK * 8192 * 2 <= WS_XB, "SB overlay");
static_assert(XCD_BAR_WORDS_MAX * 4 <= CTL_ZERO_BYTES, "barrier words inside the memset region");

constexpr int LDS_BYTES = 147456;
constexpr int MISC_OFF = LDS_BYTES - 256;

__device__ __forceinline__ float row_sumsq(const float* ss, int np, int row) {
    float s = 0.f;
#pragma unroll 8
    for (int p = 0; p < np; ++p) s += ss[(size_t)p * MTOK + row];
    return s;
}
namespace pg8 {
#define PG8_LAS __attribute__((address_space(3)))
typedef unsigned short bf16_t;
typedef short bf16x8 __attribute__((ext_vector_type(8)));
typedef float f32x4 __attribute__((ext_vector_type(4)));
typedef unsigned u32x4 __attribute__((ext_vector_type(4)));
constexpr int BM = 256, BK = 64, HALF = 128, HTB = HALF * BK * 2  , STAGE_BYTES = 8 * HTB, NXCD = 8, WGM = 8;

__host__ __device__ __forceinline__ int lds_byte(int r, int c) { const int st = (r >> 4) * 2 + (c >> 5), rr = r & 15, cc = c & 31, ob = rr * 64 + cc * 2; return st * 1024 + (ob ^ (((ob >> 9) & 1) << 5)); }
__host__ __device__ __forceinline__ void stage_rc(int b, int& R, int& C) { const int st = b / 1024, sb = b % 1024, swz = sb ^ (((sb >> 9) & 1) << 5); R = (st >> 1) * 16 + swz / 64; C = (st & 1) * 32 + (swz % 64) / 2; }
__host__ __device__ __forceinline__ int perm32(int rho) { const int n = rho >> 4, i = rho & 15; return 8 * (i >> 2) + 4 * n + (i & 3); }

struct Unit { int pm, pn; };
struct Gemm { const bf16_t* A; const bf16_t* Bt; int M, N, K; };

struct StaticOrder {
    int nM, nN, nwg, G, c;
    __host__ __device__ void init(int M, int N, int G_, int c_) { nM = M / BM; nN = N / BM; nwg = nM * nN; G = G_; c = c_; }
    __host__ __device__ bool next(int i, Unit& u) const {
        const long L = (long)i * G + c; if (L >= nwg) return false;
        int wgid = (int)L; { const int q = nwg / NXCD, r = nwg % NXCD, xcd = wgid % NXCD, off = wgid / NXCD; wgid = (xcd < r ? xcd * (q + 1) : r * (q + 1) + (xcd - r) * q) + off; }
        const int nig = WGM * nN, gid = wgid / nig, fm = gid * WGM, gsz = (nM - fm) < WGM ? (nM - fm) : WGM;
        u.pm = fm + ((wgid % nig) % gsz); u.pn = (wgid % nig) / gsz; return true;
    }
    __device__ __forceinline__ void a_ready(const Unit&) const {}
    __device__ __forceinline__ void done(const Unit&) const {}
};


__device__ __forceinline__ unsigned cvt_pk_bf16(float lo, float hi) { unsigned r; asm volatile("v_cvt_pk_bf16_f32 %0, %1, %2" : "=v"(r) : "v"(lo), "v"(hi)); return r; }

struct EpiSplit {
    static constexpr bool PERM = true, AFTER_DRAIN = false;
    bf16_t* O0; int ld0; int t1; bf16_t* O1; int ld1; int t2; bf16_t* O2; int ld2; const float* ss; const PG8_LAS float* rs_lds; int fm; int np;
    __device__ __forceinline__ void operator()(const f32x4 (&acc)[2][2][4][2], const Unit& u, int wr, int wc, int fr, int fq) const {
        const int row0 = u.pm * BM + wr * 64 + fr;
        bf16_t* base; int ldc, ct;
        if (u.pn < t1) { base = O0; ldc = ld0; ct = u.pn; } else if (u.pn < t2) { base = O1; ldc = ld1; ct = u.pn - t1; } else { base = O2; ldc = ld2; ct = u.pn - t2; }
        const int col0 = ct * BM + wc * 32 + 8 * fq;
#pragma unroll
        for (int ai = 0; ai < 2; ++ai)
#pragma unroll
            for (int m = 0; m < 4; ++m) { bf16_t* rowp = base + (size_t)(row0 + ai * HALF + m * 16) * ldc + col0;
                const unsigned pl = (unsigned)(u.pm - fm);
                const float rs = pl < 8u ? rs_lds[pl * BM + wr * 64 + fr + ai * HALF + m * 16] : 1.0f / sqrtf(row_sumsq(ss, np, row0 + ai * HALF + m * 16) * (1.0f / 4096.0f) + 1e-6f);
#pragma unroll
                for (int bj = 0; bj < 2; ++bj) { const f32x4 v0 = acc[ai][bj][m][0] * rs, v1 = acc[ai][bj][m][1] * rs;
                    u32x4 w; w.x = cvt_pk_bf16(v0[0], v0[1]); w.y = cvt_pk_bf16(v0[2], v0[3]); w.z = cvt_pk_bf16(v1[0], v1[1]); w.w = cvt_pk_bf16(v1[2], v1[3]);
                    *(u32x4*)(rowp + bj * HALF) = w; } }
    }
};
struct EpiRes {
    static constexpr bool PERM = true, AFTER_DRAIN = false;
    bf16_t* xb; float* out; int ldc; float* ssp; int last;
    __device__ __forceinline__ void operator()(const f32x4 (&acc)[2][2][4][2], const Unit& u, int wr, int wc, int fr, int fq) const {
        const int row0 = u.pm * BM + wr * 64 + fr, col0 = u.pn * BM + wc * 32 + 8 * fq;
        float* sp = ssp + (size_t)(u.pn * 4 + wc) * MTOK;
        u32x4 r[2][4][2];
#pragma unroll
        for (int ai = 0; ai < 2; ++ai)
#pragma unroll
            for (int m = 0; m < 4; ++m) { const size_t off = (size_t)(row0 + ai * HALF + m * 16) * ldc + col0;
#pragma unroll
                for (int bj = 0; bj < 2; ++bj) r[ai][m][bj] = *(const u32x4*)(xb + off + bj * HALF); }
#pragma unroll
        for (int ai = 0; ai < 2; ++ai) {
#pragma unroll
            for (int m = 0; m < 4; ++m) { const size_t off = (size_t)(row0 + ai * HALF + m * 16) * ldc + col0;
                float sq = 0.f;
#pragma unroll
                for (int bj = 0; bj < 2; ++bj) { const u32x4 rv = r[ai][m][bj];
                    const f32x4 o0 = (f32x4){__uint_as_float(rv.x << 16), __uint_as_float(rv.x & 0xffff0000u), __uint_as_float(rv.y << 16), __uint_as_float(rv.y & 0xffff0000u)} + acc[ai][bj][m][0];
                    const f32x4 o1 = (f32x4){__uint_as_float(rv.z << 16), __uint_as_float(rv.z & 0xffff0000u), __uint_as_float(rv.w << 16), __uint_as_float(rv.w & 0xffff0000u)} + acc[ai][bj][m][1];
                    sq += ((o0[0] * o0[0] + o0[1] * o0[1]) + (o0[2] * o0[2] + o0[3] * o0[3])) + ((o1[0] * o1[0] + o1[1] * o1[1]) + (o1[2] * o1[2] + o1[3] * o1[3]));
                    u32x4 w; w.x = cvt_pk_bf16(o0[0], o0[1]); w.y = cvt_pk_bf16(o0[2], o0[3]); w.z = cvt_pk_bf16(o1[0], o1[1]); w.w = cvt_pk_bf16(o1[2], o1[3]); *(u32x4*)(xb + off + bj * HALF) = w; }
                sq += __shfl_xor(sq, 16); sq += __shfl_xor(sq, 32);
                if (fq == 0) sp[row0 + ai * HALF + m * 16] = sq; }
            asm volatile("" ::: "memory");
        }
    }
};
template <class Epi, class Sched, bool ALIGN_EPI = false, bool SP2 = false>
__device__ __forceinline__ void gemm_phase(PG8_LAS unsigned char* lds, const Gemm g, const Sched& S, const Epi& E) {
    int tid_ = (int)threadIdx.x; asm volatile("" : "+v"(tid_));
    const int tid = tid_, wid = __builtin_amdgcn_readfirstlane(tid >> 6), lane = tid & 63, wr = wid >> 2, wc = wid & 3, fr = lane & 15, fq = lane >> 4;
    const int K = g.K, nt = K / BK;
    unsigned voffA[2], voffB[2];
#pragma unroll
    for (int i = 0; i < 2; ++i) { int R, C; stage_rc(tid * 16 + i * 8192, R, C); const int Rb = Epi::PERM ? ((R & ~31) + perm32(R & 31)) : R;
        voffA[i] = (unsigned)(R * K + C) * 2u; voffB[i] = (unsigned)(Rb * K + C) * 2u; }
    asm volatile("" : "+v"(voffA[0]), "+v"(voffA[1]), "+v"(voffB[0]), "+v"(voffB[1]));
    const size_t kstep = (size_t)(BK * 2);
    const size_t hstep = (size_t)HALF * K * 2;
    const size_t tstep = 2 * hstep;
    const unsigned ldsw = (unsigned)wid * 1024u;
    const int aoff = lds_byte(wr * 64 + fr, fq * 8), boff = lds_byte(wc * 32 + fr, fq * 8);
#define PG8_SA(b, h) (((b) * 2 + (h)) * HTB)
#define PG8_SB(b, h) ((4 + (b) * 2 + (h)) * HTB)
#define PG8_STAGE(bufoff, gbase, voff) do { _Pragma("unroll") for (int _i = 0; _i < 2; ++_i) \
        __builtin_amdgcn_global_load_lds((const unsigned*)((const char*)(gbase) + (voff)[_i]), (PG8_LAS unsigned*)(lds + (bufoff) + ldsw + _i * 8192), 16, 0, 0); } while (0)
#define PG8_LDA(dst, b, h) do { _Pragma("unroll") for (int m = 0; m < 4; ++m) _Pragma("unroll") for (int k = 0; k < 2; ++k) dst[m][k] = *(const PG8_LAS bf16x8*)(lds + PG8_SA(b, h) + aoff + m * 2048 + k * 1024); } while (0)
#define PG8_LDB(dst, b, h) do { _Pragma("unroll") for (int n = 0; n < 2; ++n) _Pragma("unroll") for (int k = 0; k < 2; ++k) dst[n][k] = *(const PG8_LAS bf16x8*)(lds + PG8_SB(b, h) + boff + n * 2048 + k * 1024); } while (0)
#define PG8_MMA(ai, bj, At, Bt) do { __builtin_amdgcn_s_setprio(1); _Pragma("unroll") for (int m = 0; m < 4; ++m) _Pragma("unroll") for (int n = 0; n < 2; ++n) _Pragma("unroll") for (int k = 0; k < 2; ++k) \
        acc[ai][bj][m][n] = __builtin_amdgcn_mfma_f32_16x16x32_bf16(Bt[n][k], At[m][k], acc[ai][bj][m][n], 0, 0, 0); __builtin_amdgcn_s_setprio(0); } while (0)
#define PG8_WAIT_V(n) asm volatile("s_waitcnt vmcnt(" #n ")" ::: "memory")
#define PG8_WAIT_L(n) asm volatile("s_waitcnt lgkmcnt(" #n ")" ::: "memory")
#define PG8_BAR __builtin_amdgcn_s_barrier()
#define PG8_SCHED __builtin_amdgcn_sched_barrier(0)
    Unit cur, nxt; int ui = 0;
    if (!S.next(0, cur)) return;
    f32x4 acc[2][2][4][2];
#pragma unroll
    for (int a = 0; a < 2; ++a)
#pragma unroll
        for (int b = 0; b < 2; ++b)
#pragma unroll
            for (int m = 0; m < 4; ++m)
#pragma unroll
                for (int n = 0; n < 2; ++n) acc[a][b][m][n] = (f32x4){0.f, 0.f, 0.f, 0.f};
    bf16x8 At[4][2], B0[2][2], B1[2][2];
    const char* cA = (const char*)g.A + (size_t)cur.pm * tstep; const char* cB = (const char*)g.Bt + (size_t)cur.pn * tstep;
    S.a_ready(cur);
    if constexpr (SP2) {
        PG8_STAGE(PG8_SB(0, 0), cB, voffB); PG8_STAGE(PG8_SB(0, 1), cB + hstep, voffB); PG8_STAGE(PG8_SA(0, 0), cA, voffA); PG8_STAGE(PG8_SA(0, 1), cA + hstep, voffA);
        if (wr == 1) PG8_BAR;
        PG8_WAIT_V(2); PG8_BAR;
        PG8_STAGE(PG8_SB(1, 0), cB + kstep, voffB); PG8_STAGE(PG8_SA(1, 0), cA + kstep, voffA); PG8_STAGE(PG8_SB(1, 1), cB + hstep + kstep, voffB);
        PG8_WAIT_V(6); PG8_BAR;
    } else {
        PG8_STAGE(PG8_SB(0, 0), cB, voffB); PG8_STAGE(PG8_SA(0, 0), cA, voffA); PG8_STAGE(PG8_SB(0, 1), cB + hstep, voffB); PG8_STAGE(PG8_SA(0, 1), cA + hstep, voffA);
        if (wr == 1) PG8_BAR;
        PG8_WAIT_V(4); PG8_BAR;
        PG8_STAGE(PG8_SB(1, 0), cB + kstep, voffB); PG8_STAGE(PG8_SA(1, 0), cA + kstep, voffA); PG8_STAGE(PG8_SB(1, 1), cB + hstep + kstep, voffB);
        PG8_WAIT_V(6); PG8_BAR;
    }
    for (;;) {
        const bool has_next = S.next(ui + 1, nxt);
        const char* nA = has_next ? (const char*)g.A + (size_t)nxt.pm * tstep : cA; const char* nB = has_next ? (const char*)g.Bt + (size_t)nxt.pn * tstep : cB;
        for (int t = 0; t < nt; t += 2) {
            const bool last = (t == nt - 2);
            const char* a1 = cA + (size_t)(t + 1) * kstep;
            const char* a2 = last ? nA : cA + (size_t)(t + 2) * kstep; const char* b2 = last ? nB : cB + (size_t)(t + 2) * kstep;
            const char* a3 = a2 + kstep; const char* b3 = b2 + kstep;
            if (last && has_next) S.a_ready(nxt);
            if constexpr (SP2) {
            PG8_LDB(B0, 0, 0); PG8_LDB(B1, 0, 1); PG8_SCHED; PG8_LDA(At, 0, 0); PG8_STAGE(PG8_SA(1, 1), a1 + hstep, voffA);
            PG8_WAIT_V(8); PG8_WAIT_L(0); PG8_BAR; PG8_MMA(0, 0, At, B0); PG8_MMA(0, 1, At, B1); PG8_BAR; PG8_SCHED;
            PG8_LDA(At, 0, 1); PG8_STAGE(PG8_SB(0, 0), b2, voffB); PG8_STAGE(PG8_SB(0, 1), b2 + hstep, voffB); PG8_STAGE(PG8_SA(0, 0), a2, voffA);
            PG8_WAIT_V(8); PG8_WAIT_L(0); PG8_BAR; PG8_MMA(1, 0, At, B0); PG8_MMA(1, 1, At, B1); PG8_BAR; PG8_SCHED;
            PG8_LDB(B0, 1, 0); PG8_LDB(B1, 1, 1); PG8_SCHED; PG8_LDA(At, 1, 0); PG8_STAGE(PG8_SA(0, 1), a2 + hstep, voffA);
            PG8_WAIT_V(8); PG8_WAIT_L(0); PG8_BAR; PG8_MMA(0, 0, At, B0); PG8_MMA(0, 1, At, B1); PG8_BAR; PG8_SCHED;
            PG8_LDA(At, 1, 1); PG8_STAGE(PG8_SB(1, 0), b3, voffB); PG8_STAGE(PG8_SB(1, 1), b3 + hstep, voffB); PG8_STAGE(PG8_SA(1, 0), a3, voffA);
            PG8_WAIT_V(8); PG8_WAIT_L(0); PG8_BAR; PG8_MMA(1, 0, At, B0); PG8_MMA(1, 1, At, B1); PG8_BAR; PG8_SCHED;
            } else {
            PG8_LDB(B0, 0, 0); PG8_SCHED; PG8_LDA(At, 0, 0); PG8_STAGE(PG8_SA(1, 1), a1 + hstep, voffA);
            PG8_WAIT_L(8); PG8_BAR; PG8_WAIT_L(0); PG8_MMA(0, 0, At, B0); PG8_BAR; PG8_SCHED;
            PG8_LDB(B1, 0, 1); PG8_STAGE(PG8_SB(0, 0), b2, voffB);
            PG8_BAR; PG8_WAIT_L(0); PG8_MMA(0, 1, At, B1); PG8_BAR;
            PG8_LDA(At, 0, 1); PG8_STAGE(PG8_SA(0, 0), a2, voffA);
            PG8_BAR; PG8_WAIT_L(0); PG8_MMA(1, 0, At, B0); PG8_BAR; PG8_SCHED;
            PG8_STAGE(PG8_SB(0, 1), b2 + hstep, voffB);
            PG8_WAIT_V(6); PG8_BAR; PG8_MMA(1, 1, At, B1); PG8_BAR;
            PG8_LDB(B0, 1, 0); PG8_SCHED; PG8_LDA(At, 1, 0); PG8_STAGE(PG8_SA(0, 1), a2 + hstep, voffA);
            PG8_WAIT_L(8); PG8_BAR; PG8_WAIT_L(0); PG8_MMA(0, 0, At, B0); PG8_BAR; PG8_SCHED;
            PG8_LDB(B1, 1, 1); PG8_STAGE(PG8_SB(1, 0), b3, voffB);
            PG8_BAR; PG8_WAIT_L(0); PG8_MMA(0, 1, At, B1); PG8_BAR;
            PG8_LDA(At, 1, 1); PG8_STAGE(PG8_SA(1, 0), a3, voffA);
            PG8_BAR; PG8_WAIT_L(0); PG8_MMA(1, 0, At, B0); PG8_BAR; PG8_SCHED;
            PG8_STAGE(PG8_SB(1, 1), b3 + hstep, voffB);
            PG8_WAIT_V(6); PG8_BAR; PG8_MMA(1, 1, At, B1); PG8_BAR;
            }
        }
        if constexpr (ALIGN_EPI) { if (wr == 0) PG8_BAR; }
        if constexpr (!Epi::AFTER_DRAIN) { E(acc, cur, wr, wc, fr, fq); S.done(cur); }
        if (!has_next) break;
#pragma unroll
        for (int a = 0; a < 2; ++a)
#pragma unroll
            for (int b = 0; b < 2; ++b)
#pragma unroll
                for (int m = 0; m < 4; ++m)
#pragma unroll
                    for (int n = 0; n < 2; ++n) acc[a][b][m][n] = (f32x4){0.f, 0.f, 0.f, 0.f};
        cur = nxt; cA = nA; cB = nB; ++ui;
        if constexpr (ALIGN_EPI) { if (wr == 1) PG8_BAR; }
    }
    PG8_WAIT_V(0);
    if constexpr (!ALIGN_EPI) { if (wr == 0) PG8_BAR; }
    PG8_BAR;
    if constexpr (Epi::AFTER_DRAIN) { E.fused(acc, cur, wr, wc, fr, fq, lds, wid, lane); S.done(cur); }
#undef PG8_SA
#undef PG8_SB
#undef PG8_STAGE
#undef PG8_LDA
#undef PG8_LDB
#undef PG8_MMA
#undef PG8_WAIT_V
#undef PG8_WAIT_L
#undef PG8_BAR
#undef PG8_SCHED
}
}
#define XB_TMO      128
#define XB_XCNT(j)  (256  + 64 * (j))
#define XB_XSUB(j)  (1280 + 64 * (j))
#define XB_XGEN(j)  (2304 + 64 * (j))
#define XB_TOP      3328
#define XB_TOPGEN   3392
#define XCD_BAR_WORDS 3456
#define XB_SPIN_CAP (1u << 18)

__device__ __forceinline__ unsigned xb_ld(unsigned* p)              { return __hip_atomic_load(p, __ATOMIC_RELAXED, __HIP_MEMORY_SCOPE_AGENT); }
__device__ __forceinline__ unsigned xb_add(unsigned* p, unsigned v) { return __hip_atomic_fetch_add(p, v, __ATOMIC_RELAXED, __HIP_MEMORY_SCOPE_AGENT); }
__device__ __forceinline__ unsigned xb_xcc_id() { return (unsigned)__builtin_amdgcn_s_getreg((3 << 11) | 20) & 0xFu; }
#define XB_SPIN(cond, bar) do { unsigned _sp = 0; while (cond) { __builtin_amdgcn_s_sleep(1); \
    if ((++_sp & 255u) == 0u) { if (xb_ld(&(bar)[XB_TMO])) break; if (_sp > XB_SPIN_CAP) { atomicAdd(&(bar)[XB_TMO], 1u); break; } } } } while (0)

struct XcdBarrier {
    unsigned* bar; unsigned x;
    volatile LAS unsigned* st;
};

__device__ __forceinline__ XcdBarrier xcd_barrier_post(unsigned* bar, volatile LAS unsigned* st) {
    XcdBarrier b; b.bar = bar; b.x = xb_xcc_id(); b.st = st;
    if (threadIdx.x == 0) (void)xb_add(&bar[XB_XCNT(b.x)], 1u);
    return b;
}
__device__ __forceinline__ void xcd_barrier_complete(unsigned* bar, unsigned x, unsigned& nloc, unsigned& nx) {
    const unsigned G = gridDim.x * gridDim.y * gridDim.z;
    unsigned sum, cnt, mine, sp = 0u;
    for (;;) {
        sum = 0u; cnt = 0u; mine = 0u;
#pragma unroll
        for (unsigned j = 0; j < 16; ++j) { const unsigned c = xb_ld(&bar[XB_XCNT(j)]); sum += c; cnt += (c > 0u) ? 1u : 0u; mine = (j == x) ? c : mine; }
        if (sum == G) break;
        __builtin_amdgcn_s_sleep(1);
        if ((++sp & 255u) == 0u) { if (xb_ld(&bar[XB_TMO])) break; if (sp > XB_SPIN_CAP) { atomicAdd(&bar[XB_TMO], 1u); break; } }
    }
    nloc = mine > 0u ? mine : 1u; nx = cnt > 0u ? cnt : 1u;
}

__device__ __forceinline__ void xcd_barrier(const XcdBarrier& b) {
    asm volatile("s_waitcnt vmcnt(0)" ::: "memory");
    __syncthreads();
    if (threadIdx.x == 0) {
        unsigned* bar = b.bar;
        __builtin_amdgcn_s_waitcnt(0);
        unsigned nloc = b.st[0], nx = b.st[1];
        if (nloc == 0u) { xcd_barrier_complete(bar, b.x, nloc, nx); b.st[0] = nloc; b.st[1] = nx; }
        const unsigned old = xb_add(&bar[XB_XSUB(b.x)], 1u);
        const unsigned gen = old / nloc;
        if (old + 1u == (gen + 1u) * nloc) {
            __builtin_amdgcn_fence(__ATOMIC_RELEASE, "agent");
            asm volatile("s_waitcnt vmcnt(0)" ::: "memory");
            const unsigned og = xb_add(&bar[XB_TOP], 1u);
            const unsigned tg = og / nx;
            if (og + 1u == (tg + 1u) * nx) xb_add(&bar[XB_TOPGEN], 1u);
            else XB_SPIN(xb_ld(&bar[XB_TOPGEN]) == tg, bar);
            __builtin_amdgcn_fence(__ATOMIC_ACQUIRE, "agent");
            xb_add(&bar[XB_XGEN(b.x)], 1u);
            asm volatile("s_waitcnt vmcnt(0)" ::: "memory");
        } else {
            XB_SPIN(xb_ld(&bar[XB_XGEN(b.x)]) == gen, bar);
            __builtin_amdgcn_fence(__ATOMIC_ACQUIRE, "agent");
            asm volatile("s_waitcnt vmcnt(0)" ::: "memory");
        }
    }
    __syncthreads();
}

#define LDS_WAIT() asm volatile("s_waitcnt lgkmcnt(0)" ::: "memory")
#define VM_WAIT() asm volatile("s_waitcnt vmcnt(0)" ::: "memory")
#define SBAR() __builtin_amdgcn_sched_barrier(0)
__device__ __forceinline__ unsigned cvtpk(float lo, float hi) { unsigned r; asm volatile("v_cvt_pk_bf16_f32 %0, %1, %2" : "=v"(r) : "v"(lo), "v"(hi)); return r; }
__device__ __forceinline__ float bf_lo(unsigned w) { return __uint_as_float(w << 16); }
__device__ __forceinline__ float bf_hi(unsigned w) { return __uint_as_float(w & 0xffff0000u); }
__device__ __forceinline__ float bf2f(bf16_t h) { return __uint_as_float(((unsigned)h) << 16); }
__device__ __forceinline__ float wave_sum(float v) {
#pragma unroll
    for (int o = 1; o < 64; o <<= 1) v += __shfl_xor(v, o);
    return v;
}
__device__ __forceinline__ float fast_exp2(float x) { return __builtin_amdgcn_exp2f(x); }
__device__ __forceinline__ float fast_log2(float x) { return __builtin_amdgcn_logf(x); }
__device__ __forceinline__ float fast_rcp(float x) { return __builtin_amdgcn_rcpf(x); }

__device__ __forceinline__ int tid_now() { int t = (int)threadIdx.x; asm volatile("" : "+v"(t)); return t; }

struct Params { const float* in[27]; float* out; unsigned char* ws; int ph_lo, ph_hi; };

struct TrJob { int src, N, c0, ncols, K, gain, r0; size_t dst; };
__device__ __forceinline__ void tr_item(const float* W, int N, int c0, int ncols, int K, const float* gain, bf16_t* WT, int r0, int kb, int nb, LAS float* scr, int lane) {
    const int k0 = kb * 64, n0 = nb * 64;
    const float* src = W + (size_t)k0 * N + c0 + n0 + lane;
#pragma unroll 16
    for (int i = 0; i < 64; ++i) scr[i * 65 + lane] = src[(size_t)i * N];
    LDS_WAIT(); asm volatile("" ::: "memory");
    const int c = lane & 7;
    float gv[8];
#pragma unroll
    for (int e = 0; e < 8; ++e) gv[e] = gain ? gain[k0 + 8 * c + e] : 1.0f;
#pragma unroll
    for (int j = 0; j < 8; ++j) { const int n = (lane >> 3) + 8 * j; const LAS float* s = scr + (8 * c) * 65 + n;
        u32x4 o; o.x = cvtpk(s[0 * 65] * gv[0], s[1 * 65] * gv[1]); o.y = cvtpk(s[2 * 65] * gv[2], s[3 * 65] * gv[3]); o.z = cvtpk(s[4 * 65] * gv[4], s[5 * 65] * gv[5]); o.w = cvtpk(s[6 * 65] * gv[6], s[7 * 65] * gv[7]);
        if (n0 + n >= ncols) o = (u32x4){0u, 0u, 0u, 0u};
        *(u32x4*)(WT + (size_t)(r0 + n0 + n) * K + k0 + 8 * c) = o; }
    LDS_WAIT(); asm volatile("" ::: "memory");
}
constexpr int NJOBS = 21;
__device__ __forceinline__ TrJob get_job(int id) {
    TrJob j{};
    if (id < 16) { const int l = id >> 3, k = id & 7, ib = 2 + 8 * l;
        switch (k) {
        case 0: j = TrJob{ib + 1, 19552, 0, 7168, 4096, ib, 0, WS_WAIN + l * WAIN_BYTES}; break;
        case 1: j = TrJob{ib + 1, 19552, 7264, 12288, 4096, ib, 7168, WS_WAIN + l * WAIN_BYTES}; break;
        case 2: j = TrJob{ib + 1, 19552, 7168, 96, 4096, ib, 0, WS_WG + (size_t)l * 128 * 4096 * 2}; break;
        case 3: j = TrJob{ib + 7, 4096, 0, 4096, 4096, -1, 0, WS_WAOUT + l * WOUT_BYTES}; break;
        case 4: j = TrJob{ib + 3, 128, 0, 128, 4096, -1, 0, WS_W1T + (size_t)(l * 2 + 0) * 128 * 4096 * 2}; break;
        case 5: j = TrJob{ib + 5, 128, 0, 128, 4096, -1, 0, WS_W1T + (size_t)(l * 2 + 1) * 128 * 4096 * 2}; break;
        case 6: j = TrJob{ib + 4, 128, 0, 128, 128, -1, 0, WS_W2T + (size_t)(l * 2 + 0) * 128 * 128 * 2}; break;
        default: j = TrJob{ib + 6, 128, 0, 128, 128, -1, 0, WS_W2T + (size_t)(l * 2 + 1) * 128 * 128 * 2}; break;
        }
    } else {
        switch (id) {
        case 16: j = TrJob{19, 8192, 0, 8192, 4096, 18, 0, WS_WKVQ}; break;
        case 17: j = TrJob{21, 8192, 0, 8192, 4096, 20, 8192, WS_WKVQ}; break;
        case 18: j = TrJob{22, 4096, 0, 4096, 4096, -1, 0, WS_WBOUT}; break;
        case 19: j = TrJob{24, 8192, 0, 8192, 4096, 23, 0, WS_WB3}; break;
        default: j = TrJob{25, 4096, 0, 4096, 4096, -1, 0, WS_WBOUT + WOUT_BYTES}; break;
        }
    }
    return j;
}
__device__ __forceinline__ int job_items(const TrJob& j) { return (j.K / 64) * ((j.ncols + 63) / 64); }

__device__ __forceinline__ void phase_x_to_bf16(const float* x, bf16_t* xb, float* ss) {
    const int tid = tid_now(), lane = tid & 63, gw = blockIdx.x * 8 + __builtin_amdgcn_readfirstlane(tid >> 6), ngw = gridDim.x * 8;
    for (int m = gw; m < MTOK; m += ngw) {
        const f32x4* xr = (const f32x4*)(x + (size_t)m * DM) + lane; u32x2* o8 = (u32x2*)(xb + (size_t)m * DM) + lane;
        f32x4 v[16]; float s = 0.f;
#pragma unroll
        for (int j = 0; j < 16; ++j) { v[j] = xr[64 * j]; s += (v[j].x * v[j].x + v[j].y * v[j].y) + (v[j].z * v[j].z + v[j].w * v[j].w); }
#pragma unroll
        for (int j = 0; j < 16; ++j) { u32x2 w; w.x = cvtpk(v[j].x, v[j].y); w.y = cvtpk(v[j].z, v[j].w); o8[64 * j] = w; }
        s = wave_sum(s);
        if (lane == 0) ss[m] = s;
    }
}
__device__ __forceinline__ void phase_final_norm(const bf16_t* xb, float* out, const float* g, const float* ss, LAS unsigned char* lds) {
    const int tid = tid_now(), lane = tid & 63, wave = __builtin_amdgcn_readfirstlane(tid >> 6);
    LAS float* RSF = (LAS float*)lds;
    for (int r0 = blockIdx.x * 64; r0 < MTOK; r0 += gridDim.x * 64) {
        __syncthreads();
        if (tid < 64) RSF[tid] = 1.0f / sqrtf(row_sumsq(ss, SS_NP, r0 + tid) * (1.0f / DM) + RMS_EPS);
        __syncthreads();
        for (int k = 0; k < 8; ++k) { const int m = r0 + wave * 8 + k;
            const u32x4* xr = (const u32x4*)(xb + (size_t)m * DM) + lane; f32x4* orow = (f32x4*)(out + (size_t)m * DM) + 2 * lane; const f32x4* gr = (const f32x4*)g + 2 * lane;
            const float rstd = RSF[wave * 8 + k];
#pragma unroll
            for (int j = 0; j < 8; ++j) { const u32x4 v = xr[64 * j];
                const f32x4 lo = (f32x4){__uint_as_float(v.x << 16), __uint_as_float(v.x & 0xffff0000u), __uint_as_float(v.y << 16), __uint_as_float(v.y & 0xffff0000u)};
                const f32x4 hi = (f32x4){__uint_as_float(v.z << 16), __uint_as_float(v.z & 0xffff0000u), __uint_as_float(v.w << 16), __uint_as_float(v.w & 0xffff0000u)};
                orow[128 * j] = lo * rstd * gr[128 * j]; orow[128 * j + 1] = hi * rstd * gr[128 * j + 1]; } }
    }
}

__device__ __forceinline__ void phase_prologue(const Params& P, LAS unsigned char* lds) {
    const int tid = tid_now(), lane = tid & 63, wave = __builtin_amdgcn_readfirstlane(tid >> 6), G = gridDim.x;
    LAS float* scr = (LAS float*)(lds + wave * 16640);
    const int gw = blockIdx.x * 8 + wave, ngw = G * 8;
    int base = 0;
    for (int id = 0; id < NJOBS; ++id) {
        const TrJob j = get_job(id); const int ni = job_items(j), nbn = (j.ncols + 63) / 64;
        int it = gw - (base % ngw); if (it < 0) it += ngw;
        const float* W = P.in[j.src]; const float* gain = j.gain >= 0 ? P.in[j.gain] : nullptr; bf16_t* WT = (bf16_t*)(P.ws + j.dst);
        for (; it < ni; it += ngw) tr_item(W, j.N, j.c0, j.ncols, j.K, gain, WT, j.r0, it / nbn, it % nbn, scr, lane);
        base += ni;
    }
    __syncthreads();
    for (int item = blockIdx.x; item < 64; item += G) {
        const int lk = item >> 4, kp = item & 15, l = lk >> 1, kv = lk & 1, ib = 2 + 8 * l;
        const float* pos = P.in[ib + 2]; const float* w1 = P.in[ib + 3 + 2 * kv];
        const int col = tid & 127, part = tid >> 7, kbeg = kp * 256 + part * 64; float s = 0.f;
#pragma unroll 8
        for (int k = kbeg; k < kbeg + 64; ++k) s += pos[k] * w1[(size_t)k * 128 + col];
        LAS float* red = (LAS float*)lds;
        red[part * 128 + col] = s; __syncthreads();
        if (tid < 128) ((float*)(P.ws + WS_C1))[item * 128 + tid] = (red[tid] + red[128 + tid]) + (red[256 + tid] + red[384 + tid]);
        __syncthreads();
    }
    phase_x_to_bf16(P.in[0], (bf16_t*)(P.ws + WS_XB), (float*)(P.ws + WS_SS));
}

__device__ __forceinline__ bf16x8 ld8(const bf16_t* p) { return *(const bf16x8*)p; }
__device__ __forceinline__ void compress_unit(const Params& P, int l, int cu, LAS unsigned char* lds) {
    const int tid = tid_now(), lane = tid & 63, wave = __builtin_amdgcn_readfirstlane(tid >> 6);
    const int rt = cu & 3, kv = (cu >> 2) & 1, bg = cu >> 3, b = bg >> 2, g = bg & 3;
    const bf16_t* raw = (const bf16_t*)(P.ws + WS_KV) + (size_t)(b * SEQ) * KVW + kv * 512 + g * 128;
    const bf16_t* w1t = (const bf16_t*)(P.ws + WS_W1T) + (size_t)(l * 2 + kv) * 128 * 4096;
    const bf16_t* w2t = (const bf16_t*)(P.ws + WS_W2T) + (size_t)(l * 2 + kv) * 128 * 128;
    const float* c1p = (const float*)(P.ws + WS_C1) + (size_t)(l * 2 + kv) * 16 * 128;
    bf16_t* outp = (bf16_t*)(P.ws + (kv ? WS_VC : WS_KC)) + (size_t)bg * 128 * 128;
    const int fr = lane & 15, fq = lane >> 4;
    LAS float* PART = (LAS float*)lds;
    LAS bf16_t* H = (LAS bf16_t*)(lds + 131072);
    {
        int n0 = rt * 32 + fr, n1 = n0 + 16; n0 = n0 > 126 ? 126 : n0; n1 = n1 > 126 ? 126 : n1;
        const bf16_t* ap0 = raw + (size_t)(16 * n0 + wave * 4) * KVW + fq * 8; const bf16_t* ap1 = raw + (size_t)(16 * n1 + wave * 4) * KVW + fq * 8;
        const bf16_t* bp = w1t + (size_t)fr * 4096 + wave * 512 + fq * 8;
        f32x4 acc[2][8];
#pragma unroll
        for (int i = 0; i < 2; ++i)
#pragma unroll
            for (int c = 0; c < 8; ++c) acc[i][c] = (f32x4){0.f, 0.f, 0.f, 0.f};
#pragma unroll 4
        for (int ks = 0; ks < 16; ++ks) {
            const bf16x8 a0 = ld8(ap0 + (size_t)(ks >> 2) * KVW + (ks & 3) * 32), a1 = ld8(ap1 + (size_t)(ks >> 2) * KVW + (ks & 3) * 32);
            bf16x8 bb[8];
#pragma unroll
            for (int c = 0; c < 8; ++c) bb[c] = ld8(bp + (size_t)c * 16 * 4096 + ks * 32);
#pragma unroll
            for (int c = 0; c < 8; ++c) { acc[0][c] = __builtin_amdgcn_mfma_f32_16x16x32_bf16(a0, bb[c], acc[0][c], 0, 0, 0); acc[1][c] = __builtin_amdgcn_mfma_f32_16x16x32_bf16(a1, bb[c], acc[1][c], 0, 0, 0); }
        }
#pragma unroll
        for (int i = 0; i < 2; ++i)
#pragma unroll
            for (int c = 0; c < 8; ++c)
#pragma unroll
                for (int r = 0; r < 4; ++r) PART[(wave * 32 + i * 16 + fq * 4 + r) * 128 + c * 16 + fr] = acc[i][c][r];
    }
    __syncthreads();
    { const int col = tid & 127; float cc = 0.f;
#pragma unroll
      for (int kp = 0; kp < 16; ++kp) cc += c1p[kp * 128 + col];
#pragma unroll
      for (int e = 0; e < 8; ++e) { const int row = (tid >> 7) * 8 + e; float v = cc;
#pragma unroll
          for (int w = 0; w < 8; ++w) v += PART[(w * 32 + row) * 128 + col];
          const float sv = v * fast_rcp(1.0f + fast_exp2(-v * LOG2E));
          H[row * 136 + col] = (bf16_t)(cvtpk(sv, 0.f) & 0xffffu); } }
    __syncthreads();
    const int rtile = wave & 1, ct0 = (wave >> 1) * 2;
    f32x4 o0 = {0.f, 0.f, 0.f, 0.f}, o1 = {0.f, 0.f, 0.f, 0.f};
#pragma unroll
    for (int ks = 0; ks < 4; ++ks) {
        const bf16x8 a = *(const LAS bf16x8*)(H + (rtile * 16 + fr) * 136 + ks * 32 + fq * 8);
        const bf16x8 b0 = ld8(w2t + (size_t)(ct0 * 16 + fr) * 128 + ks * 32 + fq * 8), b1 = ld8(w2t + (size_t)((ct0 + 1) * 16 + fr) * 128 + ks * 32 + fq * 8);
        o0 = __builtin_amdgcn_mfma_f32_16x16x32_bf16(a, b0, o0, 0, 0, 0);
        o1 = __builtin_amdgcn_mfma_f32_16x16x32_bf16(a, b1, o1, 0, 0, 0);
    }
#pragma unroll
    for (int c = 0; c < 2; ++c) { const int col = (ct0 + c) * 16 + fr;
#pragma unroll
        for (int r = 0; r < 4; ++r) { const int nr = rt * 32 + rtile * 16 + fq * 4 + r; const float v = nr < NCMP ? (c ? o1[r] : o0[r]) : 0.f;
            outp[(size_t)nr * 128 + col] = (bf16_t)(cvtpk(v, 0.f) & 0xffffu); } }
    __syncthreads();
}
__device__ __forceinline__ void gate_unit(const Params& P, int l, int gu, LAS unsigned char* lds) {
    const int tid = tid_now(), lane = tid & 63, wave = __builtin_amdgcn_readfirstlane(tid >> 6);
    const bf16_t* xb = (const bf16_t*)(P.ws + WS_XB); const bf16_t* wg = (const bf16_t*)(P.ws + WS_WG) + (size_t)l * 128 * 4096;
    const float* ss = l == 0 ? (const float*)(P.ws + WS_SS) : (const float*)(P.ws + WS_SSP); const int np = l == 0 ? 1 : SS_NP;
    float* Gt = (float*)(P.ws + WS_G);
    const int fr = lane & 15, fq = lane >> 4, kq = wave & 3, rh = wave >> 2;
    LAS float* PART = (LAS float*)lds;
    {
        const bf16_t* ap = xb + (size_t)(gu * 64 + rh * 32 + fr) * DM + kq * 1024 + fq * 8;
        const bf16_t* bp = wg + (size_t)fr * DM + kq * 1024 + fq * 8;
        f32x4 acc[2][6];
#pragma unroll
        for (int i = 0; i < 2; ++i)
#pragma unroll
            for (int c = 0; c < 6; ++c) acc[i][c] = (f32x4){0.f, 0.f, 0.f, 0.f};
#pragma unroll 4
        for (int ks = 0; ks < 32; ++ks) {
            const bf16x8 a0 = ld8(ap + ks * 32), a1 = ld8(ap + (size_t)16 * DM + ks * 32);
            bf16x8 bb[6];
#pragma unroll
            for (int c = 0; c < 6; ++c) bb[c] = ld8(bp + (size_t)c * 16 * DM + ks * 32);
#pragma unroll
            for (int c = 0; c < 6; ++c) { acc[0][c] = __builtin_amdgcn_mfma_f32_16x16x32_bf16(a0, bb[c], acc[0][c], 0, 0, 0); acc[1][c] = __builtin_amdgcn_mfma_f32_16x16x32_bf16(a1, bb[c], acc[1][c], 0, 0, 0); }
        }
#pragma unroll
        for (int i = 0; i < 2; ++i)
#pragma unroll
            for (int c = 0; c < 6; ++c)
#pragma unroll
                for (int r = 0; r < 4; ++r) PART[(kq * 64 + rh * 32 + i * 16 + fq * 4 + r) * 96 + c * 16 + fr] = acc[i][c][r];
    }
    LAS float* RSG = (LAS float*)(lds + 98304);
    if (tid < 64) RSG[tid] = 1.0f / sqrtf(row_sumsq(ss, np, gu * 64 + tid) * (1.0f / DM) + RMS_EPS);
    __syncthreads();
    for (int e = tid; e < 64 * 96; e += 512) { const int row = e / 96, col = e - row * 96;
        const float v = (PART[row * 96 + col] + PART[(64 + row) * 96 + col]) + (PART[(128 + row) * 96 + col] + PART[(192 + row) * 96 + col]);
        const float lg = v * RSG[row];
        Gt[(size_t)(gu * 64 + row) * NGATE + col] = fast_rcp(1.0f + fast_exp2(-lg * LOG2E)); }
    __syncthreads();
}

namespace att {
constexpr int SHM_K = 16384, SHM_V = 16384, NSLOT = 3;
constexpr int OFF_V = 0, OFF_K = NSLOT * SHM_V;
constexpr int OFF_IMP = NSLOT * (SHM_V + SHM_K);
constexpr int OFF_FIN = OFF_IMP + 8 * 32 * 33 * 4;
constexpr int OFF_SELM = OFF_FIN + 32 * 33 * 4;
constexpr int OFF_BT = OFF_SELM + 128;
constexpr int OFF_WS = OFF_BT + 8 * 132 * 4;
constexpr int OFF_DONE = OFF_WS + 8 * 64 * 4;
constexpr int ATT_LDS_END = OFF_DONE + 64;
static_assert(ATT_LDS_END <= MISC_OFF, "attention LDS map");

#define KSWZ(row, colB) ((row) * 256 + ((colB) ^ (((row) & 7) << 4)))
__device__ __forceinline__ int v_st(int k, int c) { const int kk = (k & ~0xC) | ((k & 4) << 1) | ((k & 8) >> 1); return ((kk >> 3) * 4 + (c >> 5)) * 512 + ((kk & 7) * 32 + (c & 31)) * 2; }
__device__ __forceinline__ int v_rd_base(int lane) { return ((lane & 3) << 3) | (((lane >> 2) & 3) << 6) | (((lane >> 4) & 1) << 5) | (((lane >> 5) & 1) << 8); }
constexpr int v_rd_off(int d0, int ks, int half) { return d0 * 512 + ks * 4096 + half * 2048; }
__device__ __forceinline__ int crow(int r, int hi) { return (r & 3) + 8 * (r >> 2) + 4 * hi; }

struct Geo { int tid, wid, lane, r32, hi, vb0; };
__device__ __forceinline__ Geo make_geo(LAS unsigned char* lds) {
    Geo g; g.tid = tid_now(); g.wid = __builtin_amdgcn_readfirstlane(g.tid >> 6); g.lane = g.tid & 63; g.r32 = g.lane & 31; g.hi = g.lane >> 5;
    g.vb0 = (int)(uintptr_t)(lds + OFF_V) + v_rd_base(g.lane);
    return g;
}
struct DmaOff { unsigned k[2], v[2]; };
__device__ __forceinline__ DmaOff make_dma(const Geo& g, int ld) {
    DmaOff d;
#pragma unroll
    for (int i = 0; i < 2; ++i) { const int ch = g.wid + 8 * i;
        const int krow = 4 * ch + (g.lane >> 4), kc = (g.lane & 15) ^ (krow & 7);
        d.k[i] = (unsigned)(krow * ld * 2 + kc * 16);
        const int sub = 2 * ch + (g.lane >> 5), kk = 8 * (sub >> 2) + ((g.lane & 31) >> 2), key = (kk & ~0xC) | ((kk & 4) << 1) | ((kk & 8) >> 1);
        d.v[i] = (unsigned)(key * ld * 2 + ((sub & 3) * 32 + (g.lane & 3) * 8) * 2); }
    return d;
}
__device__ __forceinline__ void dma_tile(LAS unsigned char* lds, int slot, const bf16_t* Kp, const bf16_t* Vp, size_t ld, int key0, DmaOff d, const Geo& g) {
    asm volatile("" : "+v"(d.k[0]), "+v"(d.k[1]), "+v"(d.v[0]), "+v"(d.v[1]));
    const char* kb = (const char*)Kp + (size_t)key0 * ld * 2; const char* vb = (const char*)Vp + (size_t)key0 * ld * 2;
#pragma unroll
    for (int i = 0; i < 2; ++i) {
        __builtin_amdgcn_global_load_lds((const unsigned*)(kb + d.k[i]), (LAS unsigned*)(lds + OFF_K + slot * SHM_K + (g.wid + 8 * i) * 1024), 16, 0, 0);
        __builtin_amdgcn_global_load_lds((const unsigned*)(vb + d.v[i]), (LAS unsigned*)(lds + OFF_V + slot * SHM_V + (g.wid + 8 * i) * 1024), 16, 0, 0); }
}
#define WAIT_VM(n) asm volatile("s_waitcnt vmcnt(" #n ")" ::: "memory")
#define RAW_BAR() do { asm volatile("s_waitcnt lgkmcnt(0)" ::: "memory"); __builtin_amdgcn_s_barrier(); asm volatile("" ::: "memory"); } while (0)
__device__ __forceinline__ void qkt(f32x16& p0, f32x16& p1, LAS unsigned char* lds, int buf, const Geo& g, const bf16x8* qr) {
    p0 = f32x16{}; p1 = f32x16{};
    LAS unsigned char* kb[4];
#pragma unroll
    for (int dd = 0; dd < 4; ++dd) kb[dd] = lds + OFF_K + buf * SHM_K + KSWZ(g.r32, (dd * 16 + g.hi * 8) * 2);
#pragma unroll
    for (int d0 = 0; d0 < 8; ++d0) { LAS unsigned char* a = kb[d0 & 3] + (d0 >> 2) * 128;
        const bf16x8 b0 = *(const LAS bf16x8*)a, b1 = *(const LAS bf16x8*)(a + 32 * 256);
        p0 = __builtin_amdgcn_mfma_f32_32x32x16_bf16(b0, qr[d0], p0, 0, 0, 0);
        p1 = __builtin_amdgcn_mfma_f32_32x32x16_bf16(b1, qr[d0], p1, 0, 0, 0); }
}
__device__ __forceinline__ void pv_tile(f32x16* o, int vb, bf16x8 pa0, bf16x8 pa1, bf16x8 pa2, bf16x8 pa3) {
#define TRRD(dst, off) asm volatile("ds_read_b64_tr_b16 %0, %1 offset:%2" : "=&v"(dst) : "v"(vb), "i"(off) : "memory")
#define PV_D0(d0) do { s16x4 l0, l1, l2, l3, h0, h1, h2, h3; constexpr int b_ = v_rd_off(d0, 0, 0); \
        TRRD(l0, b_); TRRD(h0, b_ + 2048); TRRD(l1, b_ + 4096); TRRD(h1, b_ + 6144); TRRD(l2, b_ + 8192); TRRD(h2, b_ + 10240); TRRD(l3, b_ + 12288); TRRD(h3, b_ + 14336); \
        asm volatile("s_waitcnt lgkmcnt(0)" ::: "memory"); SBAR(); \
        o[d0] = __builtin_amdgcn_mfma_f32_32x32x16_bf16(pa0, (bf16x8){l0[0], l0[1], l0[2], l0[3], h0[0], h0[1], h0[2], h0[3]}, o[d0], 0, 0, 0); \
        o[d0] = __builtin_amdgcn_mfma_f32_32x32x16_bf16(pa1, (bf16x8){l1[0], l1[1], l1[2], l1[3], h1[0], h1[1], h1[2], h1[3]}, o[d0], 0, 0, 0); \
        o[d0] = __builtin_amdgcn_mfma_f32_32x32x16_bf16(pa2, (bf16x8){l2[0], l2[1], l2[2], l2[3], h2[0], h2[1], h2[2], h2[3]}, o[d0], 0, 0, 0); \
        o[d0] = __builtin_amdgcn_mfma_f32_32x32x16_bf16(pa3, (bf16x8){l3[0], l3[1], l3[2], l3[3], h3[0], h3[1], h3[2], h3[3]}, o[d0], 0, 0, 0); } while (0)
    PV_D0(0); PV_D0(1); PV_D0(2); PV_D0(3);
#undef PV_D0
#undef TRRD
}
__device__ __forceinline__ void pack_p(const f32x16& p0, const f32x16& p1, bf16x8& pa0, bf16x8& pa1, bf16x8& pa2, bf16x8& pa3) {
#define PK4(P, B_, OUT) do { unsigned a0 = cvtpk(P[B_+0], P[B_+1]), a1 = cvtpk(P[B_+2], P[B_+3]); \
        unsigned b0 = cvtpk(P[B_+4], P[B_+5]), b1 = cvtpk(P[B_+6], P[B_+7]); \
        auto r0 = __builtin_amdgcn_permlane32_swap(a0, b0, false, false); auto r1 = __builtin_amdgcn_permlane32_swap(a1, b1, false, false); \
        u32x4 w = {r0[0], r1[0], r0[1], r1[1]}; OUT = *reinterpret_cast<bf16x8*>(&w); } while (0)
    PK4(p0, 0, pa0); PK4(p0, 8, pa1); PK4(p1, 0, pa2); PK4(p1, 8, pa3);
#undef PK4
}
__device__ __forceinline__ void pair_vals(float x, float& lo, float& hi) {
    auto rr = __builtin_amdgcn_permlane32_swap(__float_as_uint(x), __float_as_uint(x), false, false);
    lo = __uint_as_float(rr[0]); hi = __uint_as_float(rr[1]);
}
__device__ __forceinline__ float pair_max(float x) { float a, b; pair_vals(x, a, b); return fmaxf(a, b); }
__device__ __forceinline__ float pair_sum(float x) { float a, b; pair_vals(x, a, b); return a + b; }

constexpr float SM_THR = 8.0f;
__device__ __forceinline__ void rescale_o(f32x16* o, float alpha, LAS float* al_l, const Geo& g) {
    if (g.hi == 0) al_l[g.r32] = alpha;
    LDS_WAIT();
#pragma unroll
    for (int r = 0; r < 16; ++r) { const float a = al_l[crow(r, g.hi)];
#pragma unroll
        for (int d = 0; d < 4; ++d) o[d][r] *= a; }
}
__device__ __forceinline__ void softmax_step(f32x16& p0, f32x16& p1, float mulc, float badd, bool ok, float& m_reg, float& l_reg, f32x16* o, LAS float* al_l, const Geo& g) {
    const float NEG = -__builtin_inff();
    float xmax = fmaxf(p0[0], p1[0]);
#pragma unroll
    for (int r = 1; r < 16; ++r) xmax = fmaxf(xmax, fmaxf(p0[r], p1[r]));
    xmax = pair_max(xmax);
    const float smax = ok ? fmaf(xmax, mulc, badd) : NEG;
    float mn = m_reg, alpha = 1.0f;
    if (!__all(smax - m_reg <= SM_THR)) { mn = fmaxf(m_reg, smax); alpha = fast_exp2(m_reg - mn); m_reg = mn; rescale_o(o, alpha, al_l, g); }
    const float addc = ok ? (badd - mn) : NEG;
    float ps = 0.f;
#pragma unroll
    for (int r = 0; r < 16; ++r) { p0[r] = fast_exp2(fmaf(p0[r], mulc, addc)); ps += p0[r]; }
#pragma unroll
    for (int r = 0; r < 16; ++r) { p1[r] = fast_exp2(fmaf(p1[r], mulc, addc)); ps += p1[r]; }
    ps = pair_sum(ps);
    l_reg = l_reg * alpha + ps;
}

struct NsaT { const bf16_t* Q; const bf16_t* KV; const bf16_t* Z; const float* Gt; const bf16_t* KC; const bf16_t* VC; bf16_t* MIX; const float* rel_bias; };

constexpr int EMIT_ROWB = 144, EMIT_TILE = 32 * EMIT_ROWB;
static_assert(8 * EMIT_TILE <= OFF_SELM - OFF_IMP, "emit tiles fit the IMP + FIN region");
__device__ __forceinline__ void silu2_mul(unsigned ov, unsigned zv, float& lo, float& hi) {
    const float z0 = bf_lo(zv), z1 = bf_hi(zv);
    lo = bf_lo(ov) * z0 * fast_rcp(1.0f + fast_exp2(-z0 * LOG2E)); hi = bf_hi(ov) * z1 * fast_rcp(1.0f + fast_exp2(-z1 * LOG2E));
}
__device__ __forceinline__ float lane_xor1(float x) { return __int_as_float(__builtin_amdgcn_update_dpp(0, __float_as_int(x), 0xB1, 0xF, 0xF, true)); }
template <bool RMW, bool SCALE>
__device__ __forceinline__ void emit_tile(LAS unsigned char* lds, const f32x16* o, float f, const bf16_t* zb  , size_t zld,
                                          bf16_t* mb  , LAS float* li_l, const Geo& g) {
    const int row = g.lane >> 1, half = g.lane & 1;
    unsigned zoff = (unsigned)(row * (int)zld + half * 32), moff = (unsigned)(row * DM + half * 32);
    asm volatile("" : "+v"(zoff), "+v"(moff));
    u32x4 zv[2][4]; u32x4 old[2][4];
#pragma unroll
    for (int c = 0; c < 2; ++c)
#pragma unroll
        for (int q = 0; q < 4; ++q) zv[c][q] = *(const u32x4*)(zb + zoff + 64 * c + q * 8);
    if (RMW) {
#pragma unroll
        for (int c = 0; c < 2; ++c)
#pragma unroll
            for (int q = 0; q < 4; ++q) { const unsigned long long* ap = (const unsigned long long*)(mb + moff + 64 * c + q * 8);
                const unsigned long long a0 = __hip_atomic_load(ap, __ATOMIC_RELAXED, __HIP_MEMORY_SCOPE_AGENT), a1 = __hip_atomic_load(ap + 1, __ATOMIC_RELAXED, __HIP_MEMORY_SCOPE_AGENT);
                old[c][q] = (u32x4){(unsigned)a0, (unsigned)(a0 >> 32), (unsigned)a1, (unsigned)(a1 >> 32)}; }
    }
    float fr[16];
    if (SCALE) { if (g.hi == 0) li_l[g.r32] = f;
        LDS_WAIT();
#pragma unroll
        for (int r = 0; r < 16; ++r) fr[r] = li_l[(r & 3) + 8 * (r >> 2) + 4 * g.hi]; }
    LAS unsigned char* T = lds + OFF_IMP + g.wid * EMIT_TILE;
    const LAS unsigned char* trow = T + row * EMIT_ROWB + half * 64;
#pragma unroll
    for (int c = 0; c < 2; ++c) {
#pragma unroll
        for (int r = 0; r < 16; ++r) { const int rc = (r & 3) + 8 * (r >> 2);
#pragma unroll
            for (int dd = 0; dd < 2; ++dd) { const float v = SCALE ? o[2 * c + dd][r] * fr[r] : o[2 * c + dd][r]; const float vn = lane_xor1(v);
                if ((g.r32 & 1) == 0) *(LAS unsigned*)(T + (rc + 4 * g.hi) * EMIT_ROWB + (dd * 32 + g.r32) * 2) = cvtpk(v, vn); } }
        LDS_WAIT();
#pragma unroll
        for (int q = 0; q < 4; ++q) { const u32x4 ov = *(const LAS u32x4*)(trow + q * 16); u32x4 w;
#pragma unroll
            for (int e = 0; e < 4; ++e) { float lo, hi; silu2_mul(ov[e], zv[c][q][e], lo, hi);
                if (RMW) { lo += bf_lo(old[c][q][e]); hi += bf_hi(old[c][q][e]); }
                w[e] = cvtpk(lo, hi); }
            *(u32x4*)(mb + moff + 64 * c + q * 8) = w; }
        asm volatile("" ::: "memory");
    }
}

template <int MODE>
__device__ __forceinline__ void tile_softmax(f32x16& p0, f32x16& p1, int kb, int t0, bool selbit, const LAS float* btw, float& m_reg, float& l_reg, f32x16* o, LAS float* al_l, const Geo& g) {
    constexpr float C2 = SM_SCALE * LOG2E; const float NEG = -__builtin_inff();
    const bool near = (kb + 63 + 128 > t0);
    const bool wedge = (MODE == 2) && (t0 + 31 - kb >= 512);
    bool ok = (MODE == 1) ? selbit : true; float mulc = C2, badd = btw[128];
    if (near || wedge) {
        const int dq = t0 + g.r32 - kb - 4 * g.hi; const unsigned W = (MODE == 2) ? 512u : 0x7fffffffu;
#pragma unroll
        for (int r = 0; r < 16; ++r) { const int c = (r & 3) + 8 * (r >> 2);
            const unsigned d0 = (unsigned)(dq - c), d1 = (unsigned)(dq - c - 32);
            float b0 = btw[d0 < 128u ? d0 : 128u], b1 = btw[d1 < 128u ? d1 : 128u];
            asm volatile("" : "+v"(b0), "+v"(b1));
            p0[r] = (ok && d0 < W) ? fmaf(p0[r], C2, b0) : NEG; p1[r] = (ok && d1 < W) ? fmaf(p1[r], C2, b1) : NEG;
            if ((r & 3) == 3) asm volatile("" ::: "memory"); }
        mulc = 1.0f; badd = 0.f; ok = true;
    }
    softmax_step(p0, p1, mulc, badd, ok, m_reg, l_reg, o, al_l, g);
}

struct TileIter { unsigned rem; int nxt, j_hi, j, j1, j2; };
template <int MODE> __device__ __forceinline__ void ti_next(TileIter& it, int& dst) {
    if (MODE == 1) { dst = it.rem ? __builtin_ctz(it.rem) : -1; it.rem &= it.rem - 1u; } else { dst = (it.nxt <= it.j_hi) ? it.nxt : -1; ++it.nxt; } }
template <int MODE> __device__ __forceinline__ TileIter ti_init(unsigned umask, int j_lo, int j_hi) {
    TileIter it; it.rem = umask; it.nxt = j_lo; it.j_hi = j_hi; ti_next<MODE>(it, it.j); ti_next<MODE>(it, it.j1); ti_next<MODE>(it, it.j2); return it; }
__device__ __forceinline__ void branch_issue(LAS unsigned char* lds, const TileIter& it, const bf16_t* Kp, const bf16_t* Vp, size_t ld, const DmaOff& dof, const Geo& g) {
    dma_tile(lds, 0, Kp, Vp, ld, 64 * it.j, dof, g);
    if (it.j1 >= 0) dma_tile(lds, 1, Kp, Vp, ld, 64 * it.j1, dof, g);
}
template <int MODE>
__device__ __forceinline__ void branch_run(f32x16* o, float& l_out, LAS unsigned char* lds, TileIter it, const bf16_t* Kp, const bf16_t* Vp, size_t ld, const DmaOff& dof, const bf16x8* qr,
                                           unsigned selword, int t0, const LAS float* btw, LAS float* al_l, const Geo& g) {
    float m_reg = -1e30f, l_reg = 0.f;
#pragma unroll
    for (int d = 0; d < 4; ++d) o[d] = f32x16{};
    int slot = 0; bool first = true;
    for (;;) {
        if (first || it.j1 < 0) WAIT_VM(0); else WAIT_VM(4);
        first = false;
        RAW_BAR();
        if (it.j2 >= 0) dma_tile(lds, slot >= 1 ? slot - 1 : 2, Kp, Vp, ld, 64 * it.j2, dof, g);
        f32x16 p0, p1;
        qkt(p0, p1, lds, slot, g, qr);
        tile_softmax<MODE>(p0, p1, 64 * it.j, t0, ((selword >> it.j) & 1u) != 0u, btw, m_reg, l_reg, o, al_l, g);
        bf16x8 pa0, pa1, pa2, pa3; pack_p(p0, p1, pa0, pa1, pa2, pa3);
        pv_tile(o, g.vb0 + slot * SHM_V, pa0, pa1, pa2, pa3);
        if (it.j1 < 0) break;
        it.j = it.j1; it.j1 = it.j2; ti_next<MODE>(it, it.j2); slot = slot == 2 ? 0 : slot + 1;
    }
    RAW_BAR();
    l_out = l_reg;
}

__device__ __forceinline__ int t5_bucket(int d) {
    if (d < 16) return d;
    const float lr = logf((float)d / 16.0f);
    int large = 16 + (int)(lr / 2.0794415416798357f * 16.0f);
    return large < 31 ? large : 31;
}


struct NsaUnit { int b, grp, t0; };
__device__ __forceinline__ NsaUnit nsa_decode(int u) {
    const int p = u >> 1, s2 = u & 1, k = p >> 8, w = p & 255, bg = (w & 7) + 8 * k, i = ((w >> 3) + 8 * k) & 31;
    NsaUnit r; r.b = bg >> 2; r.grp = bg & 3; r.t0 = s2 ? 32 * i : 32 * (63 - i); return r; }
__device__ __forceinline__ void nsa_issue_cmp(LAS unsigned char* lds, const NsaT& A, const NsaUnit& U, const Geo& g) {
    const bf16_t* Kc = A.KC + (size_t)(U.b * NGRP + U.grp) * 128 * 128; const bf16_t* Vc = A.VC + (size_t)(U.b * NGRP + U.grp) * 128 * 128;
    const DmaOff dc = make_dma(g, 128);
    dma_tile(lds, 0, Kc, Vc, 128, 0, dc, g); dma_tile(lds, 1, Kc, Vc, 128, 64, dc, g);
}
__device__ __forceinline__ void nsa_unit(LAS unsigned char* lds, const NsaT& A, const NsaUnit U, bool build_bt) {
    const Geo g = make_geo(lds);
    __syncthreads();
    nsa_issue_cmp(lds, A, U, g);
    const int b = U.b, grp = U.grp, t0 = U.t0, h = grp * 8 + g.wid;
    LAS float* IMP = (LAS float*)(lds + OFF_IMP); LAS float* FIN = (LAS float*)(lds + OFF_FIN); LAS unsigned* SELM = (LAS unsigned*)(lds + OFF_SELM);
    LAS float* BT = (LAS float*)(lds + OFF_BT); LAS float* wsl = (LAS float*)(lds + OFF_WS) + g.wid * 64;
    const LAS float* btw = BT + g.wid * 132;
    float gates[3];
    { const float* gp = A.Gt + (size_t)(b * SEQ + t0) * NGATE + h + (unsigned)(g.r32 * NGATE);
#pragma unroll
      for (int br = 0; br < 3; ++br) gates[br] = gp[br * 32]; }
    bf16x8 qr[8];
    { const bf16_t* qp = A.Q + (size_t)(b * SEQ + t0) * DM + h * 128 + (unsigned)(g.r32 * DM + g.hi * 8);
#pragma unroll
      for (int d0 = 0; d0 < 8; ++d0) qr[d0] = *(const bf16x8*)(qp + d0 * 16); }
    if (build_bt) for (int e = g.tid; e < 8 * 129; e += 512) { const int r = e / 129, d = e - r * 129; BT[r * 132 + d] = A.rel_bias[t5_bucket(d) * NH + grp * 8 + r] * LOG2E; }
    const bf16_t* Ks = A.KV + (size_t)(b * SEQ) * KVW + 1024 + grp * 128; const bf16_t* Vs = Ks + 512;
    const bf16_t* Kw = Ks + 1024; const bf16_t* Vw = Kw + 512;
    const DmaOff dof = make_dma(g, KVW);
    f32x16 o[4]; float l_reg;
    unsigned selword, um;
    WAIT_VM(0);
    __syncthreads();
    {
        f32x16 pA0, pA1, pB0, pB1;
        qkt(pA0, pA1, lds, 0, g, qr); qkt(pB0, pB1, lds, 1, g, qr);
        constexpr float C2 = SM_SCALE * LOG2E; const float NEG = -__builtin_inff();
        const int dbase = t0 + g.r32 - 31 - 64 * g.hi;
        float pmax = NEG;
#pragma unroll
        for (int r = 0; r < 16; ++r) { const int c = (r & 3) + 8 * (r >> 2);
#define CSC(P, NL) do { const int dist = dbase - 16 * (NL); const unsigned ud = (unsigned)dist; const float bb = btw[ud < 128u ? ud : 128u]; \
            P[r] = dist >= 0 ? fmaf(P[r], C2, bb) : NEG; pmax = fmaxf(pmax, P[r]); } while (0)
            CSC(pA0, c); CSC(pA1, c + 32); CSC(pB0, c + 64); CSC(pB1, c + 96);
#undef CSC
        }
        pmax = pair_max(pmax);
        const float mref = (pmax == NEG) ? 0.f : pmax;
        float ps = 0.f;
#pragma unroll
        for (int r = 0; r < 16; ++r) { pA0[r] = fast_exp2(pA0[r] - mref); pA1[r] = fast_exp2(pA1[r] - mref); pB0[r] = fast_exp2(pB0[r] - mref); pB1[r] = fast_exp2(pB1[r] - mref);
            ps += (pA0[r] + pA1[r]) + (pB0[r] + pB1[r]); }
        ps = pair_sum(ps);
        l_reg = ps;
        const float inv = ps > 0.f ? 1.0f / ps : 0.f;
        float qs[16], e3[16];
#pragma unroll
        for (int i = 0; i < 4; ++i) {
            qs[0 + i] = ((pA0[4 * i] + pA0[4 * i + 1]) + (pA0[4 * i + 2] + pA0[4 * i + 3])) * inv; e3[0 + i] = pA0[4 * i + 3] * inv;
            qs[4 + i] = ((pA1[4 * i] + pA1[4 * i + 1]) + (pA1[4 * i + 2] + pA1[4 * i + 3])) * inv; e3[4 + i] = pA1[4 * i + 3] * inv;
            qs[8 + i] = ((pB0[4 * i] + pB0[4 * i + 1]) + (pB0[4 * i + 2] + pB0[4 * i + 3])) * inv; e3[8 + i] = pB0[4 * i + 3] * inv;
            qs[12 + i] = ((pB1[4 * i] + pB1[4 * i + 1]) + (pB1[4 * i + 2] + pB1[4 * i + 3])) * inv; e3[12 + i] = pB1[4 * i + 3] * inv;
        }
        { LAS float* ip = IMP + (g.wid * 32 + g.r32) * 33;
          float prev_hi1 = 0.f;
#pragma unroll
          for (int idx = 0; idx < 16; ++idx) { float lo, hi1; pair_vals(e3[idx], lo, hi1);
              const float add = g.hi ? lo : prev_hi1;
              ip[2 * idx + g.hi] = qs[idx] + add; prev_hi1 = hi1; } }
        bf16x8 a0, a1, a2, a3, c0, c1, c2, c3;
        pack_p(pA0, pA1, a0, a1, a2, a3); pack_p(pB0, pB1, c0, c1, c2, c3);
#pragma unroll
        for (int d = 0; d < 4; ++d) o[d] = f32x16{};
        pv_tile(o, g.vb0, a0, a1, a2, a3); pv_tile(o, g.vb0 + SHM_V, c0, c1, c2, c3);
    }
    LDS_WAIT();
    __syncthreads();
    dma_tile(lds, 0, Ks, Vs, KVW, 0, dof, g);
    {
        const int tl = g.tid >> 4, j0 = (g.tid & 15) * 2, tok = t0 + tl, cur = tok >> 6;
        float v2[2];
#pragma unroll
        for (int e = 0; e < 2; ++e) { const int j = j0 + e; float v = 0.f;
#pragma unroll
            for (int r = 0; r < 8; ++r) v += IMP[(r * 32 + tl) * 33 + j];
            const bool forced = (j == 0) || (j == cur) || (j == cur - 1), valid = (64 * j <= tok);
            v = forced ? 1.0e6f : (valid ? v : -1.0f); v2[e] = v; FIN[tl * 33 + j] = v; }
        LDS_WAIT();
        __syncthreads();
        unsigned bits = 0u;
#pragma unroll
        for (int e = 0; e < 2; ++e) { const int j = j0 + e; int cnt = 0;
#pragma unroll
            for (int i = 0; i < 32; ++i) { const float w = FIN[tl * 33 + i]; cnt += (w > v2[e] || (w == v2[e] && i < j)) ? 1 : 0; }
            if (cnt < 16) bits |= 1u << j; }
        bits |= (unsigned)__builtin_amdgcn_update_dpp(0, (int)bits, 0xB1, 0xF, 0xF, true);
        bits |= (unsigned)__builtin_amdgcn_update_dpp(0, (int)bits, 0x4E, 0xF, 0xF, true);
        bits |= (unsigned)__builtin_amdgcn_update_dpp(0, (int)bits, 0x141, 0xF, 0xF, true);
        bits |= (unsigned)__builtin_amdgcn_update_dpp(0, (int)bits, 0x140, 0xF, 0xF, true);
        if ((g.tid & 15) == 0) SELM[tl] = bits;
        LDS_WAIT();
        __syncthreads();
        selword = SELM[g.r32]; um = selword;
        um |= __shfl_xor(um, 1); um |= __shfl_xor(um, 2); um |= __shfl_xor(um, 4); um |= __shfl_xor(um, 8); um |= __shfl_xor(um, 16);
        const int jmax = (t0 + 31) >> 6;
        um = __builtin_amdgcn_readfirstlane(um) & (jmax >= 31 ? 0xffffffffu : ((2u << jmax) - 1u));
    }
    TileIter its = ti_init<1>(um, 0, 0);
    if (its.j1 >= 0) dma_tile(lds, 1, Ks, Vs, KVW, 64 * its.j1, dof, g);
    const bf16_t* zb = A.Z + (size_t)(b * SEQ + t0) * ZW + h * 128;
    bf16_t* mb = A.MIX + (size_t)(b * SEQ + t0) * DM + h * 128;
    emit_tile<false, true>(lds, o, (l_reg > 0.f ? 1.0f / l_reg : 0.f) * gates[0], zb, ZW, mb, wsl, g);
    branch_run<1>(o, l_reg, lds, its, Ks, Vs, KVW, dof, qr, selword, t0, btw, wsl + 32, g);
    const int lowk = t0 - 511;
    TileIter itw = ti_init<2>(0u, lowk > 0 ? lowk >> 6 : 0, (t0 + 31) >> 6);
    branch_issue(lds, itw, Kw, Vw, KVW, dof, g);
    emit_tile<true, true>(lds, o, (1.0f / l_reg) * gates[1], zb + 4096, ZW, mb, wsl, g);
    branch_run<2>(o, l_reg, lds, itw, Kw, Vw, KVW, dof, qr, 0u, t0, btw, wsl + 32, g);
    emit_tile<true, true>(lds, o, (1.0f / l_reg) * gates[2], zb + 8192, ZW, mb, wsl, g);
}
__device__ __forceinline__ void nsa_phase(LAS unsigned char* lds, const NsaT& A) {
    const int G = gridDim.x, first = 2 * (int)blockIdx.x;
    if (first >= 2048) return;
    int prev_grp = -1;
#pragma unroll 1
    for (int u = first; u < 2048; u = (u & 1) ? u + 2 * G - 1 : u + 1) {
        const NsaUnit U = nsa_decode(u);
        nsa_unit(lds, A, U, U.grp != prev_grp);
        prev_grp = U.grp;
    }
    VM_WAIT();
    __syncthreads();
}

constexpr bool SB_EARLY_EXIT = true;
constexpr float SB_PCUT = 1.0e-37f;
struct SbT { const bf16_t* QZ; const bf16_t* KVSH; bf16_t* MIX; };
struct SbUnit { int b, h, qb; };
__device__ __forceinline__ SbUnit sb_decode(int u) {
    const int p = u >> 1, s2 = u & 1, k = p >> 8, w = p & 255, bh = k * 64 + (w & 7) * 8 + (w >> 5), pi = ((w >> 3) + k) & 3;
    SbUnit r; r.b = bh >> 5; r.h = bh & 31; r.qb = s2 ? pi : 7 - pi; return r; }
__device__ __forceinline__ void sb_issue(LAS unsigned char* lds, const SbT& A, const SbUnit& U, const Geo& g) {
    const bf16_t* Kp = A.KVSH + (size_t)(U.b * SEQ) * 8192 + U.h * 128; const bf16_t* Vp = Kp + 4096;
    const DmaOff dof = make_dma(g, 8192); const int j = 4 * U.qb + 3;
    dma_tile(lds, 0, Kp, Vp, 8192, 64 * j, dof, g); dma_tile(lds, 1, Kp, Vp, 8192, 64 * (j - 1), dof, g);
}
__device__ __forceinline__ void sb_unit(LAS unsigned char* lds, const SbT& A, const SbUnit U, bool has_next, const SbUnit UN) {
    const Geo g = make_geo(lds);
    const int b = U.b, h = U.h, qb = U.qb;
    LAS unsigned* DONE = (LAS unsigned*)(lds + OFF_DONE);
    const int tw0 = qb * 256 + g.wid * 32, t = tw0 + g.r32;
    bf16x8 qr[8];
    { const bf16_t* qp = A.QZ + (size_t)(b * SEQ + tw0) * 8192 + h * 128 + (unsigned)(g.r32 * 8192 + g.hi * 8);
#pragma unroll
      for (int d0 = 0; d0 < 8; ++d0) qr[d0] = *(const bf16x8*)(qp + d0 * 16); }
    const bf16_t* Kp = A.KVSH + (size_t)(b * SEQ) * 8192 + h * 128; const bf16_t* Vp = Kp + 4096;
    f32x16 o[4];
#pragma unroll
    for (int d = 0; d < 4; ++d) o[d] = f32x16{};
    float PR = 1.0f; bool wdone = false;
    const DmaOff dof = make_dma(g, 8192);
    int j = 4 * qb + 3, bank = 0, slot = 0;
    for (int step = 0;; ++step) {
        if (step > 0 && j >= 1) WAIT_VM(4); else WAIT_VM(0);
        RAW_BAR();
        if (SB_EARLY_EXIT && step > 0) { unsigned all = 1u;
#pragma unroll
            for (int w = 0; w < 8; ++w) all &= DONE[bank * 8 + w];
            bank ^= 1;
            if (__builtin_amdgcn_readfirstlane(all)) break; }
        if (j >= 2) dma_tile(lds, slot >= 1 ? slot - 1 : 2, Kp, Vp, 8192, 64 * (j - 2), dof, g);
        const int kb = 64 * j;
        const bool active = (kb <= tw0 + 30) && !wdone;
        if (active) {
            f32x16 p0, p1;
            qkt(p0, p1, lds, slot, g, qr);
            const bool needmask = (kb + 63 >= tw0);
            const int dq = t - kb - 4 * g.hi;
            constexpr float ZS = SM_SCALE * LOG2E;
            float rr0[16], rr1[16];
#pragma unroll
            for (int r = 0; r < 16; ++r) { const int c = (r & 3) + 8 * (r >> 2);
                float e0 = fast_exp2(fminf(p0[r] * ZS, 64.0f)), e1 = fast_exp2(fminf(p1[r] * ZS, 64.0f));
                if (needmask) { e0 = (dq - c > 0) ? e0 : 0.f; e1 = (dq - c - 32 > 0) ? e1 : 0.f; }
                p0[r] = e0; p1[r] = e1; rr0[r] = fast_rcp(1.0f + e0); rr1[r] = fast_rcp(1.0f + e1); }
            float tot[8];
#pragma unroll
            for (int i = 0; i < 4; ++i) {
                rr0[4 * i + 2] *= rr0[4 * i + 3]; rr0[4 * i + 1] *= rr0[4 * i + 2]; rr0[4 * i] *= rr0[4 * i + 1]; tot[i] = rr0[4 * i];
                rr1[4 * i + 2] *= rr1[4 * i + 3]; rr1[4 * i + 1] *= rr1[4 * i + 2]; rr1[4 * i] *= rr1[4 * i + 1]; tot[4 + i] = rr1[4 * i];
            }
            float off[8]; float suf = PR;
#pragma unroll
            for (int idx = 7; idx >= 0; --idx) { float t0_, t1_; pair_vals(tot[idx], t0_, t1_);
                const float oh1 = suf; suf *= t1_; const float oh0 = suf; suf *= t0_; off[idx] = g.hi ? oh1 : oh0; }
            PR = suf;
#pragma unroll
            for (int r = 0; r < 16; ++r) { p0[r] *= rr0[r] * off[r >> 2]; p1[r] *= rr1[r] * off[4 + (r >> 2)]; }
            bf16x8 pa0, pa1, pa2, pa3; pack_p(p0, p1, pa0, pa1, pa2, pa3);
            pv_tile(o, g.vb0 + slot * SHM_V, pa0, pa1, pa2, pa3);
            if (SB_EARLY_EXIT) wdone = __all(PR < SB_PCUT);
        }
        if (SB_EARLY_EXIT && g.lane == 0) DONE[bank * 8 + g.wid] = wdone ? 1u : 0u;
        if (j == 0) break;
        --j; slot = slot == 2 ? 0 : slot + 1;
    }
    WAIT_VM(0);
    RAW_BAR();
    if (has_next) sb_issue(lds, A, UN, g);
    emit_tile<false, false>(lds, o, 1.0f, A.QZ + (size_t)(b * SEQ + tw0) * 8192 + 4096 + h * 128, 8192, A.MIX + (size_t)(b * SEQ + tw0) * DM + h * 128, (LAS float*)(lds + OFF_WS), g);
}
__device__ __forceinline__ void sb_phase(LAS unsigned char* lds, const SbT& A) {
    const int G = gridDim.x, first = 2 * (int)blockIdx.x;
    if (first >= 2048) return;
    { const Geo g = make_geo(lds); sb_issue(lds, A, sb_decode(first), g); }
#pragma unroll 1
    for (int u = first; u < 2048; u = (u & 1) ? u + 2 * G - 1 : u + 1) {
        const int un = (u & 1) ? u + 2 * G - 1 : u + 1; const bool has_next = un < 2048;
        sb_unit(lds, A, sb_decode(u), has_next, sb_decode(has_next ? un : u));
    }
    VM_WAIT();
    __syncthreads();
}
}

constexpr int NPHASES = 16;
__global__ void __launch_bounds__(512, 2) yoco_fwd(Params P) {
    extern __shared__ __attribute__((aligned(16))) unsigned char lds_raw[];
    LAS unsigned char* lds = (LAS unsigned char*)lds_raw;
    const int G = gridDim.x;
    volatile LAS unsigned* MISC = (volatile LAS unsigned*)(lds + MISC_OFF);
    { const int t0_ = tid_now(); if (t0_ < 64) MISC[t0_] = 0u; }
    __syncthreads();
    unsigned char* ws = P.ws;
    XcdBarrier bar = xcd_barrier_post((unsigned*)(ws + WS_CTL), MISC + 8);
    const int lo = P.ph_lo, hi = P.ph_hi;
#define IN(k) (lo <= (k) && (k) < hi)
#define SEAM(k) do { if (IN(k) && IN((k) + 1)) xcd_barrier(bar); } while (0)
    bf16_t* HN = (bf16_t*)(ws + WS_HN); bf16_t* XB = (bf16_t*)(ws + WS_XB); float* SS = (float*)(ws + WS_SS); float* SSP = (float*)(ws + WS_SSP);

    if (IN(0)) phase_prologue(P, lds);
    SEAM(0);

#pragma unroll
    for (int l = 0; l < 2; ++l) {
        const int pb = 1 + 4 * l;
        if (IN(pb)) {
            pg8::Gemm g{XB, (const bf16_t*)(ws + WS_WAIN + l * WAIN_BYTES), MTOK, NSA_N, DM}; pg8::StaticOrder S; S.init(MTOK, NSA_N, G, (int)blockIdx.x);
            const int fm = 8 * ((int)blockIdx.x & 7); LAS float* RS = (LAS float*)(lds + 131072);
            const float* ssrc = l == 0 ? SS : SSP; const int np = l == 0 ? 1 : SS_NP;
            { const int i4 = tid_now() * 4; f32x4 s4 = {0.f, 0.f, 0.f, 0.f};
#pragma unroll 8
              for (int p = 0; p < np; ++p) s4 += *(const f32x4*)(ssrc + (size_t)p * MTOK + fm * 256 + i4);
#pragma unroll
              for (int k = 0; k < 4; ++k) RS[i4 + k] = 1.0f / sqrtf(s4[k] * (1.0f / DM) + RMS_EPS); }
            __syncthreads();
            pg8::EpiSplit E{(bf16_t*)(ws + WS_Q), DM, 16, (bf16_t*)(ws + WS_KV), KVW, 28, (bf16_t*)(ws + WS_Z), ZW, ssrc, RS, fm, np};
            pg8::gemm_phase<pg8::EpiSplit, pg8::StaticOrder, true, true>(lds, g, S, E);
        }
        SEAM(pb);
        if (IN(pb + 1)) {
            for (int u = blockIdx.x; u < 256; u += G) { compress_unit(P, l, u, lds); gate_unit(P, l, u, lds); }
        }
        SEAM(pb + 1);
        if (IN(pb + 2)) {
            att::NsaT A{(const bf16_t*)(ws + WS_Q), (const bf16_t*)(ws + WS_KV), (const bf16_t*)(ws + WS_Z), (const float*)(ws + WS_G),
                        (const bf16_t*)(ws + WS_KC), (const bf16_t*)(ws + WS_VC), HN, P.in[1]};
            att::nsa_phase(lds, A);
        }
        SEAM(pb + 2);
        if (IN(pb + 3)) {
            pg8::Gemm g{HN, (const bf16_t*)(ws + WS_WAOUT + l * WOUT_BYTES), MTOK, DM, DM}; pg8::StaticOrder S; S.init(MTOK, DM, G, (int)blockIdx.x);
            pg8::EpiRes E{XB, P.out, DM, SSP, 0};
            pg8::gemm_phase<pg8::EpiRes, pg8::StaticOrder, true, true>(lds, g, S, E);
        }
        SEAM(pb + 3);
    }

#pragma unroll
    for (int l = 2; l < 4; ++l) {
        const int pb = 9 + 3 * (l - 2);
        if (IN(pb)) {
            const int N = (l == 2) ? 16384 : 8192;
            pg8::Gemm g{XB, (const bf16_t*)(ws + (l == 2 ? WS_WKVQ : WS_WB3)), MTOK, N, DM}; pg8::StaticOrder S; S.init(MTOK, N, G, (int)blockIdx.x);
            const int fm = 8 * ((int)blockIdx.x & 7); LAS float* RS = (LAS float*)(lds + 131072);
            const float* ssrc = SSP; const int np = SS_NP;
            { const int i4 = tid_now() * 4; f32x4 s4 = {0.f, 0.f, 0.f, 0.f};
#pragma unroll 8
              for (int p = 0; p < np; ++p) s4 += *(const f32x4*)(ssrc + (size_t)p * MTOK + fm * 256 + i4);
#pragma unroll
              for (int k = 0; k < 4; ++k) RS[i4 + k] = 1.0f / sqrtf(s4[k] * (1.0f / DM) + RMS_EPS); }
            __syncthreads();
            pg8::EpiSplit E{(bf16_t*)(ws + (l == 2 ? WS_KVSH : WS_QZ)), 8192, 32, (bf16_t*)(ws + WS_QZ), 8192, 1 << 20, nullptr, 0, ssrc, RS, fm, np};
            pg8::gemm_phase<pg8::EpiSplit, pg8::StaticOrder, true, true>(lds, g, S, E);
        }
        SEAM(pb);
        if (IN(pb + 1)) {
            att::SbT A{(const bf16_t*)(ws + WS_QZ), (const bf16_t*)(ws + WS_KVSH), HN};
            att::sb_phase(lds, A);
        }
        SEAM(pb + 1);
        if (IN(pb + 2)) {
            pg8::Gemm g{HN, (const bf16_t*)(ws + WS_WBOUT + (l - 2) * WOUT_BYTES), MTOK, DM, DM}; pg8::StaticOrder S; S.init(MTOK, DM, G, (int)blockIdx.x);
            pg8::EpiRes E{XB, P.out, DM, SSP, 0};
            pg8::gemm_phase<pg8::EpiRes, pg8::StaticOrder, true, true>(lds, g, S, E);
        }
        SEAM(pb + 2);
    }
    if (IN(15)) phase_final_norm(XB, P.out, P.in[26], SSP, lds);
#undef IN
#undef SEAM
}

extern "C" void kernel_launch(void* const* d_in, const int* in_sizes, int n_in, void* d_out, int out_size, void* d_ws, size_t ws_size, hipStream_t stream) {
    static int grid = 0;
    if (grid == 0) {
        if (n_in != 27 || out_size != MTOK * DM || ws_size < WS_END) { fprintf(stderr, "kernel_launch: unexpected shapes (n_in %d, out %d, ws %zu < %zu)\n", n_in, out_size, ws_size, (size_t)WS_END); grid = -1; return; }
        int dev = 0, cus = 0, per_cu = 0;
        if (hipGetDevice(&dev) != hipSuccess || hipDeviceGetAttribute(&cus, hipDeviceAttributeMultiprocessorCount, dev) != hipSuccess || cus <= 0) { grid = -1; return; }
        if (hipFuncSetAttribute((const void*)yoco_fwd, hipFuncAttributeMaxDynamicSharedMemorySize, LDS_BYTES) != hipSuccess) { fprintf(stderr, "kernel_launch: hipFuncSetAttribute failed\n"); grid = -1; return; }
        if (hipOccupancyMaxActiveBlocksPerMultiprocessor(&per_cu, (const void*)yoco_fwd, 512, LDS_BYTES) != hipSuccess || per_cu < 1) { fprintf(stderr, "kernel_launch: occupancy query says %d\n", per_cu); }
        (void)hipGetLastError();
        grid = cus;
    }
    if (grid < 0) return;
    (void)hipMemsetAsync((char*)d_ws + WS_CTL, 0, CTL_ZERO_BYTES, stream);
    Params p{};
    for (int i = 0; i < 27; ++i) p.in[i] = (const float*)d_in[i];
    p.out = (float*)d_out; p.ws = (unsigned char*)d_ws;
    p.ph_lo = 0; p.ph_hi = NPHASES;
    hipLaunchKernelGGL(yoco_fwd, dim3(grid), dim3(512), LDS_BYTES, stream, p);
}
```

```cpp
#include <hip/hip_runtime.h>
#include <cstdio>
#include <cstdint>

#define LAS __attribute__((address_space(3)))
#define GAS __attribute__((address_space(1)))
typedef unsigned short bf16_t;
typedef short bf16x8 __attribute__((ext_vector_type(8)));
typedef short s16x4 __attribute__((ext_vector_type(4)));
typedef float f32x4 __attribute__((ext_vector_type(4)));
typedef float f32x16 __attribute__((ext_vector_type(16)));
typedef unsigned u32x4 __attribute__((ext_vector_type(4)));
typedef unsigned u32x2 __attribute__((ext_vector_type(2)));

constexpr int BATCH = 8, SEQ = 2048, DM = 4096, NH = 32, HD = 128, NGRP = 4, GSZ = 8;
constexpr int MTOK = BATCH * SEQ;
constexpr int NSA_N = 19456;
constexpr int KVW = 3072, ZW = 12288, NGATE = 96;
constexpr int NCMP = 127;
constexpr float RMS_EPS = 1e-6f;
constexpr float SM_SCALE = 0.08838834764831845f;
constexpr float LOG2E = 1.4426950408889634f;
constexpr float LN2 = 0.6931471805599453f;

constexpr size_t MiB = 1u << 20;
constexpr size_t WS_CTL = 0, CTL_ZERO_BYTES = 32 * 1024;
constexpr int XCD_BAR_WORDS_MAX = 3456;
constexpr size_t WS_SS = 64 * 1024;
constexpr size_t WS_C1 = 1 * MiB;
constexpr size_t WS_KC = 2 * MiB;
constexpr size_t WS_VC = 3 * MiB;
constexpr size_t WS_W2T = 4 * MiB;
constexpr size_t WS_W1T = 8 * MiB;
constexpr size_t WS_SSP = 12 * MiB;
constexpr int SS_NP = 64;
constexpr size_t WS_WG = 16 * MiB;
constexpr size_t WS_WAIN = 20 * MiB;
constexpr size_t WAIN_BYTES = (size_t)NSA_N * DM * 2;
constexpr size_t WS_WAOUT = WS_WAIN + 2 * WAIN_BYTES;
constexpr size_t WOUT_BYTES = (size_t)DM * DM * 2;
constexpr size_t WS_WKVQ = WS_WAOUT + 2 * WOUT_BYTES;
constexpr size_t WS_WB3 = WS_WKVQ + (size_t)16384 * DM * 2;
constexpr size_t WS_WBOUT = WS_WB3 + (size_t)8192 * DM * 2;
constexpr size_t WS_HN = WS_WBOUT + 2 * WOUT_BYTES;
constexpr size_t WS_PROJ = WS_HN + (size_t)MTOK * DM * 2;
constexpr size_t WS_Q = WS_PROJ;
constexpr size_t WS_KV = WS_Q + (size_t)MTOK * DM * 2;
constexpr size_t WS_Z = WS_KV + (size_t)MTOK * KVW * 2;
constexpr size_t WS_G = WS_Z + (size_t)MTOK * ZW * 2;
constexpr size_t WS_KVSH = WS_PROJ;
constexpr size_t WS_QZ = WS_KVSH + (size_t)MTOK * 8192 * 2;
constexpr size_t WS_XB = WS_G + (size_t)MTOK * NGATE * 4;
constexpr size_t WS_END = WS_XB + (size_t)MTOK * DM * 2;
static_assert(WS_END <= (size_t)1515 * MiB, "d_ws map must fit the guaranteed workspace (sum of inputs = 1515 MiB)");
static_assert(WS_QZ + (size_t)MTOK * 8192 * 2 <= WS_XB, "SB overlay");
static_assert(XCD_BAR_WORDS_MAX * 4 <= CTL_ZERO_BYTES, "barrier words inside the memset region");

constexpr int LDS_BYTES = 147456;
constexpr int MISC_OFF = LDS_BYTES - 256;

__device__ __forceinline__ float row_sumsq(const float* ss, int np, int row) {
    float s = 0.f;
#pragma unroll 8
    for (int p = 0; p < np; ++p) s += ss[(size_t)p * MTOK + row];
    return s;
}
namespace pg8 {
#define PG8_LAS __attribute__((address_space(3)))
typedef unsigned short bf16_t;
typedef short bf16x8 __attribute__((ext_vector_type(8)));
typedef float f32x4 __attribute__((ext_vector_type(4)));
typedef unsigned u32x4 __attribute__((ext_vector_type(4)));
constexpr int BM = 256, BK = 64, HALF = 128, HTB = HALF * BK * 2  , STAGE_BYTES = 8 * HTB, NXCD = 8, WGM = 8;

__host__ __device__ __forceinline__ int lds_byte(int r, int c) { const int st = (r >> 4) * 2 + (c >> 5), rr = r & 15, cc = c & 31, ob = rr * 64 + cc * 2; return st * 1024 + (ob ^ (((ob >> 9) & 1) << 5)); }
__host__ __device__ __forceinline__ void stage_rc(int b, int& R, int& C) { const int st = b / 1024, sb = b % 1024, swz = sb ^ (((sb >> 9) & 1) << 5); R = (st >> 1) * 16 + swz / 64; C = (st & 1) * 32 + (swz % 64) / 2; }
__host__ __device__ __forceinline__ int perm32(int rho) { const int n = rho >> 4, i = rho & 15; return 8 * (i >> 2) + 4 * n + (i & 3); }

struct Unit { int pm, pn; };
struct Gemm { const bf16_t* A; const bf16_t* Bt; int M, N, K; };

struct StaticOrder {
    int nM, nN, nwg, G, c;
    __host__ __device__ void init(int M, int N, int G_, int c_) { nM = M / BM; nN = N / BM; nwg = nM * nN; G = G_; c = c_; }
    __host__ __device__ bool next(int i, Unit& u) const {
        const long L = (long)i * G + c; if (L >= nwg) return false;
        int wgid = (int)L; { const int q = nwg / NXCD, r = nwg % NXCD, xcd = wgid % NXCD, off = wgid / NXCD; wgid = (xcd < r ? xcd * (q + 1) : r * (q + 1) + (xcd - r) * q) + off; }
        const int nig = WGM * nN, gid = wgid / nig, fm = gid * WGM, gsz = (nM - fm) < WGM ? (nM - fm) : WGM;
        u.pm = fm + ((wgid % nig) % gsz); u.pn = (wgid % nig) / gsz; return true;
    }
    __device__ __forceinline__ void a_ready(const Unit&) const {}
    __device__ __forceinline__ void done(const Unit&) const {}
};


__device__ __forceinline__ unsigned cvt_pk_bf16(float lo, float hi) { unsigned r; asm volatile("v_cvt_pk_bf16_f32 %0, %1, %2" : "=v"(r) : "v"(lo), "v"(hi)); return r; }

struct EpiSplit {
    static constexpr bool PERM = true, AFTER_DRAIN = false;
    bf16_t* O0; int ld0; int t1; bf16_t* O1; int ld1; int t2; bf16_t* O2; int ld2; const float* ss; const PG8_LAS float* rs_lds; int fm; int np;
    __device__ __forceinline__ void operator()(const f32x4 (&acc)[2][2][4][2], const Unit& u, int wr, int wc, int fr, int fq) const {
        const int row0 = u.pm * BM + wr * 64 + fr;
        bf16_t* base; int ldc, ct;
        if (u.pn < t1) { base = O0; ldc = ld0; ct = u.pn; } else if (u.pn < t2) { base = O1; ldc = ld1; ct = u.pn - t1; } else { base = O2; ldc = ld2; ct = u.pn - t2; }
        const int col0 = ct * BM + wc * 32 + 8 * fq;
#pragma unroll
        for (int ai = 0; ai < 2; ++ai)
#pragma unroll
            for (int m = 0; m < 4; ++m) { bf16_t* rowp = base + (size_t)(row0 + ai * HALF + m * 16) * ldc + col0;
                const unsigned pl = (unsigned)(u.pm - fm);
                const float rs = pl < 8u ? rs_lds[pl * BM + wr * 64 + fr + ai * HALF + m * 16] : 1.0f / sqrtf(row_sumsq(ss, np, row0 + ai * HALF + m * 16) * (1.0f / 4096.0f) + 1e-6f);
#pragma unroll
                for (int bj = 0; bj < 2; ++bj) { const f32x4 v0 = acc[ai][bj][m][0] * rs, v1 = acc[ai][bj][m][1] * rs;
                    u32x4 w; w.x = cvt_pk_bf16(v0[0], v0[1]); w.y = cvt_pk_bf16(v0[2], v0[3]); w.z = cvt_pk_bf16(v1[0], v1[1]); w.w = cvt_pk_bf16(v1[2], v1[3]);
                    *(u32x4*)(rowp + bj * HALF) = w; } }
    }
};
struct EpiRes {
    static constexpr bool PERM = true, AFTER_DRAIN = false;
    bf16_t* xb; float* out; int ldc; float* ssp; int last;
    __device__ __forceinline__ void operator()(const f32x4 (&acc)[2][2][4][2], const Unit& u, int wr, int wc, int fr, int fq) const {
        const int row0 = u.pm * BM + wr * 64 + fr, col0 = u.pn * BM + wc * 32 + 8 * fq;
        float* sp = ssp + (size_t)(u.pn * 4 + wc) * MTOK;
        u32x4 r[2][4][2];
#pragma unroll
        for (int ai = 0; ai < 2; ++ai)
#pragma unroll
            for (int m = 0; m < 4; ++m) { const size_t off = (size_t)(row0 + ai * HALF + m * 16) * ldc + col0;
#pragma unroll
                for (int bj = 0; bj < 2; ++bj) r[ai][m][bj] = *(const u32x4*)(xb + off + bj * HALF); }
#pragma unroll
        for (int ai = 0; ai < 2; ++ai) {
#pragma unroll
            for (int m = 0; m < 4; ++m) { const size_t off = (size_t)(row0 + ai * HALF + m * 16) * ldc + col0;
                float sq = 0.f;
#pragma unroll
                for (int bj = 0; bj < 2; ++bj) { const u32x4 rv = r[ai][m][bj];
                    const f32x4 o0 = (f32x4){__uint_as_float(rv.x << 16), __uint_as_float(rv.x & 0xffff0000u), __uint_as_float(rv.y << 16), __uint_as_float(rv.y & 0xffff0000u)} + acc[ai][bj][m][0];
                    const f32x4 o1 = (f32x4){__uint_as_float(rv.z << 16), __uint_as_float(rv.z & 0xffff0000u), __uint_as_float(rv.w << 16), __uint_as_float(rv.w & 0xffff0000u)} + acc[ai][bj][m][1];
                    sq += ((o0[0] * o0[0] + o0[1] * o0[1]) + (o0[2] * o0[2] + o0[3] * o0[3])) + ((o1[0] * o1[0] + o1[1] * o1[1]) + (o1[2] * o1[2] + o1[3] * o1[3]));
                    u32x4 w; w.x = cvt_pk_bf16(o0[0], o0[1]); w.y = cvt_pk_bf16(o0[2], o0[3]); w.z = cvt_pk_bf16(o1[0], o1[1]); w.w = cvt_pk_bf16(o1[2], o1[3]); *(u32x4*)(xb + off + bj * HALF) = w; }
                sq += __shfl_xor(sq, 16); sq += __shfl_xor(sq, 32);
                if (fq == 0) sp[row0 + ai * HALF + m * 16] = sq; }
            asm volatile("" ::: "memory");
        }
    }
};
template <class Epi, class Sched, bool ALIGN_EPI = false, bool SP2 = false>
__device__ __forceinline__ void gemm_phase(PG8_LAS unsigned char* lds, const Gemm g, const Sched& S, const Epi& E) {
    int tid_ = (int)threadIdx.x; asm volatile("" : "+v"(tid_));
    const int tid = tid_, wid = __builtin_amdgcn_readfirstlane(tid >> 6), lane = tid & 63, wr = wid >> 2, wc = wid & 3, fr = lane & 15, fq = lane >> 4;
    const int K = g.K, nt = K / BK;
    unsigned voffA[2], voffB[2];
#pragma unroll
    for (int i = 0; i < 2; ++i) { int R, C; stage_rc(tid * 16 + i * 8192, R, C); const int Rb = Epi::PERM ? ((R & ~31) + perm32(R & 31)) : R;
        voffA[i] = (unsigned)(R * K + C) * 2u; voffB[i] = (unsigned)(Rb * K + C) * 2u; }
    asm volatile("" : "+v"(voffA[0]), "+v"(voffA[1]), "+v"(voffB[0]), "+v"(voffB[1]));
    const size_t kstep = (size_t)(BK * 2);
    const size_t hstep = (size_t)HALF * K * 2;
    const size_t tstep = 2 * hstep;
    const unsigned ldsw = (unsigned)wid * 1024u;
    const int aoff = lds_byte(wr * 64 + fr, fq * 8), boff = lds_byte(wc * 32 + fr, fq * 8);
#define PG8_SA(b, h) (((b) * 2 + (h)) * HTB)
#define PG8_SB(b, h) ((4 + (b) * 2 + (h)) * HTB)
#define PG8_STAGE(bufoff, gbase, voff) do { _Pragma("unroll") for (int _i = 0; _i < 2; ++_i) \
        __builtin_amdgcn_global_load_lds((const unsigned*)((const char*)(gbase) + (voff)[_i]), (PG8_LAS unsigned*)(lds + (bufoff) + ldsw + _i * 8192), 16, 0, 0); } while (0)
#define PG8_LDA(dst, b, h) do { _Pragma("unroll") for (int m = 0; m < 4; ++m) _Pragma("unroll") for (int k = 0; k < 2; ++k) dst[m][k] = *(const PG8_LAS bf16x8*)(lds + PG8_SA(b, h) + aoff + m * 2048 + k * 1024); } while (0)
#define PG8_LDB(dst, b, h) do { _Pragma("unroll") for (int n = 0; n < 2; ++n) _Pragma("unroll") for (int k = 0; k < 2; ++k) dst[n][k] = *(const PG8_LAS bf16x8*)(lds + PG8_SB(b, h) + boff + n * 2048 + k * 1024); } while (0)
#define PG8_MMA(ai, bj, At, Bt) do { __builtin_amdgcn_s_setprio(1); _Pragma("unroll") for (int m = 0; m < 4; ++m) _Pragma("unroll") for (int n = 0; n < 2; ++n) _Pragma("unroll") for (int k = 0; k < 2; ++k) \
        acc[ai][bj][m][n] = __builtin_amdgcn_mfma_f32_16x16x32_bf16(Bt[n][k], At[m][k], acc[ai][bj][m][n], 0, 0, 0); __builtin_amdgcn_s_setprio(0); } while (0)
#define PG8_WAIT_V(n) asm volatile("s_waitcnt vmcnt(" #n ")" ::: "memory")
#define PG8_WAIT_L(n) asm volatile("s_waitcnt lgkmcnt(" #n ")" ::: "memory")
#define PG8_BAR __builtin_amdgcn_s_barrier()
#define PG8_SCHED __builtin_amdgcn_sched_barrier(0)
    Unit cur, nxt; int ui = 0;
    if (!S.next(0, cur)) return;
    f32x4 acc[2][2][4][2];
#pragma unroll
    for (int a = 0; a < 2; ++a)
#pragma unroll
        for (int b = 0; b < 2; ++b)
#pragma unroll
            for (int m = 0; m < 4; ++m)
#pragma unroll
                for (int n = 0; n < 2; ++n) acc[a][b][m][n] = (f32x4){0.f, 0.f, 0.f, 0.f};
    bf16x8 At[4][2], B0[2][2], B1[2][2];
    const char* cA = (const char*)g.A + (size_t)cur.pm * tstep; const char* cB = (const char*)g.Bt + (size_t)cur.pn * tstep;
    S.a_ready(cur);
    if constexpr (SP2) {
        PG8_STAGE(PG8_SB(0, 0), cB, voffB); PG8_STAGE(PG8_SB(0, 1), cB + hstep, voffB); PG8_STAGE(PG8_SA(0, 0), cA, voffA); PG8_STAGE(PG8_SA(0, 1), cA + hstep, voffA);
        if (wr == 1) PG8_BAR;
        PG8_WAIT_V(2); PG8_BAR;
        PG8_STAGE(PG8_SB(1, 0), cB + kstep, voffB); PG8_STAGE(PG8_SA(1, 0), cA + kstep, voffA); PG8_STAGE(PG8_SB(1, 1), cB + hstep + kstep, voffB);
        PG8_WAIT_V(6); PG8_BAR;
    } else {
        PG8_STAGE(PG8_SB(0, 0), cB, voffB); PG8_STAGE(PG8_SA(0, 0), cA, voffA); PG8_STAGE(PG8_SB(0, 1), cB + hstep, voffB); PG8_STAGE(PG8_SA(0, 1), cA + hstep, voffA);
        if (wr == 1) PG8_BAR;
        PG8_WAIT_V(4); PG8_BAR;
        PG8_STAGE(PG8_SB(1, 0), cB + kstep, voffB); PG8_STAGE(PG8_SA(1, 0), cA + kstep, voffA); PG8_STAGE(PG8_SB(1, 1), cB + hstep + kstep, voffB);
        PG8_WAIT_V(6); PG8_BAR;
    }
    for (;;) {
        const bool has_next = S.next(ui + 1, nxt);
        const char* nA = has_next ? (const char*)g.A + (size_t)nxt.pm * tstep : cA; const char* nB = has_next ? (const char*)g.Bt + (size_t)nxt.pn * tstep : cB;
        for (int t = 0; t < nt; t += 2) {
            const bool last = (t == nt - 2);
            const char* a1 = cA + (size_t)(t + 1) * kstep;
            const char* a2 = last ? nA : cA + (size_t)(t + 2) * kstep; const char* b2 = last ? nB : cB + (size_t)(t + 2) * kstep;
            const char* a3 = a2 + kstep; const char* b3 = b2 + kstep;
            if (last && has_next) S.a_ready(nxt);
            if constexpr (SP2) {
            PG8_LDB(B0, 0, 0); PG8_LDB(B1, 0, 1); PG8_SCHED; PG8_LDA(At, 0, 0); PG8_STAGE(PG8_SA(1, 1), a1 + hstep, voffA);
            PG8_WAIT_V(8); PG8_WAIT_L(0); PG8_BAR; PG8_MMA(0, 0, At, B0); PG8_MMA(0, 1, At, B1); PG8_BAR; PG8_SCHED;
            PG8_LDA(At, 0, 1); PG8_STAGE(PG8_SB(0, 0), b2, voffB); PG8_STAGE(PG8_SB(0, 1), b2 + hstep, voffB); PG8_STAGE(PG8_SA(0, 0), a2, voffA);
            PG8_WAIT_V(8); PG8_WAIT_L(0); PG8_BAR; PG8_MMA(1, 0, At, B0); PG8_MMA(1, 1, At, B1); PG8_BAR; PG8_SCHED;
            PG8_LDB(B0, 1, 0); PG8_LDB(B1, 1, 1); PG8_SCHED; PG8_LDA(At, 1, 0); PG8_STAGE(PG8_SA(0, 1), a2 + hstep, voffA);
            PG8_WAIT_V(8); PG8_WAIT_L(0); PG8_BAR; PG8_MMA(0, 0, At, B0); PG8_MMA(0, 1, At, B1); PG8_BAR; PG8_SCHED;
            PG8_LDA(At, 1, 1); PG8_STAGE(PG8_SB(1, 0), b3, voffB); PG8_STAGE(PG8_SB(1, 1), b3 + hstep, voffB); PG8_STAGE(PG8_SA(1, 0), a3, voffA);
            PG8_WAIT_V(8); PG8_WAIT_L(0); PG8_BAR; PG8_MMA(1, 0, At, B0); PG8_MMA(1, 1, At, B1); PG8_BAR; PG8_SCHED;
            } else {
            PG8_LDB(B0, 0, 0); PG8_SCHED; PG8_LDA(At, 0, 0); PG8_STAGE(PG8_SA(1, 1), a1 + hstep, voffA);
            PG8_WAIT_L(8); PG8_BAR; PG8_WAIT_L(0); PG8_MMA(0, 0, At, B0); PG8_BAR; PG8_SCHED;
            PG8_LDB(B1, 0, 1); PG8_STAGE(PG8_SB(0, 0), b2, voffB);
            PG8_BAR; PG8_WAIT_L(0); PG8_MMA(0, 1, At, B1); PG8_BAR;
            PG8_LDA(At, 0, 1); PG8_STAGE(PG8_SA(0, 0), a2, voffA);
            PG8_BAR; PG8_WAIT_L(0); PG8_MMA(1, 0, At, B0); PG8_BAR; PG8_SCHED;
            PG8_STAGE(PG8_SB(0, 1), b2 + hstep, voffB);
            PG8_WAIT_V(6); PG8_BAR; PG8_MMA(1, 1, At, B1); PG8_BAR;
            PG8_LDB(B0, 1, 0); PG8_SCHED; PG8_LDA(At, 1, 0); PG8_STAGE(PG8_SA(0, 1), a2 + hstep, voffA);
            PG8_WAIT_L(8); PG8_BAR; PG8_WAIT_L(0); PG8_MMA(0, 0, At, B0); PG8_BAR; PG8_SCHED;
            PG8_LDB(B1, 1, 1); PG8_STAGE(PG8_SB(1, 0), b3, voffB);
            PG8_BAR; PG8_WAIT_L(0); PG8_MMA(0, 1, At, B1); PG8_BAR;
            PG8_LDA(At, 1, 1); PG8_STAGE(PG8_SA(1, 0), a3, voffA);
            PG8_BAR; PG8_WAIT_L(0); PG8_MMA(1, 0, At, B0); PG8_BAR; PG8_SCHED;
            PG8_STAGE(PG8_SB(1, 1), b3 + hstep, voffB);
            PG8_WAIT_V(6); PG8_BAR; PG8_MMA(1, 1, At, B1); PG8_BAR;
            }
        }
        if constexpr (ALIGN_EPI) { if (wr == 0) PG8_BAR; }
        if constexpr (!Epi::AFTER_DRAIN) { E(acc, cur, wr, wc, fr, fq); S.done(cur); }
        if (!has_next) break;
#pragma unroll
        for (int a = 0; a < 2; ++a)
#pragma unroll
            for (int b = 0; b < 2; ++b)
#pragma unroll
                for (int m = 0; m < 4; ++m)
#pragma unroll
                    for (int n = 0; n < 2; ++n) acc[a][b][m][n] = (f32x4){0.f, 0.f, 0.f, 0.f};
        cur = nxt; cA = nA; cB = nB; ++ui;
        if constexpr (ALIGN_EPI) { if (wr == 1) PG8_BAR; }
    }
    PG8_WAIT_V(0);
    if constexpr (!ALIGN_EPI) { if (wr == 0) PG8_BAR; }
    PG8_BAR;
    if constexpr (Epi::AFTER_DRAIN) { E.fused(acc, cur, wr, wc, fr, fq, lds, wid, lane); S.done(cur); }
#undef PG8_SA
#undef PG8_SB
#undef PG8_STAGE
#undef PG8_LDA
#undef PG8_LDB
#undef PG8_MMA
#undef PG8_WAIT_V
#undef PG8_WAIT_L
#undef PG8_BAR
#undef PG8_SCHED
}
}
#define XB_TMO      128
#define XB_XCNT(j)  (256  + 64 * (j))
#define XB_XSUB(j)  (1280 + 64 * (j))
#define XB_XGEN(j)  (2304 + 64 * (j))
#define XB_TOP      3328
#define XB_TOPGEN   3392
#define XCD_BAR_WORDS 3456
#define XB_SPIN_CAP (1u << 18)

__device__ __forceinline__ unsigned xb_ld(unsigned* p)              { return __hip_atomic_load(p, __ATOMIC_RELAXED, __HIP_MEMORY_SCOPE_AGENT); }
__device__ __forceinline__ unsigned xb_add(unsigned* p, unsigned v) { return __hip_atomic_fetch_add(p, v, __ATOMIC_RELAXED, __HIP_MEMORY_SCOPE_AGENT); }
__device__ __forceinline__ unsigned xb_xcc_id() { return (unsigned)__builtin_amdgcn_s_getreg((3 << 11) | 20) & 0xFu; }
#define XB_SPIN(cond, bar) do { unsigned _sp = 0; while (cond) { __builtin_amdgcn_s_sleep(1); \
    if ((++_sp & 255u) == 0u) { if (xb_ld(&(bar)[XB_TMO])) break; if (_sp > XB_SPIN_CAP) { atomicAdd(&(bar)[XB_TMO], 1u); break; } } } } while (0)

struct XcdBarrier {
    unsigned* bar; unsigned x;
    volatile LAS unsigned* st;
};

__device__ __forceinline__ XcdBarrier xcd_barrier_post(unsigned* bar, volatile LAS unsigned* st) {
    XcdBarrier b; b.bar = bar; b.x = xb_xcc_id(); b.st = st;
    if (threadIdx.x == 0) (void)xb_add(&bar[XB_XCNT(b.x)], 1u);
    return b;
}
__device__ __forceinline__ void xcd_barrier_complete(unsigned* bar, unsigned x, unsigned& nloc, unsigned& nx) {
    const unsigned G = gridDim.x * gridDim.y * gridDim.z;
    unsigned sum, cnt, mine, sp = 0u;
    for (;;) {
        sum = 0u; cnt = 0u; mine = 0u;
#pragma unroll
        for (unsigned j = 0; j < 16; ++j) { const unsigned c = xb_ld(&bar[XB_XCNT(j)]); sum += c; cnt += (c > 0u) ? 1u : 0u; mine = (j == x) ? c : mine; }
        if (sum == G) break;
        __builtin_amdgcn_s_sleep(1);
        if ((++sp & 255u) == 0u) { if (xb_ld(&bar[XB_TMO])) break; if (sp > XB_SPIN_CAP) { atomicAdd(&bar[XB_TMO], 1u); break; } }
    }
    nloc = mine > 0u ? mine : 1u; nx = cnt > 0u ? cnt : 1u;
}

__device__ __forceinline__ void xcd_barrier(const XcdBarrier& b) {
    asm volatile("s_waitcnt vmcnt(0)" ::: "memory");
    __syncthreads();
    if (threadIdx.x == 0) {
        unsigned* bar = b.bar;
        __builtin_amdgcn_s_waitcnt(0);
        unsigned nloc = b.st[0], nx = b.st[1];
        if (nloc == 0u) { xcd_barrier_complete(bar, b.x, nloc, nx); b.st[0] = nloc; b.st[1] = nx; }
        const unsigned old = xb_add(&bar[XB_XSUB(b.x)], 1u);
        const unsigned gen = old / nloc;
        if (old + 1u == (gen + 1u) * nloc) {
            __builtin_amdgcn_fence(__ATOMIC_RELEASE, "agent");
            asm volatile("s_waitcnt vmcnt(0)" ::: "memory");
            const unsigned og = xb_add(&bar[XB_TOP], 1u);
            const unsigned tg = og / nx;
            if (og + 1u == (tg + 1u) * nx) xb_add(&bar[XB_TOPGEN], 1u);
            else XB_SPIN(xb_ld(&bar[XB_TOPGEN]) == tg, bar);
            __builtin_amdgcn_fence(__ATOMIC_ACQUIRE, "agent");
            xb_add(&bar[XB_XGEN(b.x)], 1u);
            asm volatile("s_waitcnt vmcnt(0)" ::: "memory");
        } else {
            XB_SPIN(xb_ld(&bar[XB_XGEN(b.x)]) == gen, bar);
            __builtin_amdgcn_fence(__ATOMIC_ACQUIRE, "agent");
            asm volatile("s_waitcnt vmcnt(0)" ::: "memory");
        }
    }
    __syncthreads();
}

#define LDS_WAIT() asm volatile("s_waitcnt lgkmcnt(0)" ::: "memory")
#define VM_WAIT() asm volatile("s_waitcnt vmcnt(0)" ::: "memory")
#define SBAR() __builtin_amdgcn_sched_barrier(0)
__device__ __forceinline__ unsigned cvtpk(float lo, float hi) { unsigned r; asm volatile("v_cvt_pk_bf16_f32 %0, %1, %2" : "=v"(r) : "v"(lo), "v"(hi)); return r; }
__device__ __forceinline__ float bf_lo(unsigned w) { return __uint_as_float(w << 16); }
__device__ __forceinline__ float bf_hi(unsigned w) { return __uint_as_float(w & 0xffff0000u); }
__device__ __forceinline__ float bf2f(bf16_t h) { return __uint_as_float(((unsigned)h) << 16); }
__device__ __forceinline__ float wave_sum(float v) {
#pragma unroll
    for (int o = 1; o < 64; o <<= 1) v += __shfl_xor(v, o);
    return v;
}
__device__ __forceinline__ float fast_exp2(float x) { return __builtin_amdgcn_exp2f(x); }
__device__ __forceinline__ float fast_log2(float x) { return __builtin_amdgcn_logf(x); }
__device__ __forceinline__ float fast_rcp(float x) { return __builtin_amdgcn_rcpf(x); }

__device__ __forceinline__ int tid_now() { int t = (int)threadIdx.x; asm volatile("" : "+v"(t)); return t; }

struct Params { const float* in[27]; float* out; unsigned char* ws; int ph_lo, ph_hi; };

struct TrJob { int src, N, c0, ncols, K, gain, r0; size_t dst; };
__device__ __forceinline__ void tr_item(const float* W, int N, int c0, int ncols, int K, const float* gain, bf16_t* WT, int r0, int kb, int nb, LAS float* scr, int lane) {
    const int k0 = kb * 64, n0 = nb * 64;
    const float* src = W + (size_t)k0 * N + c0 + n0 + lane;
#pragma unroll 16
    for (int i = 0; i < 64; ++i) scr[i * 65 + lane] = src[(size_t)i * N];
    LDS_WAIT(); asm volatile("" ::: "memory");
    const int c = lane & 7;
    float gv[8];
#pragma unroll
    for (int e = 0; e < 8; ++e) gv[e] = gain ? gain[k0 + 8 * c + e] : 1.0f;
#pragma unroll
    for (int j = 0; j < 8; ++j) { const int n = (lane >> 3) + 8 * j; const LAS float* s = scr + (8 * c) * 65 + n;
        u32x4 o; o.x = cvtpk(s[0 * 65] * gv[0], s[1 * 65] * gv[1]); o.y = cvtpk(s[2 * 65] * gv[2], s[3 * 65] * gv[3]); o.z = cvtpk(s[4 * 65] * gv[4], s[5 * 65] * gv[5]); o.w = cvtpk(s[6 * 65] * gv[6], s[7 * 65] * gv[7]);
        if (n0 + n >= ncols) o = (u32x4){0u, 0u, 0u, 0u};
        *(u32x4*)(WT + (size_t)(r0 + n0 + n) * K + k0 + 8 * c) = o; }
    LDS_WAIT(); asm volatile("" ::: "memory");
}
constexpr int NJOBS = 21;
__device__ __forceinline__ TrJob get_job(int id) {
    TrJob j{};
    if (id < 16) { const int l = id >> 3, k = id & 7, ib = 2 + 8 * l;
        switch (k) {
        case 0: j = TrJob{ib + 1, 19552, 0, 7168, 4096, ib, 0, WS_WAIN + l * WAIN_BYTES}; break;
        case 1: j = TrJob{ib + 1, 19552, 7264, 12288, 4096, ib, 7168, WS_WAIN + l * WAIN_BYTES}; break;
        case 2: j = TrJob{ib + 1, 19552, 7168, 96, 4096, ib, 0, WS_WG + (size_t)l * 128 * 4096 * 2}; break;
        case 3: j = TrJob{ib + 7, 4096, 0, 4096, 4096, -1, 0, WS_WAOUT + l * WOUT_BYTES}; break;
        case 4: j = TrJob{ib + 3, 128, 0, 128, 4096, -1, 0, WS_W1T + (size_t)(l * 2 + 0) * 128 * 4096 * 2}; break;
        case 5: j = TrJob{ib + 5, 128, 0, 128, 4096, -1, 0, WS_W1T + (size_t)(l * 2 + 1) * 128 * 4096 * 2}; break;
        case 6: j = TrJob{ib + 4, 128, 0, 128, 128, -1, 0, WS_W2T + (size_t)(l * 2 + 0) * 128 * 128 * 2}; break;
        default: j = TrJob{ib + 6, 128, 0, 128, 128, -1, 0, WS_W2T + (size_t)(l * 2 + 1) * 128 * 128 * 2}; break;
        }
    } else {
        switch (id) {
        case 16: j = TrJob{19, 8192, 0, 8192, 4096, 18, 0, WS_WKVQ}; break;
        case 17: j = TrJob{21, 8192, 0, 8192, 4096, 20, 8192, WS_WKVQ}; break;
        case 18: j = TrJob{22, 4096, 0, 4096, 4096, -1, 0, WS_WBOUT}; break;
        case 19: j = TrJob{24, 8192, 0, 8192, 4096, 23, 0, WS_WB3}; break;
        default: j = TrJob{25, 4096, 0, 4096, 4096, -1, 0, WS_WBOUT + WOUT_BYTES}; break;
        }
    }
    return j;
}
__device__ __forceinline__ int job_items(const TrJob& j) { return (j.K / 64) * ((j.ncols + 63) / 64); }

__device__ __forceinline__ void phase_x_to_bf16(const float* x, bf16_t* xb, float* ss) {
    const int tid = tid_now(), lane = tid & 63, gw = blockIdx.x * 8 + __builtin_amdgcn_readfirstlane(tid >> 6), ngw = gridDim.x * 8;
    for (int m = gw; m < MTOK; m += ngw) {
        const f32x4* xr = (const f32x4*)(x + (size_t)m * DM) + 2 * lane; u32x4* o16 = (u32x4*)(xb + (size_t)m * DM) + lane;
        f32x4 v[16]; float s = 0.f;
#pragma unroll
        for (int j = 0; j < 8; ++j) { v[2 * j] = xr[128 * j]; v[2 * j + 1] = xr[128 * j + 1]; }
#pragma unroll
        for (int j = 0; j < 16; ++j) s += (v[j].x * v[j].x + v[j].y * v[j].y) + (v[j].z * v[j].z + v[j].w * v[j].w);
#pragma unroll
        for (int j = 0; j < 8; ++j) { u32x4 w; w.x = cvtpk(v[2 * j].x, v[2 * j].y); w.y = cvtpk(v[2 * j].z, v[2 * j].w); w.z = cvtpk(v[2 * j + 1].x, v[2 * j + 1].y); w.w = cvtpk(v[2 * j + 1].z, v[2 * j + 1].w); o16[64 * j] = w; }
        s = wave_sum(s);
        if (lane == 0) ss[m] = s;
    }
}
__device__ __forceinline__ void phase_final_norm(const bf16_t* xb, float* out, const float* g, const float* ss, LAS unsigned char* lds) {
    const int tid = tid_now(), lane = tid & 63, wave = __builtin_amdgcn_readfirstlane(tid >> 6);
    LAS float* RSF = (LAS float*)lds;
    for (int r0 = blockIdx.x * 64; r0 < MTOK; r0 += gridDim.x * 64) {
        __syncthreads();
        { const int row = tid & 63, part = tid >> 6; float s8 = 0.f;
#pragma unroll
          for (int p = 0; p < 8; ++p) s8 += ss[(size_t)(part * 8 + p) * MTOK + r0 + row];
          RSF[64 + part * 64 + row] = s8; }
        __syncthreads();
        if (tid < 64) { float t = 0.f;
#pragma unroll
            for (int q = 0; q < 8; ++q) t += RSF[64 + q * 64 + tid];
            RSF[tid] = 1.0f / sqrtf(t * (1.0f / DM) + RMS_EPS); }
        __syncthreads();
        for (int k = 0; k < 8; ++k) { const int m = r0 + wave * 8 + k;
            const u32x4* xr = (const u32x4*)(xb + (size_t)m * DM) + lane; f32x4* orow = (f32x4*)(out + (size_t)m * DM) + 2 * lane; const f32x4* gr = (const f32x4*)g + 2 * lane;
            const float rstd = RSF[wave * 8 + k];
#pragma unroll
            for (int j = 0; j < 8; ++j) { const u32x4 v = xr[64 * j];
                const f32x4 lo = (f32x4){__uint_as_float(v.x << 16), __uint_as_float(v.x & 0xffff0000u), __uint_as_float(v.y << 16), __uint_as_float(v.y & 0xffff0000u)};
                const f32x4 hi = (f32x4){__uint_as_float(v.z << 16), __uint_as_float(v.z & 0xffff0000u), __uint_as_float(v.w << 16), __uint_as_float(v.w & 0xffff0000u)};
                orow[128 * j] = lo * rstd * gr[128 * j]; orow[128 * j + 1] = hi * rstd * gr[128 * j + 1]; } }
    }
}

__device__ __forceinline__ void phase_prologue(const Params& P, LAS unsigned char* lds) {
    const int tid = tid_now(), lane = tid & 63, wave = __builtin_amdgcn_readfirstlane(tid >> 6), G = gridDim.x;
    LAS float* scr = (LAS float*)(lds + wave * 16640);
    const int gw = blockIdx.x * 8 + wave, ngw = G * 8;
    int base = 0;
    for (int id = 0; id < NJOBS; ++id) {
        const TrJob j = get_job(id); const int ni = job_items(j), nbn = (j.ncols + 63) / 64;
        int it = gw - (base % ngw); if (it < 0) it += ngw;
        const float* W = P.in[j.src]; const float* gain = j.gain >= 0 ? P.in[j.gain] : nullptr; bf16_t* WT = (bf16_t*)(P.ws + j.dst);
        for (; it < ni; it += ngw) tr_item(W, j.N, j.c0, j.ncols, j.K, gain, WT, j.r0, it / nbn, it % nbn, scr, lane);
        base += ni;
    }
    __syncthreads();
    for (int item = blockIdx.x; item < 64; item += G) {
        const int lk = item >> 4, kp = item & 15, l = lk >> 1, kv = lk & 1, ib = 2 + 8 * l;
        const float* pos = P.in[ib + 2]; const float* w1 = P.in[ib + 3 + 2 * kv];
        const int col = tid & 127, part = tid >> 7, kbeg = kp * 256 + part * 64; float s = 0.f;
#pragma unroll 8
        for (int k = kbeg; k < kbeg + 64; ++k) s += pos[k] * w1[(size_t)k * 128 + col];
        LAS float* red = (LAS float*)lds;
        red[part * 128 + col] = s; __syncthreads();
        if (tid < 128) ((float*)(P.ws + WS_C1))[item * 128 + tid] = (red[tid] + red[128 + tid]) + (red[256 + tid] + red[384 + tid]);
        __syncthreads();
    }
    phase_x_to_bf16(P.in[0], (bf16_t*)(P.ws + WS_XB), (float*)(P.ws + WS_SS));
}

__device__ __forceinline__ bf16x8 ld8(const bf16_t* p) { return *(const bf16x8*)p; }
__device__ __forceinline__ void compress_unit(const Params& P, int l, int cu, LAS unsigned char* lds) {
    const int tid = tid_now(), lane = tid & 63, wave = __builtin_amdgcn_readfirstlane(tid >> 6);
    const int rt = cu & 3, kv = (cu >> 2) & 1, bg = cu >> 3, b = bg >> 2, g = bg & 3;
    const bf16_t* raw = (const bf16_t*)(P.ws + WS_KV) + (size_t)(b * SEQ) * KVW + kv * 512 + g * 128;
    const bf16_t* w1t = (const bf16_t*)(P.ws + WS_W1T) + (size_t)(l * 2 + kv) * 128 * 4096;
    const bf16_t* w2t = (const bf16_t*)(P.ws + WS_W2T) + (size_t)(l * 2 + kv) * 128 * 128;
    const float* c1p = (const float*)(P.ws + WS_C1) + (size_t)(l * 2 + kv) * 16 * 128;
    bf16_t* outp = (bf16_t*)(P.ws + (kv ? WS_VC : WS_KC)) + (size_t)bg * 128 * 128;
    const int fr = lane & 15, fq = lane >> 4;
    LAS float* PART = (LAS float*)lds;
    LAS bf16_t* H = (LAS bf16_t*)(lds + 131072);
    {
        int n0 = rt * 32 + fr, n1 = n0 + 16; n0 = n0 > 126 ? 126 : n0; n1 = n1 > 126 ? 126 : n1;
        const bf16_t* ap0 = raw + (size_t)(16 * n0 + wave * 4) * KVW + fq * 8; const bf16_t* ap1 = raw + (size_t)(16 * n1 + wave * 4) * KVW + fq * 8;
        const bf16_t* bp = w1t + (size_t)fr * 4096 + wave * 512 + fq * 8;
        f32x4 acc[2][8];
#pragma unroll
        for (int i = 0; i < 2; ++i)
#pragma unroll
            for (int c = 0; c < 8; ++c) acc[i][c] = (f32x4){0.f, 0.f, 0.f, 0.f};
#pragma unroll 4
        for (int ks = 0; ks < 16; ++ks) {
            const bf16x8 a0 = ld8(ap0 + (size_t)(ks >> 2) * KVW + (ks & 3) * 32), a1 = ld8(ap1 + (size_t)(ks >> 2) * KVW + (ks & 3) * 32);
            bf16x8 bb[8];
#pragma unroll
            for (int c = 0; c < 8; ++c) bb[c] = ld8(bp + (size_t)c * 16 * 4096 + ks * 32);
#pragma unroll
            for (int c = 0; c < 8; ++c) { acc[0][c] = __builtin_amdgcn_mfma_f32_16x16x32_bf16(a0, bb[c], acc[0][c], 0, 0, 0); acc[1][c] = __builtin_amdgcn_mfma_f32_16x16x32_bf16(a1, bb[c], acc[1][c], 0, 0, 0); }
        }
#pragma unroll
        for (int i = 0; i < 2; ++i)
#pragma unroll
            for (int c = 0; c < 8; ++c)
#pragma unroll
                for (int r = 0; r < 4; ++r) PART[(wave * 32 + i * 16 + fq * 4 + r) * 128 + c * 16 + fr] = acc[i][c][r];
    }
    __syncthreads();
    { const int col = tid & 127; float cc = 0.f;
#pragma unroll
      for (int kp = 0; kp < 16; ++kp) cc += c1p[kp * 128 + col];
#pragma unroll
      for (int e = 0; e < 8; ++e) { const int row = (tid >> 7) * 8 + e; float v = cc;
#pragma unroll
          for (int w = 0; w < 8; ++w) v += PART[(w * 32 + row) * 128 + col];
          const float sv = v * fast_rcp(1.0f + fast_exp2(-v * LOG2E));
          H[row * 136 + col] = (bf16_t)(cvtpk(sv, 0.f) & 0xffffu); } }
    __syncthreads();
    const int rtile = wave & 1, ct0 = (wave >> 1) * 2;
    f32x4 o0 = {0.f, 0.f, 0.f, 0.f}, o1 = {0.f, 0.f, 0.f, 0.f};
#pragma unroll
    for (int ks = 0; ks < 4; ++ks) {
        const bf16x8 a = *(const LAS bf16x8*)(H + (rtile * 16 + fr) * 136 + ks * 32 + fq * 8);
        const bf16x8 b0 = ld8(w2t + (size_t)(ct0 * 16 + fr) * 128 + ks * 32 + fq * 8), b1 = ld8(w2t + (size_t)((ct0 + 1) * 16 + fr) * 128 + ks * 32 + fq * 8);
        o0 = __builtin_amdgcn_mfma_f32_16x16x32_bf16(a, b0, o0, 0, 0, 0);
        o1 = __builtin_amdgcn_mfma_f32_16x16x32_bf16(a, b1, o1, 0, 0, 0);
    }
#pragma unroll
    for (int c = 0; c < 2; ++c) { const int col = (ct0 + c) * 16 + fr;
#pragma unroll
        for (int r = 0; r < 4; ++r) { const int nr = rt * 32 + rtile * 16 + fq * 4 + r; const float v = nr < NCMP ? (c ? o1[r] : o0[r]) : 0.f;
            outp[(size_t)nr * 128 + col] = (bf16_t)(cvtpk(v, 0.f) & 0xffffu); } }
    __syncthreads();
}
__device__ __forceinline__ void gate_unit(const Params& P, int l, int gu, LAS unsigned char* lds) {
    const int tid = tid_now(), lane = tid & 63, wave = __builtin_amdgcn_readfirstlane(tid >> 6);
    const bf16_t* xb = (const bf16_t*)(P.ws + WS_XB); const bf16_t* wg = (const bf16_t*)(P.ws + WS_WG) + (size_t)l * 128 * 4096;
    const float* ss = l == 0 ? (const float*)(P.ws + WS_SS) : (const float*)(P.ws + WS_SSP); const int np = l == 0 ? 1 : SS_NP;
    float* Gt = (float*)(P.ws + WS_G);
    const int fr = lane & 15, fq = lane >> 4, kq = wave & 3, rh = wave >> 2;
    LAS float* PART = (LAS float*)lds;
    {
        const bf16_t* ap = xb + (size_t)(gu * 64 + rh * 32 + fr) * DM + kq * 1024 + fq * 8;
        const bf16_t* bp = wg + (size_t)fr * DM + kq * 1024 + fq * 8;
        f32x4 acc[2][6];
#pragma unroll
        for (int i = 0; i < 2; ++i)
#pragma unroll
            for (int c = 0; c < 6; ++c) acc[i][c] = (f32x4){0.f, 0.f, 0.f, 0.f};
#pragma unroll 4
        for (int ks = 0; ks < 32; ++ks) {
            const bf16x8 a0 = ld8(ap + ks * 32), a1 = ld8(ap + (size_t)16 * DM + ks * 32);
            bf16x8 bb[6];
#pragma unroll
            for (int c = 0; c < 6; ++c) bb[c] = ld8(bp + (size_t)c * 16 * DM + ks * 32);
#pragma unroll
            for (int c = 0; c < 6; ++c) { acc[0][c] = __builtin_amdgcn_mfma_f32_16x16x32_bf16(a0, bb[c], acc[0][c], 0, 0, 0); acc[1][c] = __builtin_amdgcn_mfma_f32_16x16x32_bf16(a1, bb[c], acc[1][c], 0, 0, 0); }
        }
#pragma unroll
        for (int i = 0; i < 2; ++i)
#pragma unroll
            for (int c = 0; c < 6; ++c)
#pragma unroll
                for (int r = 0; r < 4; ++r) PART[(kq * 64 + rh * 32 + i * 16 + fq * 4 + r) * 96 + c * 16 + fr] = acc[i][c][r];
    }
    LAS float* RSG = (LAS float*)(lds + 98304);
    if (tid < 64) RSG[tid] = 1.0f / sqrtf(row_sumsq(ss, np, gu * 64 + tid) * (1.0f / DM) + RMS_EPS);
    __syncthreads();
    for (int e = tid; e < 64 * 96; e += 512) { const int row = e / 96, col = e - row * 96;
        const float v = (PART[row * 96 + col] + PART[(64 + row) * 96 + col]) + (PART[(128 + row) * 96 + col] + PART[(192 + row) * 96 + col]);
        const float lg = v * RSG[row];
        Gt[(size_t)(gu * 64 + row) * NGATE + col] = fast_rcp(1.0f + fast_exp2(-lg * LOG2E)); }
    __syncthreads();
}

namespace att {
constexpr int SHM_K = 16384, SHM_V = 16384, NSLOT = 3;
constexpr int OFF_V = 0, OFF_K = NSLOT * SHM_V;
constexpr int OFF_IMP = NSLOT * (SHM_V + SHM_K);
constexpr int OFF_FIN = OFF_IMP + 8 * 32 * 33 * 4;
constexpr int OFF_SELM = OFF_FIN + 32 * 33 * 4;
constexpr int OFF_BT = OFF_SELM + 128;
constexpr int OFF_WS = OFF_BT + 8 * 132 * 4;
constexpr int OFF_DONE = OFF_WS + 8 * 64 * 4;
constexpr int ATT_LDS_END = OFF_DONE + 64;
static_assert(ATT_LDS_END <= MISC_OFF, "attention LDS map");

#define KSWZ(row, colB) ((row) * 256 + ((colB) ^ (((row) & 7) << 4)))
__device__ __forceinline__ int v_st(int k, int c) { const int kk = (k & ~0xC) | ((k & 4) << 1) | ((k & 8) >> 1); return ((kk >> 3) * 4 + (c >> 5)) * 512 + ((kk & 7) * 32 + (c & 31)) * 2; }
__device__ __forceinline__ int v_rd_base(int lane) { return ((lane & 3) << 3) | (((lane >> 2) & 3) << 6) | (((lane >> 4) & 1) << 5) | (((lane >> 5) & 1) << 8); }
constexpr int v_rd_off(int d0, int ks, int half) { return d0 * 512 + ks * 4096 + half * 2048; }
__device__ __forceinline__ int crow(int r, int hi) { return (r & 3) + 8 * (r >> 2) + 4 * hi; }

struct Geo { int tid, wid, lane, r32, hi, vb0; };
__device__ __forceinline__ Geo make_geo(LAS unsigned char* lds) {
    Geo g; g.tid = tid_now(); g.wid = __builtin_amdgcn_readfirstlane(g.tid >> 6); g.lane = g.tid & 63; g.r32 = g.lane & 31; g.hi = g.lane >> 5;
    g.vb0 = (int)(uintptr_t)(lds + OFF_V) + v_rd_base(g.lane);
    return g;
}
struct DmaOff { unsigned k[2], v[2]; };
__device__ __forceinline__ DmaOff make_dma(const Geo& g, int ld) {
    DmaOff d;
#pragma unroll
    for (int i = 0; i < 2; ++i) { const int ch = g.wid + 8 * i;
        const int krow = 4 * ch + (g.lane >> 4), kc = (g.lane & 15) ^ (krow & 7);
        d.k[i] = (unsigned)(krow * ld * 2 + kc * 16);
        const int sub = 2 * ch + (g.lane >> 5), kk = 8 * (sub >> 2) + ((g.lane & 31) >> 2), key = (kk & ~0xC) | ((kk & 4) << 1) | ((kk & 8) >> 1);
        d.v[i] = (unsigned)(key * ld * 2 + ((sub & 3) * 32 + (g.lane & 3) * 8) * 2); }
    return d;
}
__device__ __forceinline__ void dma_tile(LAS unsigned char* lds, int slot, const bf16_t* Kp, const bf16_t* Vp, size_t ld, int key0, DmaOff d, const Geo& g) {
    asm volatile("" : "+v"(d.k[0]), "+v"(d.k[1]), "+v"(d.v[0]), "+v"(d.v[1]));
    const char* kb = (const char*)Kp + (size_t)key0 * ld * 2; const char* vb = (const char*)Vp + (size_t)key0 * ld * 2;
#pragma unroll
    for (int i = 0; i < 2; ++i) {
        __builtin_amdgcn_global_load_lds((const unsigned*)(kb + d.k[i]), (LAS unsigned*)(lds + OFF_K + slot * SHM_K + (g.wid + 8 * i) * 1024), 16, 0, 0);
        __builtin_amdgcn_global_load_lds((const unsigned*)(vb + d.v[i]), (LAS unsigned*)(lds + OFF_V + slot * SHM_V + (g.wid + 8 * i) * 1024), 16, 0, 0); }
}
#define WAIT_VM(n) asm volatile("s_waitcnt vmcnt(" #n ")" ::: "memory")
#define RAW_BAR() do { asm volatile("s_waitcnt lgkmcnt(0)" ::: "memory"); __builtin_amdgcn_s_barrier(); asm volatile("" ::: "memory"); } while (0)
__device__ __forceinline__ void qkt(f32x16& p0, f32x16& p1, LAS unsigned char* lds, int buf, const Geo& g, const bf16x8* qr) {
    p0 = f32x16{}; p1 = f32x16{};
    LAS unsigned char* kb[4];
#pragma unroll
    for (int dd = 0; dd < 4; ++dd) kb[dd] = lds + OFF_K + buf * SHM_K + KSWZ(g.r32, (dd * 16 + g.hi * 8) * 2);
#pragma unroll
    for (int d0 = 0; d0 < 8; ++d0) { LAS unsigned char* a = kb[d0 & 3] + (d0 >> 2) * 128;
        const bf16x8 b0 = *(const LAS bf16x8*)a, b1 = *(const LAS bf16x8*)(a + 32 * 256);
        p0 = __builtin_amdgcn_mfma_f32_32x32x16_bf16(b0, qr[d0], p0, 0, 0, 0);
        p1 = __builtin_amdgcn_mfma_f32_32x32x16_bf16(b1, qr[d0], p1, 0, 0, 0); }
}
__device__ __forceinline__ void pv_tile(f32x16* o, int vb, bf16x8 pa0, bf16x8 pa1, bf16x8 pa2, bf16x8 pa3) {
#define TRRD(dst, off) asm volatile("ds_read_b64_tr_b16 %0, %1 offset:%2" : "=&v"(dst) : "v"(vb), "i"(off) : "memory")
#define PV_D0(d0) do { s16x4 l0, l1, l2, l3, h0, h1, h2, h3; constexpr int b_ = v_rd_off(d0, 0, 0); \
        TRRD(l0, b_); TRRD(h0, b_ + 2048); TRRD(l1, b_ + 4096); TRRD(h1, b_ + 6144); TRRD(l2, b_ + 8192); TRRD(h2, b_ + 10240); TRRD(l3, b_ + 12288); TRRD(h3, b_ + 14336); \
        asm volatile("s_waitcnt lgkmcnt(0)" ::: "memory"); SBAR(); \
        o[d0] = __builtin_amdgcn_mfma_f32_32x32x16_bf16(pa0, (bf16x8){l0[0], l0[1], l0[2], l0[3], h0[0], h0[1], h0[2], h0[3]}, o[d0], 0, 0, 0); \
        o[d0] = __builtin_amdgcn_mfma_f32_32x32x16_bf16(pa1, (bf16x8){l1[0], l1[1], l1[2], l1[3], h1[0], h1[1], h1[2], h1[3]}, o[d0], 0, 0, 0); \
        o[d0] = __builtin_amdgcn_mfma_f32_32x32x16_bf16(pa2, (bf16x8){l2[0], l2[1], l2[2], l2[3], h2[0], h2[1], h2[2], h2[3]}, o[d0], 0, 0, 0); \
        o[d0] = __builtin_amdgcn_mfma_f32_32x32x16_bf16(pa3, (bf16x8){l3[0], l3[1], l3[2], l3[3], h3[0], h3[1], h3[2], h3[3]}, o[d0], 0, 0, 0); } while (0)
    PV_D0(0); PV_D0(1); PV_D0(2); PV_D0(3);
#undef PV_D0
#undef TRRD
}
__device__ __forceinline__ void pack_p(const f32x16& p0, const f32x16& p1, bf16x8& pa0, bf16x8& pa1, bf16x8& pa2, bf16x8& pa3) {
#define PK4(P, B_, OUT) do { unsigned a0 = cvtpk(P[B_+0], P[B_+1]), a1 = cvtpk(P[B_+2], P[B_+3]); \
        unsigned b0 = cvtpk(P[B_+4], P[B_+5]), b1 = cvtpk(P[B_+6], P[B_+7]); \
        auto r0 = __builtin_amdgcn_permlane32_swap(a0, b0, false, false); auto r1 = __builtin_amdgcn_permlane32_swap(a1, b1, false, false); \
        u32x4 w = {r0[0], r1[0], r0[1], r1[1]}; OUT = *reinterpret_cast<bf16x8*>(&w); } while (0)
    PK4(p0, 0, pa0); PK4(p0, 8, pa1); PK4(p1, 0, pa2); PK4(p1, 8, pa3);
#undef PK4
}
__device__ __forceinline__ void pair_vals(float x, float& lo, float& hi) {
    auto rr = __builtin_amdgcn_permlane32_swap(__float_as_uint(x), __float_as_uint(x), false, false);
    lo = __uint_as_float(rr[0]); hi = __uint_as_float(rr[1]);
}
__device__ __forceinline__ float pair_max(float x) { float a, b; pair_vals(x, a, b); return fmaxf(a, b); }
__device__ __forceinline__ float pair_sum(float x) { float a, b; pair_vals(x, a, b); return a + b; }

constexpr float SM_THR = 8.0f;
__device__ __forceinline__ void rescale_o(f32x16* o, float alpha, LAS float* al_l, const Geo& g) {
    if (g.hi == 0) al_l[g.r32] = alpha;
    LDS_WAIT();
#pragma unroll
    for (int r = 0; r < 16; ++r) { const float a = al_l[crow(r, g.hi)];
#pragma unroll
        for (int d = 0; d < 4; ++d) o[d][r] *= a; }
}
__device__ __forceinline__ void softmax_step(f32x16& p0, f32x16& p1, float mulc, float badd, bool ok, float& m_reg, float& l_reg, f32x16* o, LAS float* al_l, const Geo& g) {
    const float NEG = -__builtin_inff();
    float xmax = fmaxf(p0[0], p1[0]);
#pragma unroll
    for (int r = 1; r < 16; ++r) xmax = fmaxf(xmax, fmaxf(p0[r], p1[r]));
    xmax = pair_max(xmax);
    const float smax = ok ? fmaf(xmax, mulc, badd) : NEG;
    float mn = m_reg, alpha = 1.0f;
    if (!__all(smax - m_reg <= SM_THR)) { mn = fmaxf(m_reg, smax); alpha = fast_exp2(m_reg - mn); m_reg = mn; rescale_o(o, alpha, al_l, g); }
    const float addc = ok ? (badd - mn) : NEG;
    float ps = 0.f;
#pragma unroll
    for (int r = 0; r < 16; ++r) { p0[r] = fast_exp2(fmaf(p0[r], mulc, addc)); ps += p0[r]; }
#pragma unroll
    for (int r = 0; r < 16; ++r) { p1[r] = fast_exp2(fmaf(p1[r], mulc, addc)); ps += p1[r]; }
    ps = pair_sum(ps);
    l_reg = l_reg * alpha + ps;
}

struct NsaT { const bf16_t* Q; const bf16_t* KV; const bf16_t* Z; const float* Gt; const bf16_t* KC; const bf16_t* VC; bf16_t* MIX; const float* rel_bias; };

constexpr int EMIT_ROWB = 144, EMIT_TILE = 32 * EMIT_ROWB;
static_assert(8 * EMIT_TILE <= OFF_SELM - OFF_IMP, "emit tiles fit the IMP + FIN region");
__device__ __forceinline__ void silu2_mul(unsigned ov, unsigned zv, float& lo, float& hi) {
    const float z0 = bf_lo(zv), z1 = bf_hi(zv);
    lo = bf_lo(ov) * z0 * fast_rcp(1.0f + fast_exp2(-z0 * LOG2E)); hi = bf_hi(ov) * z1 * fast_rcp(1.0f + fast_exp2(-z1 * LOG2E));
}
__device__ __forceinline__ float lane_xor1(float x) { return __int_as_float(__builtin_amdgcn_update_dpp(0, __float_as_int(x), 0xB1, 0xF, 0xF, true)); }
template <bool RMW, bool SCALE>
__device__ __forceinline__ void emit_tile(LAS unsigned char* lds, const f32x16* o, float f, const bf16_t* zb  , size_t zld,
                                          bf16_t* mb  , LAS float* li_l, const Geo& g) {
    const int row = g.lane >> 1, half = g.lane & 1;
    unsigned zoff = (unsigned)(row * (int)zld + half * 32), moff = (unsigned)(row * DM + half * 32);
    asm volatile("" : "+v"(zoff), "+v"(moff));
    u32x4 zv[2][4]; u32x4 old[2][4];
#pragma unroll
    for (int c = 0; c < 2; ++c)
#pragma unroll
        for (int q = 0; q < 4; ++q) zv[c][q] = *(const u32x4*)(zb + zoff + 64 * c + q * 8);
    if (RMW) {
#pragma unroll
        for (int c = 0; c < 2; ++c)
#pragma unroll
            for (int q = 0; q < 4; ++q) { const unsigned long long* ap = (const unsigned long long*)(mb + moff + 64 * c + q * 8);
                const unsigned long long a0 = __hip_atomic_load(ap, __ATOMIC_RELAXED, __HIP_MEMORY_SCOPE_AGENT), a1 = __hip_atomic_load(ap + 1, __ATOMIC_RELAXED, __HIP_MEMORY_SCOPE_AGENT);
                old[c][q] = (u32x4){(unsigned)a0, (unsigned)(a0 >> 32), (unsigned)a1, (unsigned)(a1 >> 32)}; }
    }
    float fr[16];
    if (SCALE) { if (g.hi == 0) li_l[g.r32] = f;
        LDS_WAIT();
#pragma unroll
        for (int r = 0; r < 16; ++r) fr[r] = li_l[(r & 3) + 8 * (r >> 2) + 4 * g.hi]; }
    LAS unsigned char* T = lds + OFF_IMP + g.wid * EMIT_TILE;
    const LAS unsigned char* trow = T + row * EMIT_ROWB + half * 64;
#pragma unroll
    for (int c = 0; c < 2; ++c) {
#pragma unroll
        for (int r = 0; r < 16; ++r) { const int rc = (r & 3) + 8 * (r >> 2);
#pragma unroll
            for (int dd = 0; dd < 2; ++dd) { const float v = SCALE ? o[2 * c + dd][r] * fr[r] : o[2 * c + dd][r]; const float vn = lane_xor1(v);
                if ((g.r32 & 1) == 0) *(LAS unsigned*)(T + (rc + 4 * g.hi) * EMIT_ROWB + (dd * 32 + g.r32) * 2) = cvtpk(v, vn); } }
        LDS_WAIT();
#pragma unroll
        for (int q = 0; q < 4; ++q) { const u32x4 ov = *(const LAS u32x4*)(trow + q * 16); u32x4 w;
#pragma unroll
            for (int e = 0; e < 4; ++e) { float lo, hi; silu2_mul(ov[e], zv[c][q][e], lo, hi);
                if (RMW) { lo += bf_lo(old[c][q][e]); hi += bf_hi(old[c][q][e]); }
                w[e] = cvtpk(lo, hi); }
            *(u32x4*)(mb + moff + 64 * c + q * 8) = w; }
        asm volatile("" ::: "memory");
    }
}

template <int MODE>
__device__ __forceinline__ void tile_softmax(f32x16& p0, f32x16& p1, int kb, int t0, bool selbit, const LAS float* btw, float& m_reg, float& l_reg, f32x16* o, LAS float* al_l, const Geo& g) {
    constexpr float C2 = SM_SCALE * LOG2E; const float NEG = -__builtin_inff();
    const bool near = (kb + 63 + 128 > t0);
    const bool wedge = (MODE == 2) && (t0 + 31 - kb >= 512);
    bool ok = (MODE == 1) ? selbit : true; float mulc = C2, badd = btw[128];
    if (near || wedge) {
        const int dq = t0 + g.r32 - kb - 4 * g.hi; const unsigned W = (MODE == 2) ? 512u : 0x7fffffffu;
#pragma unroll
        for (int r = 0; r < 16; ++r) { const int c = (r & 3) + 8 * (r >> 2);
            const unsigned d0 = (unsigned)(dq - c), d1 = (unsigned)(dq - c - 32);
            float b0 = btw[d0 < 128u ? d0 : 128u], b1 = btw[d1 < 128u ? d1 : 128u];
            asm volatile("" : "+v"(b0), "+v"(b1));
            p0[r] = (ok && d0 < W) ? fmaf(p0[r], C2, b0) : NEG; p1[r] = (ok && d1 < W) ? fmaf(p1[r], C2, b1) : NEG;
            if ((r & 3) == 3) asm volatile("" ::: "memory"); }
        mulc = 1.0f; badd = 0.f; ok = true;
    }
    softmax_step(p0, p1, mulc, badd, ok, m_reg, l_reg, o, al_l, g);
}

struct TileIter { unsigned rem; int nxt, j_hi, j, j1, j2; };
template <int MODE> __device__ __forceinline__ void ti_next(TileIter& it, int& dst) {
    if (MODE == 1) { dst = it.rem ? __builtin_ctz(it.rem) : -1; it.rem &= it.rem - 1u; } else { dst = (it.nxt <= it.j_hi) ? it.nxt : -1; ++it.nxt; } }
template <int MODE> __device__ __forceinline__ TileIter ti_init(unsigned umask, int j_lo, int j_hi) {
    TileIter it; it.rem = umask; it.nxt = j_lo; it.j_hi = j_hi; ti_next<MODE>(it, it.j); ti_next<MODE>(it, it.j1); ti_next<MODE>(it, it.j2); return it; }
__device__ __forceinline__ void branch_issue(LAS unsigned char* lds, const TileIter& it, const bf16_t* Kp, const bf16_t* Vp, size_t ld, const DmaOff& dof, const Geo& g) {
    dma_tile(lds, 0, Kp, Vp, ld, 64 * it.j, dof, g);
    if (it.j1 >= 0) dma_tile(lds, 1, Kp, Vp, ld, 64 * it.j1, dof, g);
}
template <int MODE>
__device__ __forceinline__ void branch_run(f32x16* o, float& l_out, LAS unsigned char* lds, TileIter it, const bf16_t* Kp, const bf16_t* Vp, size_t ld, const DmaOff& dof, const bf16x8* qr,
                                           unsigned selword, int t0, const LAS float* btw, LAS float* al_l, const Geo& g) {
    float m_reg = -1e30f, l_reg = 0.f;
#pragma unroll
    for (int d = 0; d < 4; ++d) o[d] = f32x16{};
    int slot = 0; bool first = true;
    for (;;) {
        if (first || it.j1 < 0) WAIT_VM(0); else WAIT_VM(4);
        first = false;
        RAW_BAR();
        if (it.j2 >= 0) dma_tile(lds, slot >= 1 ? slot - 1 : 2, Kp, Vp, ld, 64 * it.j2, dof, g);
        f32x16 p0, p1;
        qkt(p0, p1, lds, slot, g, qr);
        tile_softmax<MODE>(p0, p1, 64 * it.j, t0, ((selword >> it.j) & 1u) != 0u, btw, m_reg, l_reg, o, al_l, g);
        bf16x8 pa0, pa1, pa2, pa3; pack_p(p0, p1, pa0, pa1, pa2, pa3);
        pv_tile(o, g.vb0 + slot * SHM_V, pa0, pa1, pa2, pa3);
        if (it.j1 < 0) break;
        it.j = it.j1; it.j1 = it.j2; ti_next<MODE>(it, it.j2); slot = slot == 2 ? 0 : slot + 1;
    }
    RAW_BAR();
    l_out = l_reg;
}

__device__ __forceinline__ int t5_bucket(int d) {
    if (d < 16) return d;
    const float lr = logf((float)d / 16.0f);
    int large = 16 + (int)(lr / 2.0794415416798357f * 16.0f);
    return large < 31 ? large : 31;
}


struct NsaUnit { int b, grp, t0; };
__device__ __forceinline__ NsaUnit nsa_decode(int u) {
    const int p = u >> 1, s2 = u & 1, k = p >> 8, w = p & 255, bg = (w & 7) + 8 * k, i = ((w >> 3) + 8 * k) & 31;
    NsaUnit r; r.b = bg >> 2; r.grp = bg & 3; r.t0 = s2 ? 32 * i : 32 * (63 - i); return r; }
__device__ __forceinline__ void nsa_issue_cmp(LAS unsigned char* lds, const NsaT& A, const NsaUnit& U, const Geo& g) {
    const bf16_t* Kc = A.KC + (size_t)(U.b * NGRP + U.grp) * 128 * 128; const bf16_t* Vc = A.VC + (size_t)(U.b * NGRP + U.grp) * 128 * 128;
    const DmaOff dc = make_dma(g, 128);
    dma_tile(lds, 0, Kc, Vc, 128, 0, dc, g); dma_tile(lds, 1, Kc, Vc, 128, 64, dc, g);
}
__device__ __forceinline__ void nsa_unit(LAS unsigned char* lds, const NsaT& A, const NsaUnit U, bool build_bt) {
    const Geo g = make_geo(lds);
    __syncthreads();
    nsa_issue_cmp(lds, A, U, g);
    const int b = U.b, grp = U.grp, t0 = U.t0, h = grp * 8 + g.wid;
    LAS float* IMP = (LAS float*)(lds + OFF_IMP); LAS float* FIN = (LAS float*)(lds + OFF_FIN); LAS unsigned* SELM = (LAS unsigned*)(lds + OFF_SELM);
    LAS float* BT = (LAS float*)(lds + OFF_BT); LAS float* wsl = (LAS float*)(lds + OFF_WS) + g.wid * 64;
    const LAS float* btw = BT + g.wid * 132;
    float gates[3];
    { const float* gp = A.Gt + (size_t)(b * SEQ + t0) * NGATE + h + (unsigned)(g.r32 * NGATE);
#pragma unroll
      for (int br = 0; br < 3; ++br) gates[br] = gp[br * 32]; }
    bf16x8 qr[8];
    { const bf16_t* qp = A.Q + (size_t)(b * SEQ + t0) * DM + h * 128 + (unsigned)(g.r32 * DM + g.hi * 8);
#pragma unroll
      for (int d0 = 0; d0 < 8; ++d0) qr[d0] = *(const bf16x8*)(qp + d0 * 16); }
    if (build_bt) for (int e = g.tid; e < 8 * 129; e += 512) { const int r = e / 129, d = e - r * 129; BT[r * 132 + d] = A.rel_bias[t5_bucket(d) * NH + grp * 8 + r] * LOG2E; }
    const bf16_t* Ks = A.KV + (size_t)(b * SEQ) * KVW + 1024 + grp * 128; const bf16_t* Vs = Ks + 512;
    const bf16_t* Kw = Ks + 1024; const bf16_t* Vw = Kw + 512;
    const DmaOff dof = make_dma(g, KVW);
    f32x16 o[4]; float l_reg;
    unsigned selword, um;
    WAIT_VM(0);
    __syncthreads();
    {
        f32x16 pA0, pA1, pB0, pB1;
        qkt(pA0, pA1, lds, 0, g, qr); qkt(pB0, pB1, lds, 1, g, qr);
        constexpr float C2 = SM_SCALE * LOG2E; const float NEG = -__builtin_inff();
        const int dbase = t0 + g.r32 - 31 - 64 * g.hi;
        float pmax = NEG;
#pragma unroll
        for (int r = 0; r < 16; ++r) { const int c = (r & 3) + 8 * (r >> 2);
#define CSC(P, NL) do { const int dist = dbase - 16 * (NL); const unsigned ud = (unsigned)dist; const float bb = btw[ud < 128u ? ud : 128u]; \
            P[r] = dist >= 0 ? fmaf(P[r], C2, bb) : NEG; pmax = fmaxf(pmax, P[r]); } while (0)
            CSC(pA0, c); CSC(pA1, c + 32); CSC(pB0, c + 64); CSC(pB1, c + 96);
#undef CSC
        }
        pmax = pair_max(pmax);
        const float mref = (pmax == NEG) ? 0.f : pmax;
        float ps = 0.f;
#pragma unroll
        for (int r = 0; r < 16; ++r) { pA0[r] = fast_exp2(pA0[r] - mref); pA1[r] = fast_exp2(pA1[r] - mref); pB0[r] = fast_exp2(pB0[r] - mref); pB1[r] = fast_exp2(pB1[r] - mref);
            ps += (pA0[r] + pA1[r]) + (pB0[r] + pB1[r]); }
        ps = pair_sum(ps);
        l_reg = ps;
        const float inv = ps > 0.f ? 1.0f / ps : 0.f;
        float qs[16], e3[16];
#pragma unroll
        for (int i = 0; i < 4; ++i) {
            qs[0 + i] = ((pA0[4 * i] + pA0[4 * i + 1]) + (pA0[4 * i + 2] + pA0[4 * i + 3])) * inv; e3[0 + i] = pA0[4 * i + 3] * inv;
            qs[4 + i] = ((pA1[4 * i] + pA1[4 * i + 1]) + (pA1[4 * i + 2] + pA1[4 * i + 3])) * inv; e3[4 + i] = pA1[4 * i + 3] * inv;
            qs[8 + i] = ((pB0[4 * i] + pB0[4 * i + 1]) + (pB0[4 * i + 2] + pB0[4 * i + 3])) * inv; e3[8 + i] = pB0[4 * i + 3] * inv;
            qs[12 + i] = ((pB1[4 * i] + pB1[4 * i + 1]) + (pB1[4 * i + 2] + pB1[4 * i + 3])) * inv; e3[12 + i] = pB1[4 * i + 3] * inv;
        }
        { LAS float* ip = IMP + (g.wid * 32 + g.r32) * 33;
          float prev_hi1 = 0.f;
#pragma unroll
          for (int idx = 0; idx < 16; ++idx) { float lo, hi1; pair_vals(e3[idx], lo, hi1);
              const float add = g.hi ? lo : prev_hi1;
              ip[2 * idx + g.hi] = qs[idx] + add; prev_hi1 = hi1; } }
        bf16x8 a0, a1, a2, a3, c0, c1, c2, c3;
        pack_p(pA0, pA1, a0, a1, a2, a3); pack_p(pB0, pB1, c0, c1, c2, c3);
#pragma unroll
        for (int d = 0; d < 4; ++d) o[d] = f32x16{};
        pv_tile(o, g.vb0, a0, a1, a2, a3); pv_tile(o, g.vb0 + SHM_V, c0, c1, c2, c3);
    }
    LDS_WAIT();
    __syncthreads();
    dma_tile(lds, 0, Ks, Vs, KVW, 0, dof, g);
    {
        const int tl = g.tid >> 4, j0 = (g.tid & 15) * 2, tok = t0 + tl, cur = tok >> 6;
        float v2[2];
#pragma unroll
        for (int e = 0; e < 2; ++e) { const int j = j0 + e; float v = 0.f;
#pragma unroll
            for (int r = 0; r < 8; ++r) v += IMP[(r * 32 + tl) * 33 + j];
            const bool forced = (j == 0) || (j == cur) || (j == cur - 1), valid = (64 * j <= tok);
            v = forced ? 1.0e6f : (valid ? v : -1.0f); v2[e] = v; FIN[tl * 33 + j] = v; }
        LDS_WAIT();
        __syncthreads();
        unsigned bits = 0u;
#pragma unroll
        for (int e = 0; e < 2; ++e) { const int j = j0 + e; int cnt = 0;
#pragma unroll
            for (int i = 0; i < 32; ++i) { const float w = FIN[tl * 33 + i]; cnt += (w > v2[e] || (w == v2[e] && i < j)) ? 1 : 0; }
            if (cnt < 16) bits |= 1u << j; }
        bits |= (unsigned)__builtin_amdgcn_update_dpp(0, (int)bits, 0xB1, 0xF, 0xF, true);
        bits |= (unsigned)__builtin_amdgcn_update_dpp(0, (int)bits, 0x4E, 0xF, 0xF, true);
        bits |= (unsigned)__builtin_amdgcn_update_dpp(0, (int)bits, 0x141, 0xF, 0xF, true);
        bits |= (unsigned)__builtin_amdgcn_update_dpp(0, (int)bits, 0x140, 0xF, 0xF, true);
        if ((g.tid & 15) == 0) SELM[tl] = bits;
        LDS_WAIT();
        __syncthreads();
        selword = SELM[g.r32]; um = selword;
        um |= __shfl_xor(um, 1); um |= __shfl_xor(um, 2); um |= __shfl_xor(um, 4); um |= __shfl_xor(um, 8); um |= __shfl_xor(um, 16);
        const int jmax = (t0 + 31) >> 6;
        um = __builtin_amdgcn_readfirstlane(um) & (jmax >= 31 ? 0xffffffffu : ((2u << jmax) - 1u));
    }
    TileIter its = ti_init<1>(um, 0, 0);
    if (its.j1 >= 0) dma_tile(lds, 1, Ks, Vs, KVW, 64 * its.j1, dof, g);
    const bf16_t* zb = A.Z + (size_t)(b * SEQ + t0) * ZW + h * 128;
    bf16_t* mb = A.MIX + (size_t)(b * SEQ + t0) * DM + h * 128;
    emit_tile<false, true>(lds, o, (l_reg > 0.f ? 1.0f / l_reg : 0.f) * gates[0], zb, ZW, mb, wsl, g);
    branch_run<1>(o, l_reg, lds, its, Ks, Vs, KVW, dof, qr, selword, t0, btw, wsl + 32, g);
    const int lowk = t0 - 511;
    TileIter itw = ti_init<2>(0u, lowk > 0 ? lowk >> 6 : 0, (t0 + 31) >> 6);
    branch_issue(lds, itw, Kw, Vw, KVW, dof, g);
    emit_tile<true, true>(lds, o, (1.0f / l_reg) * gates[1], zb + 4096, ZW, mb, wsl, g);
    branch_run<2>(o, l_reg, lds, itw, Kw, Vw, KVW, dof, qr, 0u, t0, btw, wsl + 32, g);
    emit_tile<true, true>(lds, o, (1.0f / l_reg) * gates[2], zb + 8192, ZW, mb, wsl, g);
}
__device__ __forceinline__ void nsa_phase(LAS unsigned char* lds, const NsaT& A) {
    const int G = gridDim.x, first = 2 * (int)blockIdx.x;
    if (first >= 2048) return;
    int prev_grp = -1;
#pragma unroll 1
    for (int u = first; u < 2048; u = (u & 1) ? u + 2 * G - 1 : u + 1) {
        const NsaUnit U = nsa_decode(u);
        nsa_unit(lds, A, U, U.grp != prev_grp);
        prev_grp = U.grp;
    }
    VM_WAIT();
    __syncthreads();
}

constexpr bool SB_EARLY_EXIT = true;
constexpr float SB_PCUT = 1.0e-37f;
struct SbT { const bf16_t* QZ; const bf16_t* KVSH; bf16_t* MIX; };
struct SbUnit { int b, h, qb; };
__device__ __forceinline__ SbUnit sb_decode(int u) {
    const int p = u >> 1, s2 = u & 1, k = p >> 8, w = p & 255, bh = k * 64 + (w & 7) * 8 + (w >> 5), pi = ((w >> 3) + k) & 3;
    SbUnit r; r.b = bh >> 5; r.h = bh & 31; r.qb = s2 ? pi : 7 - pi; return r; }
__device__ __forceinline__ void sb_issue(LAS unsigned char* lds, const SbT& A, const SbUnit& U, const Geo& g) {
    const bf16_t* Kp = A.KVSH + (size_t)(U.b * SEQ) * 8192 + U.h * 128; const bf16_t* Vp = Kp + 4096;
    const DmaOff dof = make_dma(g, 8192); const int j = 4 * U.qb + 3;
    dma_tile(lds, 0, Kp, Vp, 8192, 64 * j, dof, g); dma_tile(lds, 1, Kp, Vp, 8192, 64 * (j - 1), dof, g);
}
__device__ __forceinline__ void sb_unit(LAS unsigned char* lds, const SbT& A, const SbUnit U, bool has_next, const SbUnit UN) {
    const Geo g = make_geo(lds);
    const int b = U.b, h = U.h, qb = U.qb;
    LAS unsigned* DONE = (LAS unsigned*)(lds + OFF_DONE);
    const int tw0 = qb * 256 + g.wid * 32, t = tw0 + g.r32;
    bf16x8 qr[8];
    { const bf16_t* qp = A.QZ + (size_t)(b * SEQ + tw0) * 8192 + h * 128 + (unsigned)(g.r32 * 8192 + g.hi * 8);
#pragma unroll
      for (int d0 = 0; d0 < 8; ++d0) qr[d0] = *(const bf16x8*)(qp + d0 * 16); }
    const bf16_t* Kp = A.KVSH + (size_t)(b * SEQ) * 8192 + h * 128; const bf16_t* Vp = Kp + 4096;
    f32x16 o[4];
#pragma unroll
    for (int d = 0; d < 4; ++d) o[d] = f32x16{};
    float PR = 1.0f; bool wdone = false;
    const DmaOff dof = make_dma(g, 8192);
    int j = 4 * qb + 3, bank = 0, slot = 0;
    for (int step = 0;; ++step) {
        if (step > 0 && j >= 1) WAIT_VM(4); else WAIT_VM(0);
        RAW_BAR();
        if (SB_EARLY_EXIT && step > 0) { unsigned all = 1u;
#pragma unroll
            for (int w = 0; w < 8; ++w) all &= DONE[bank * 8 + w];
            bank ^= 1;
            if (__builtin_amdgcn_readfirstlane(all)) break; }
        if (j >= 2) dma_tile(lds, slot >= 1 ? slot - 1 : 2, Kp, Vp, 8192, 64 * (j - 2), dof, g);
        const int kb = 64 * j;
        const bool active = (kb <= tw0 + 30) && !wdone;
        if (active) {
            f32x16 p0, p1;
            qkt(p0, p1, lds, slot, g, qr);
            const bool needmask = (kb + 63 >= tw0);
            const int dq = t - kb - 4 * g.hi;
            constexpr float ZS = SM_SCALE * LOG2E;
            float rr0[16], rr1[16];
#pragma unroll
            for (int r = 0; r < 16; ++r) { const int c = (r & 3) + 8 * (r >> 2);
                float e0 = fast_exp2(fminf(p0[r] * ZS, 64.0f)), e1 = fast_exp2(fminf(p1[r] * ZS, 64.0f));
                if (needmask) { e0 = (dq - c > 0) ? e0 : 0.f; e1 = (dq - c - 32 > 0) ? e1 : 0.f; }
                p0[r] = e0; p1[r] = e1; rr0[r] = fast_rcp(1.0f + e0); rr1[r] = fast_rcp(1.0f + e1); }
            float tot[8];
#pragma unroll
            for (int i = 0; i < 4; ++i) {
                rr0[4 * i + 2] *= rr0[4 * i + 3]; rr0[4 * i + 1] *= rr0[4 * i + 2]; rr0[4 * i] *= rr0[4 * i + 1]; tot[i] = rr0[4 * i];
                rr1[4 * i + 2] *= rr1[4 * i + 3]; rr1[4 * i + 1] *= rr1[4 * i + 2]; rr1[4 * i] *= rr1[4 * i + 1]; tot[4 + i] = rr1[4 * i];
            }
            float off[8]; float suf = PR;
#pragma unroll
            for (int idx = 7; idx >= 0; --idx) { float t0_, t1_; pair_vals(tot[idx], t0_, t1_);
                const float oh1 = suf; suf *= t1_; const float oh0 = suf; suf *= t0_; off[idx] = g.hi ? oh1 : oh0; }
            PR = suf;
#pragma unroll
            for (int r = 0; r < 16; ++r) { p0[r] *= rr0[r] * off[r >> 2]; p1[r] *= rr1[r] * off[4 + (r >> 2)]; }
            bf16x8 pa0, pa1, pa2, pa3; pack_p(p0, p1, pa0, pa1, pa2, pa3);
            pv_tile(o, g.vb0 + slot * SHM_V, pa0, pa1, pa2, pa3);
            if (SB_EARLY_EXIT) wdone = __all(PR < SB_PCUT);
        }
        if (SB_EARLY_EXIT && g.lane == 0) DONE[bank * 8 + g.wid] = wdone ? 1u : 0u;
        if (j == 0) break;
        --j; slot = slot == 2 ? 0 : slot + 1;
    }
    WAIT_VM(0);
    RAW_BAR();
    if (has_next) sb_issue(lds, A, UN, g);
    emit_tile<false, false>(lds, o, 1.0f, A.QZ + (size_t)(b * SEQ + tw0) * 8192 + 4096 + h * 128, 8192, A.MIX + (size_t)(b * SEQ + tw0) * DM + h * 128, (LAS float*)(lds + OFF_WS), g);
}
__device__ __forceinline__ void sb_phase(LAS unsigned char* lds, const SbT& A) {
    const int G = gridDim.x, first = 2 * (int)blockIdx.x;
    if (first >= 2048) return;
    { const Geo g = make_geo(lds); sb_issue(lds, A, sb_decode(first), g); }
#pragma unroll 1
    for (int u = first; u < 2048; u = (u & 1) ? u + 2 * G - 1 : u + 1) {
        const int un = (u & 1) ? u + 2 * G - 1 : u + 1; const bool has_next = un < 2048;
        sb_unit(lds, A, sb_decode(u), has_next, sb_decode(has_next ? un : u));
    }
    VM_WAIT();
    __syncthreads();
}
}

constexpr int NPHASES = 16;
__global__ void __launch_bounds__(512, 2) yoco_fwd(Params P) {
    extern __shared__ __attribute__((aligned(16))) unsigned char lds_raw[];
    LAS unsigned char* lds = (LAS unsigned char*)lds_raw;
    const int G = gridDim.x;
    volatile LAS unsigned* MISC = (volatile LAS unsigned*)(lds + MISC_OFF);
    { const int t0_ = tid_now(); if (t0_ < 64) MISC[t0_] = 0u; }
    __syncthreads();
    unsigned char* ws = P.ws;
    XcdBarrier bar = xcd_barrier_post((unsigned*)(ws + WS_CTL), MISC + 8);
    const int lo = P.ph_lo, hi = P.ph_hi;
#define IN(k) (lo <= (k) && (k) < hi)
#define SEAM(k) do { if (IN(k) && IN((k) + 1)) xcd_barrier(bar); } while (0)
    bf16_t* HN = (bf16_t*)(ws + WS_HN); bf16_t* XB = (bf16_t*)(ws + WS_XB); float* SS = (float*)(ws + WS_SS); float* SSP = (float*)(ws + WS_SSP);

    if (IN(0)) phase_prologue(P, lds);
    SEAM(0);

#pragma unroll
    for (int l = 0; l < 2; ++l) {
        const int pb = 1 + 4 * l;
        if (IN(pb)) {
            pg8::Gemm g{XB, (const bf16_t*)(ws + WS_WAIN + l * WAIN_BYTES), MTOK, NSA_N, DM}; pg8::StaticOrder S; S.init(MTOK, NSA_N, G, (int)blockIdx.x);
            const int fm = 8 * ((int)blockIdx.x & 7); LAS float* RS = (LAS float*)(lds + 131072);
            const float* ssrc = l == 0 ? SS : SSP; const int np = l == 0 ? 1 : SS_NP;
            { const int i4 = tid_now() * 4; f32x4 s4 = {0.f, 0.f, 0.f, 0.f};
#pragma unroll 8
              for (int p = 0; p < np; ++p) s4 += *(const f32x4*)(ssrc + (size_t)p * MTOK + fm * 256 + i4);
#pragma unroll
              for (int k = 0; k < 4; ++k) RS[i4 + k] = 1.0f / sqrtf(s4[k] * (1.0f / DM) + RMS_EPS); }
            __syncthreads();
            pg8::EpiSplit E{(bf16_t*)(ws + WS_Q), DM, 16, (bf16_t*)(ws + WS_KV), KVW, 28, (bf16_t*)(ws + WS_Z), ZW, ssrc, RS, fm, np};
            pg8::gemm_phase<pg8::EpiSplit, pg8::StaticOrder, true, true>(lds, g, S, E);
        }
        SEAM(pb);
        if (IN(pb + 1)) {
            for (int u = blockIdx.x; u < 256; u += G) { compress_unit(P, l, u, lds); gate_unit(P, l, u, lds); }
        }
        SEAM(pb + 1);
        if (IN(pb + 2)) {
            att::NsaT A{(const bf16_t*)(ws + WS_Q), (const bf16_t*)(ws + WS_KV), (const bf16_t*)(ws + WS_Z), (const float*)(ws + WS_G),
                        (const bf16_t*)(ws + WS_KC), (const bf16_t*)(ws + WS_VC), HN, P.in[1]};
            att::nsa_phase(lds, A);
        }
        SEAM(pb + 2);
        if (IN(pb + 3)) {
            pg8::Gemm g{HN, (const bf16_t*)(ws + WS_WAOUT + l * WOUT_BYTES), MTOK, DM, DM}; pg8::StaticOrder S; S.init(MTOK, DM, G, (int)blockIdx.x);
            pg8::EpiRes E{XB, P.out, DM, SSP, 0};
            pg8::gemm_phase<pg8::EpiRes, pg8::StaticOrder, true, true>(lds, g, S, E);
        }
        SEAM(pb + 3);
    }

#pragma unroll
    for (int l = 2; l < 4; ++l) {
        const int pb = 9 + 3 * (l - 2);
        if (IN(pb)) {
            const int N = (l == 2) ? 16384 : 8192;
            pg8::Gemm g{XB, (const bf16_t*)(ws + (l == 2 ? WS_WKVQ : WS_WB3)), MTOK, N, DM}; pg8::StaticOrder S; S.init(MTOK, N, G, (int)blockIdx.x);
            const int fm = 8 * ((int)blockIdx.x & 7); LAS float* RS = (LAS float*)(lds + 131072);
            const float* ssrc = SSP; const int np = SS_NP;
            { const int i4 = tid_now() * 4; f32x4 s4 = {0.f, 0.f, 0.f, 0.f};
#pragma unroll 8
              for (int p = 0; p < np; ++p) s4 += *(const f32x4*)(ssrc + (size_t)p * MTOK + fm * 256 + i4);
#pragma unroll
              for (int k = 0; k < 4; ++k) RS[i4 + k] = 1.0f / sqrtf(s4[k] * (1.0f / DM) + RMS_EPS); }
            __syncthreads();
            pg8::EpiSplit E{(bf16_t*)(ws + (l == 2 ? WS_KVSH : WS_QZ)), 8192, 32, (bf16_t*)(ws + WS_QZ), 8192, 1 << 20, nullptr, 0, ssrc, RS, fm, np};
            pg8::gemm_phase<pg8::EpiSplit, pg8::StaticOrder, true, true>(lds, g, S, E);
        }
        SEAM(pb);
        if (IN(pb + 1)) {
            att::SbT A{(const bf16_t*)(ws + WS_QZ), (const bf16_t*)(ws + WS_KVSH), HN};
            att::sb_phase(lds, A);
        }
        SEAM(pb + 1);
        if (IN(pb + 2)) {
            pg8::Gemm g{HN, (const bf16_t*)(ws + WS_WBOUT + (l - 2) * WOUT_BYTES), MTOK, DM, DM}; pg8::StaticOrder S; S.init(MTOK, DM, G, (int)blockIdx.x);
            pg8::EpiRes E{XB, P.out, DM, SSP, 0};
            pg8::gemm_phase<pg8::EpiRes, pg8::StaticOrder, true, true>(lds, g, S, E);
        }
        SEAM(pb + 2);
    }
    if (IN(15)) phase_final_norm(XB, P.out, P.in[26], SSP, lds);
#undef IN
#undef SEAM
}

extern "C" void kernel_launch(void* const* d_in, const int* in_sizes, int n_in, void* d_out, int out_size, void* d_ws, size_t ws_size, hipStream_t stream) {
    static int grid = 0;
    if (grid == 0) {
        if (n_in != 27 || out_size != MTOK * DM || ws_size < WS_END) { fprintf(stderr, "kernel_launch: unexpected shapes (n_in %d, out %d, ws %zu < %zu)\n", n_in, out_size, ws_size, (size_t)WS_END); grid = -1; return; }
        int dev = 0, cus = 0, per_cu = 0;
        if (hipGetDevice(&dev) != hipSuccess || hipDeviceGetAttribute(&cus, hipDeviceAttributeMultiprocessorCount, dev) != hipSuccess || cus <= 0) { grid = -1; return; }
        if (hipFuncSetAttribute((const void*)yoco_fwd, hipFuncAttributeMaxDynamicSharedMemorySize, LDS_BYTES) != hipSuccess) { fprintf(stderr, "kernel_launch: hipFuncSetAttribute failed\n"); grid = -1; return; }
        if (hipOccupancyMaxActiveBlocksPerMultiprocessor(&per_cu, (const void*)yoco_fwd, 512, LDS_BYTES) != hipSuccess || per_cu < 1) { fprintf(stderr, "kernel_launch: occupancy query says %d\n", per_cu); }
        (void)hipGetLastError();
        grid = cus;
    }
    if (grid < 0) return;
    (void)hipMemsetAsync((char*)d_ws + WS_CTL, 0, CTL_ZERO_BYTES, stream);
    Params p{};
    for (int i = 0; i < 27; ++i) p.in[i] = (const float*)d_in[i];
    p.out = (float*)d_out; p.ws = (unsigned char*)d_ws;
    p.ph_lo = 0; p.ph_hi = NPHASES;
    hipLaunchKernelGGL(yoco_fwd, dim3(grid), dim3(512), LDS_BYTES, stream, p);
}
```

```cpp
#include <hip/hip_runtime.h>
#include <cstdio>
#include <cstdint>

#define LAS __attribute__((address_space(3)))
#define GAS __attribute__((address_space(1)))
typedef unsigned short bf16_t;
typedef short bf16x8 __attribute__((ext_vector_type(8)));
typedef short s16x4 __attribute__((ext_vector_type(4)));
typedef float f32x4 __attribute__((ext_vector_type(4)));
typedef float f32x16 __attribute__((ext_vector_type(16)));
typedef unsigned u32x4 __attribute__((ext_vector_type(4)));
typedef unsigned u32x2 __attribute__((ext_vector_type(2)));

constexpr int BATCH = 8, SEQ = 2048, DM = 4096, NH = 32, HD = 128, NGRP = 4, GSZ = 8;
constexpr int MTOK = BATCH * SEQ;
constexpr int NSA_N = 19456;
constexpr int KVW = 3072, ZW = 12288, NGATE = 96;
constexpr int NCMP = 127;
constexpr float RMS_EPS = 1e-6f;
constexpr float SM_SCALE = 0.08838834764831845f;
constexpr float LOG2E = 1.4426950408889634f;
constexpr float LN2 = 0.6931471805599453f;

constexpr size_t MiB = 1u << 20;
constexpr size_t WS_CTL = 0, CTL_ZERO_BYTES = 32 * 1024;
constexpr int XCD_BAR_WORDS_MAX = 3456;
constexpr size_t WS_SS = 64 * 1024;
constexpr size_t WS_C1 = 1 * MiB;
constexpr size_t WS_KC = 2 * MiB;
constexpr size_t WS_VC = 3 * MiB;
constexpr size_t WS_W2T = 4 * MiB;
constexpr size_t WS_W1T = 8 * MiB;
constexpr size_t WS_SSP = 12 * MiB;
constexpr int SS_NP = 64;
constexpr size_t WS_WG = 16 * MiB;
constexpr size_t WS_WAIN = 20 * MiB;
constexpr size_t WAIN_BYTES = (size_t)NSA_N * DM * 2;
constexpr size_t WS_WAOUT = WS_WAIN + 2 * WAIN_BYTES;
constexpr size_t WOUT_BYTES = (size_t)DM * DM * 2;
constexpr size_t WS_WKVQ = WS_WAOUT + 2 * WOUT_BYTES;
constexpr size_t WS_WB3 = WS_WKVQ + (size_t)16384 * DM * 2;
constexpr size_t WS_WBOUT = WS_WB3 + (size_t)8192 * DM * 2;
constexpr size_t WS_HN = WS_WBOUT + 2 * WOUT_BYTES;
constexpr size_t WS_PROJ = WS_HN + (size_t)MTOK * DM * 2;
constexpr size_t WS_Q = WS_PROJ;
constexpr size_t WS_KV = WS_Q + (size_t)MTOK * DM * 2;
constexpr size_t WS_Z = WS_KV + (size_t)MTOK * KVW * 2;
constexpr size_t WS_G = WS_Z + (size_t)MTOK * ZW * 2;
constexpr size_t WS_KVSH = WS_PROJ;
constexpr size_t WS_QZ = WS_KVSH + (size_t)MTOK * 8192 * 2;
constexpr size_t WS_XB = WS_G + (size_t)MTOK * NGATE * 4;
constexpr size_t WS_END = WS_XB + (size_t)MTOK * DM * 2;
static_assert(WS_END <= (size_t)1515 * MiB, "d_ws map must fit the guaranteed workspace (sum of inputs = 1515 MiB)");
static_assert(WS_QZ + (size_t)MTOK * 8192 * 2 <= WS_XB, "SB overlay");
static_assert(XCD_BAR_WORDS_MAX * 4 <= CTL_ZERO_BYTES, "barrier words inside the memset region");

constexpr int LDS_BYTES = 147456;
constexpr int MISC_OFF = LDS_BYTES - 256;

__device__ __forceinline__ float row_sumsq(const float* ss, int np, int row) {
    float s = 0.f;
#pragma unroll 8
    for (int p = 0; p < np; ++p) s += ss[(size_t)p * MTOK + row];
    return s;
}
namespace pg8 {
#define PG8_LAS __attribute__((address_space(3)))
typedef unsigned short bf16_t;
typedef short bf16x8 __attribute__((ext_vector_type(8)));
typedef float f32x4 __attribute__((ext_vector_type(4)));
typedef unsigned u32x4 __attribute__((ext_vector_type(4)));
constexpr int BM = 256, BK = 64, HALF = 128, HTB = HALF * BK * 2  , STAGE_BYTES = 8 * HTB, NXCD = 8, WGM = 8;

__host__ __device__ __forceinline__ int lds_byte(int r, int c) { const int st = (r >> 4) * 2 + (c >> 5), rr = r & 15, cc = c & 31, ob = rr * 64 + cc * 2; return st * 1024 + (ob ^ (((ob >> 9) & 1) << 5)); }
__host__ __device__ __forceinline__ void stage_rc(int b, int& R, int& C) { const int st = b / 1024, sb = b % 1024, swz = sb ^ (((sb >> 9) & 1) << 5); R = (st >> 1) * 16 + swz / 64; C = (st & 1) * 32 + (swz % 64) / 2; }
__host__ __device__ __forceinline__ int perm32(int rho) { const int n = rho >> 4, i = rho & 15; return 8 * (i >> 2) + 4 * n + (i & 3); }

struct Unit { int pm, pn; };
struct Gemm { const bf16_t* A; const bf16_t* Bt; int M, N, K; };

struct StaticOrder {
    int nM, nN, nwg, G, c;
    __host__ __device__ void init(int M, int N, int G_, int c_) { nM = M / BM; nN = N / BM; nwg = nM * nN; G = G_; c = c_; }
    __host__ __device__ bool next(int i, Unit& u) const {
        const long L = (long)i * G + c; if (L >= nwg) return false;
        int wgid = (int)L; { const int q = nwg / NXCD, r = nwg % NXCD, xcd = wgid % NXCD, off = wgid / NXCD; wgid = (xcd < r ? xcd * (q + 1) : r * (q + 1) + (xcd - r) * q) + off; }
        const int nig = WGM * nN, gid = wgid / nig, fm = gid * WGM, gsz = (nM - fm) < WGM ? (nM - fm) : WGM;
        u.pm = fm + ((wgid % nig) % gsz); u.pn = (wgid % nig) / gsz; return true;
    }
    __device__ __forceinline__ void a_ready(const Unit&) const {}
    __device__ __forceinline__ void done(const Unit&) const {}
};


__device__ __forceinline__ unsigned cvt_pk_bf16(float lo, float hi) { unsigned r; asm volatile("v_cvt_pk_bf16_f32 %0, %1, %2" : "=v"(r) : "v"(lo), "v"(hi)); return r; }

struct EpiSplit {
    static constexpr bool PERM = true, AFTER_DRAIN = false;
    bf16_t* O0; int ld0; int t1; bf16_t* O1; int ld1; int t2; bf16_t* O2; int ld2; const float* ss; const PG8_LAS float* rs_lds; int fm; int np;
    __device__ __forceinline__ void operator()(const f32x4 (&acc)[2][2][4][2], const Unit& u, int wr, int wc, int fr, int fq) const {
        const int row0 = u.pm * BM + wr * 64 + fr;
        bf16_t* base; int ldc, ct;
        if (u.pn < t1) { base = O0; ldc = ld0; ct = u.pn; } else if (u.pn < t2) { base = O1; ldc = ld1; ct = u.pn - t1; } else { base = O2; ldc = ld2; ct = u.pn - t2; }
        const int col0 = ct * BM + wc * 32 + 8 * fq;
#pragma unroll
        for (int ai = 0; ai < 2; ++ai)
#pragma unroll
            for (int m = 0; m < 4; ++m) { bf16_t* rowp = base + (size_t)(row0 + ai * HALF + m * 16) * ldc + col0;
                const unsigned pl = (unsigned)(u.pm - fm);
                const float rs = pl < 8u ? rs_lds[pl * BM + wr * 64 + fr + ai * HALF + m * 16] : 1.0f / sqrtf(row_sumsq(ss, np, row0 + ai * HALF + m * 16) * (1.0f / 4096.0f) + 1e-6f);
#pragma unroll
                for (int bj = 0; bj < 2; ++bj) { const f32x4 v0 = acc[ai][bj][m][0] * rs, v1 = acc[ai][bj][m][1] * rs;
                    u32x4 w; w.x = cvt_pk_bf16(v0[0], v0[1]); w.y = cvt_pk_bf16(v0[2], v0[3]); w.z = cvt_pk_bf16(v1[0], v1[1]); w.w = cvt_pk_bf16(v1[2], v1[3]);
                    *(u32x4*)(rowp + bj * HALF) = w; } }
    }
};
struct EpiRes {
    static constexpr bool PERM = true, AFTER_DRAIN = false;
    bf16_t* xb; float* out; int ldc; float* ssp; int last;
    __device__ __forceinline__ void operator()(const f32x4 (&acc)[2][2][4][2], const Unit& u, int wr, int wc, int fr, int fq) const {
        const int row0 = u.pm * BM + wr * 64 + fr, col0 = u.pn * BM + wc * 32 + 8 * fq;
        float* sp = ssp + (size_t)(u.pn * 4 + wc) * MTOK;
        u32x4 r[2][4][2];
#pragma unroll
        for (int ai = 0; ai < 2; ++ai)
#pragma unroll
            for (int m = 0; m < 4; ++m) { const size_t off = (size_t)(row0 + ai * HALF + m * 16) * ldc + col0;
#pragma unroll
                for (int bj = 0; bj < 2; ++bj) r[ai][m][bj] = *(const u32x4*)(xb + off + bj * HALF); }
#pragma unroll
        for (int ai = 0; ai < 2; ++ai) {
#pragma unroll
            for (int m = 0; m < 4; ++m) { const size_t off = (size_t)(row0 + ai * HALF + m * 16) * ldc + col0;
                float sq = 0.f;
#pragma unroll
                for (int bj = 0; bj < 2; ++bj) { const u32x4 rv = r[ai][m][bj];
                    const f32x4 o0 = (f32x4){__uint_as_float(rv.x << 16), __uint_as_float(rv.x & 0xffff0000u), __uint_as_float(rv.y << 16), __uint_as_float(rv.y & 0xffff0000u)} + acc[ai][bj][m][0];
                    const f32x4 o1 = (f32x4){__uint_as_float(rv.z << 16), __uint_as_float(rv.z & 0xffff0000u), __uint_as_float(rv.w << 16), __uint_as_float(rv.w & 0xffff0000u)} + acc[ai][bj][m][1];
                    sq += ((o0[0] * o0[0] + o0[1] * o0[1]) + (o0[2] * o0[2] + o0[3] * o0[3])) + ((o1[0] * o1[0] + o1[1] * o1[1]) + (o1[2] * o1[2] + o1[3] * o1[3]));
                    u32x4 w; w.x = cvt_pk_bf16(o0[0], o0[1]); w.y = cvt_pk_bf16(o0[2], o0[3]); w.z = cvt_pk_bf16(o1[0], o1[1]); w.w = cvt_pk_bf16(o1[2], o1[3]); *(u32x4*)(xb + off + bj * HALF) = w; }
                sq += __shfl_xor(sq, 16); sq += __shfl_xor(sq, 32);
                if (fq == 0) sp[row0 + ai * HALF + m * 16] = sq; }
            asm volatile("" ::: "memory");
        }
    }
};
template <class Epi, class Sched, bool ALIGN_EPI = false, bool SP2 = false>
__device__ __forceinline__ void gemm_phase(PG8_LAS unsigned char* lds, const Gemm g, const Sched& S, const Epi& E) {
    int tid_ = (int)threadIdx.x; asm volatile("" : "+v"(tid_));
    const int tid = tid_, wid = __builtin_amdgcn_readfirstlane(tid >> 6), lane = tid & 63, wr = wid >> 2, wc = wid & 3, fr = lane & 15, fq = lane >> 4;
    const int K = g.K, nt = K / BK;
    unsigned voffA[2], voffB[2];
#pragma unroll
    for (int i = 0; i < 2; ++i) { int R, C; stage_rc(tid * 16 + i * 8192, R, C); const int Rb = Epi::PERM ? ((R & ~31) + perm32(R & 31)) : R;
        voffA[i] = (unsigned)(R * K + C) * 2u; voffB[i] = (unsigned)(Rb * K + C) * 2u; }
    asm volatile("" : "+v"(voffA[0]), "+v"(voffA[1]), "+v"(voffB[0]), "+v"(voffB[1]));
    const size_t kstep = (size_t)(BK * 2);
    const size_t hstep = (size_t)HALF * K * 2;
    const size_t tstep = 2 * hstep;
    const unsigned ldsw = (unsigned)wid * 1024u;
    const int aoff = lds_byte(wr * 64 + fr, fq * 8), boff = lds_byte(wc * 32 + fr, fq * 8);
#define PG8_SA(b, h) (((b) * 2 + (h)) * HTB)
#define PG8_SB(b, h) ((4 + (b) * 2 + (h)) * HTB)
#define PG8_STAGE(bufoff, gbase, voff) do { _Pragma("unroll") for (int _i = 0; _i < 2; ++_i) \
        __builtin_amdgcn_global_load_lds((const unsigned*)((const char*)(gbase) + (voff)[_i]), (PG8_LAS unsigned*)(lds + (bufoff) + ldsw + _i * 8192), 16, 0, 0); } while (0)
#define PG8_LDA(dst, b, h) do { _Pragma("unroll") for (int m = 0; m < 4; ++m) _Pragma("unroll") for (int k = 0; k < 2; ++k) dst[m][k] = *(const PG8_LAS bf16x8*)(lds + PG8_SA(b, h) + aoff + m * 2048 + k * 1024); } while (0)
#define PG8_LDB(dst, b, h) do { _Pragma("unroll") for (int n = 0; n < 2; ++n) _Pragma("unroll") for (int k = 0; k < 2; ++k) dst[n][k] = *(const PG8_LAS bf16x8*)(lds + PG8_SB(b, h) + boff + n * 2048 + k * 1024); } while (0)
#define PG8_MMA(ai, bj, At, Bt) do { __builtin_amdgcn_s_setprio(1); _Pragma("unroll") for (int m = 0; m < 4; ++m) _Pragma("unroll") for (int n = 0; n < 2; ++n) _Pragma("unroll") for (int k = 0; k < 2; ++k) \
        acc[ai][bj][m][n] = __builtin_amdgcn_mfma_f32_16x16x32_bf16(Bt[n][k], At[m][k], acc[ai][bj][m][n], 0, 0, 0); __builtin_amdgcn_s_setprio(0); } while (0)
#define PG8_WAIT_V(n) asm volatile("s_waitcnt vmcnt(" #n ")" ::: "memory")
#define PG8_WAIT_L(n) asm volatile("s_waitcnt lgkmcnt(" #n ")" ::: "memory")
#define PG8_BAR __builtin_amdgcn_s_barrier()
#define PG8_SCHED __builtin_amdgcn_sched_barrier(0)
    Unit cur, nxt; int ui = 0;
    if (!S.next(0, cur)) return;
    f32x4 acc[2][2][4][2];
#pragma unroll
    for (int a = 0; a < 2; ++a)
#pragma unroll
        for (int b = 0; b < 2; ++b)
#pragma unroll
            for (int m = 0; m < 4; ++m)
#pragma unroll
                for (int n = 0; n < 2; ++n) acc[a][b][m][n] = (f32x4){0.f, 0.f, 0.f, 0.f};
    bf16x8 At[4][2], B0[2][2], B1[2][2];
    const char* cA = (const char*)g.A + (size_t)cur.pm * tstep; const char* cB = (const char*)g.Bt + (size_t)cur.pn * tstep;
    S.a_ready(cur);
    if constexpr (SP2) {
        PG8_STAGE(PG8_SB(0, 0), cB, voffB); PG8_STAGE(PG8_SB(0, 1), cB + hstep, voffB); PG8_STAGE(PG8_SA(0, 0), cA, voffA); PG8_STAGE(PG8_SA(0, 1), cA + hstep, voffA);
        if (wr == 1) PG8_BAR;
        PG8_WAIT_V(2); PG8_BAR;
        PG8_STAGE(PG8_SB(1, 0), cB + kstep, voffB); PG8_STAGE(PG8_SA(1, 0), cA + kstep, voffA); PG8_STAGE(PG8_SB(1, 1), cB + hstep + kstep, voffB);
        PG8_WAIT_V(6); PG8_BAR;
    } else {
        PG8_STAGE(PG8_SB(0, 0), cB, voffB); PG8_STAGE(PG8_SA(0, 0), cA, voffA); PG8_STAGE(PG8_SB(0, 1), cB + hstep, voffB); PG8_STAGE(PG8_SA(0, 1), cA + hstep, voffA);
        if (wr == 1) PG8_BAR;
        PG8_WAIT_V(4); PG8_BAR;
        PG8_STAGE(PG8_SB(1, 0), cB + kstep, voffB); PG8_STAGE(PG8_SA(1, 0), cA + kstep, voffA); PG8_STAGE(PG8_SB(1, 1), cB + hstep + kstep, voffB);
        PG8_WAIT_V(6); PG8_BAR;
    }
    for (;;) {
        const bool has_next = S.next(ui + 1, nxt);
        const char* nA = has_next ? (const char*)g.A + (size_t)nxt.pm * tstep : cA; const char* nB = has_next ? (const char*)g.Bt + (size_t)nxt.pn * tstep : cB;
        for (int t = 0; t < nt; t += 2) {
            const bool last = (t == nt - 2);
            const char* a1 = cA + (size_t)(t + 1) * kstep;
            const char* a2 = last ? nA : cA + (size_t)(t + 2) * kstep; const char* b2 = last ? nB : cB + (size_t)(t + 2) * kstep;
            const char* a3 = a2 + kstep; const char* b3 = b2 + kstep;
            if (last && has_next) S.a_ready(nxt);
            if constexpr (SP2) {
            PG8_LDB(B0, 0, 0); PG8_LDB(B1, 0, 1); PG8_SCHED; PG8_LDA(At, 0, 0); PG8_STAGE(PG8_SA(1, 1), a1 + hstep, voffA);
            PG8_WAIT_V(8); PG8_WAIT_L(0); PG8_BAR; PG8_MMA(0, 0, At, B0); PG8_MMA(0, 1, At, B1); PG8_BAR; PG8_SCHED;
            PG8_LDA(At, 0, 1); PG8_STAGE(PG8_SB(0, 0), b2, voffB); PG8_STAGE(PG8_SB(0, 1), b2 + hstep, voffB); PG8_STAGE(PG8_SA(0, 0), a2, voffA);
            PG8_WAIT_V(8); PG8_WAIT_L(0); PG8_BAR; PG8_MMA(1, 0, At, B0); PG8_MMA(1, 1, At, B1); PG8_BAR; PG8_SCHED;
            PG8_LDB(B0, 1, 0); PG8_LDB(B1, 1, 1); PG8_SCHED; PG8_LDA(At, 1, 0); PG8_STAGE(PG8_SA(0, 1), a2 + hstep, voffA);
            PG8_WAIT_V(8); PG8_WAIT_L(0); PG8_BAR; PG8_MMA(0, 0, At, B0); PG8_MMA(0, 1, At, B1); PG8_BAR; PG8_SCHED;
            PG8_LDA(At, 1, 1); PG8_STAGE(PG8_SB(1, 0), b3, voffB); PG8_STAGE(PG8_SB(1, 1), b3 + hstep, voffB); PG8_STAGE(PG8_SA(1, 0), a3, voffA);
            PG8_WAIT_V(8); PG8_WAIT_L(0); PG8_BAR; PG8_MMA(1, 0, At, B0); PG8_MMA(1, 1, At, B1); PG8_BAR; PG8_SCHED;
            } else {
            PG8_LDB(B0, 0, 0); PG8_SCHED; PG8_LDA(At, 0, 0); PG8_STAGE(PG8_SA(1, 1), a1 + hstep, voffA);
            PG8_WAIT_L(8); PG8_BAR; PG8_WAIT_L(0); PG8_MMA(0, 0, At, B0); PG8_BAR; PG8_SCHED;
            PG8_LDB(B1, 0, 1); PG8_STAGE(PG8_SB(0, 0), b2, voffB);
            PG8_BAR; PG8_WAIT_L(0); PG8_MMA(0, 1, At, B1); PG8_BAR;
            PG8_LDA(At, 0, 1); PG8_STAGE(PG8_SA(0, 0), a2, voffA);
            PG8_BAR; PG8_WAIT_L(0); PG8_MMA(1, 0, At, B0); PG8_BAR; PG8_SCHED;
            PG8_STAGE(PG8_SB(0, 1), b2 + hstep, voffB);
            PG8_WAIT_V(6); PG8_BAR; PG8_MMA(1, 1, At, B1); PG8_BAR;
            PG8_LDB(B0, 1, 0); PG8_SCHED; PG8_LDA(At, 1, 0); PG8_STAGE(PG8_SA(0, 1), a2 + hstep, voffA);
            PG8_WAIT_L(8); PG8_BAR; PG8_WAIT_L(0); PG8_MMA(0, 0, At, B0); PG8_BAR; PG8_SCHED;
            PG8_LDB(B1, 1, 1); PG8_STAGE(PG8_SB(1, 0), b3, voffB);
            PG8_BAR; PG8_WAIT_L(0); PG8_MMA(0, 1, At, B1); PG8_BAR;
            PG8_LDA(At, 1, 1); PG8_STAGE(PG8_SA(1, 0), a3, voffA);
            PG8_BAR; PG8_WAIT_L(0); PG8_MMA(1, 0, At, B0); PG8_BAR; PG8_SCHED;
            PG8_STAGE(PG8_SB(1, 1), b3 + hstep, voffB);
            PG8_WAIT_V(6); PG8_BAR; PG8_MMA(1, 1, At, B1); PG8_BAR;
            }
        }
        if constexpr (ALIGN_EPI) { if (wr == 0) PG8_BAR; }
        if constexpr (!Epi::AFTER_DRAIN) { E(acc, cur, wr, wc, fr, fq); S.done(cur); }
        if (!has_next) break;
#pragma unroll
        for (int a = 0; a < 2; ++a)
#pragma unroll
            for (int b = 0; b < 2; ++b)
#pragma unroll
                for (int m = 0; m < 4; ++m)
#pragma unroll
                    for (int n = 0; n < 2; ++n) acc[a][b][m][n] = (f32x4){0.f, 0.f, 0.f, 0.f};
        cur = nxt; cA = nA; cB = nB; ++ui;
        if constexpr (ALIGN_EPI) { if (wr == 1) PG8_BAR; }
    }
    PG8_WAIT_V(0);
    if constexpr (!ALIGN_EPI) { if (wr == 0) PG8_BAR; }
    PG8_BAR;
    if constexpr (Epi::AFTER_DRAIN) { E.fused(acc, cur, wr, wc, fr, fq, lds, wid, lane); S.done(cur); }
#undef PG8_SA
#undef PG8_SB
#undef PG8_STAGE
#undef PG8_LDA
#undef PG8_LDB
#undef PG8_MMA
#undef PG8_WAIT_V
#undef PG8_WAIT_L
#undef PG8_BAR
#undef PG8_SCHED
}
}
#define XB_TMO      128
#define XB_XCNT(j)  (256  + 64 * (j))
#define XB_XSUB(j)  (1280 + 64 * (j))
#define XB_XGEN(j)  (2304 + 64 * (j))
#define XB_TOP      3328
#define XB_TOPGEN   3392
#define XCD_BAR_WORDS 3456
#define XB_SPIN_CAP (1u << 18)

__device__ __forceinline__ unsigned xb_ld(unsigned* p)              { return __hip_atomic_load(p, __ATOMIC_RELAXED, __HIP_MEMORY_SCOPE_AGENT); }
__device__ __forceinline__ unsigned xb_add(unsigned* p, unsigned v) { return __hip_atomic_fetch_add(p, v, __ATOMIC_RELAXED, __HIP_MEMORY_SCOPE_AGENT); }
__device__ __forceinline__ unsigned xb_xcc_id() { return (unsigned)__builtin_amdgcn_s_getreg((3 << 11) | 20) & 0xFu; }
#define XB_SPIN(cond, bar) do { unsigned _sp = 0; while (cond) { __builtin_amdgcn_s_sleep(1); \
    if ((++_sp & 255u) == 0u) { if (xb_ld(&(bar)[XB_TMO])) break; if (_sp > XB_SPIN_CAP) { atomicAdd(&(bar)[XB_TMO], 1u); break; } } } } while (0)

struct XcdBarrier {
    unsigned* bar; unsigned x;
    volatile LAS unsigned* st;
};

__device__ __forceinline__ XcdBarrier xcd_barrier_post(unsigned* bar, volatile LAS unsigned* st) {
    XcdBarrier b; b.bar = bar; b.x = xb_xcc_id(); b.st = st;
    if (threadIdx.x == 0) (void)xb_add(&bar[XB_XCNT(b.x)], 1u);
    return b;
}
__device__ __forceinline__ void xcd_barrier_complete(unsigned* bar, unsigned x, unsigned& nloc, unsigned& nx) {
    const unsigned G = gridDim.x * gridDim.y * gridDim.z;
    unsigned sum, cnt, mine, sp = 0u;
    for (;;) {
        sum = 0u; cnt = 0u; mine = 0u;
#pragma unroll
        for (unsigned j = 0; j < 16; ++j) { const unsigned c = xb_ld(&bar[XB_XCNT(j)]); sum += c; cnt += (c > 0u) ? 1u : 0u; mine = (j == x) ? c : mine; }
        if (sum == G) break;
        __builtin_amdgcn_s_sleep(1);
        if ((++sp & 255u) == 0u) { if (xb_ld(&bar[XB_TMO])) break; if (sp > XB_SPIN_CAP) { atomicAdd(&bar[XB_TMO], 1u); break; } }
    }
    nloc = mine > 0u ? mine : 1u; nx = cnt > 0u ? cnt : 1u;
}

__device__ __forceinline__ void xcd_barrier(const XcdBarrier& b) {
    asm volatile("s_waitcnt vmcnt(0)" ::: "memory");
    __syncthreads();
    if (threadIdx.x == 0) {
        unsigned* bar = b.bar;
        __builtin_amdgcn_s_waitcnt(0);
        unsigned nloc = b.st[0], nx = b.st[1];
        if (nloc == 0u) { xcd_barrier_complete(bar, b.x, nloc, nx); b.st[0] = nloc; b.st[1] = nx; }
        const unsigned old = xb_add(&bar[XB_XSUB(b.x)], 1u);
        const unsigned gen = old / nloc;
        if (old + 1u == (gen + 1u) * nloc) {
            __builtin_amdgcn_fence(__ATOMIC_RELEASE, "agent");
            asm volatile("s_waitcnt vmcnt(0)" ::: "memory");
            const unsigned og = xb_add(&bar[XB_TOP], 1u);
            const unsigned tg = og / nx;
            if (og + 1u == (tg + 1u) * nx) xb_add(&bar[XB_TOPGEN], 1u);
            else XB_SPIN(xb_ld(&bar[XB_TOPGEN]) == tg, bar);
            __builtin_amdgcn_fence(__ATOMIC_ACQUIRE, "agent");
            xb_add(&bar[XB_XGEN(b.x)], 1u);
            asm volatile("s_waitcnt vmcnt(0)" ::: "memory");
        } else {
            XB_SPIN(xb_ld(&bar[XB_XGEN(b.x)]) == gen, bar);
            __builtin_amdgcn_fence(__ATOMIC_ACQUIRE, "agent");
            asm volatile("s_waitcnt vmcnt(0)" ::: "memory");
        }
    }
    __syncthreads();
}

#define LDS_WAIT() asm volatile("s_waitcnt lgkmcnt(0)" ::: "memory")
#define VM_WAIT() asm volatile("s_waitcnt vmcnt(0)" ::: "memory")
#define SBAR() __builtin_amdgcn_sched_barrier(0)
__device__ __forceinline__ unsigned cvtpk(float lo, float hi) { unsigned r; asm volatile("v_cvt_pk_bf16_f32 %0, %1, %2" : "=v"(r) : "v"(lo), "v"(hi)); return r; }
__device__ __forceinline__ float bf_lo(unsigned w) { return __uint_as_float(w << 16); }
__device__ __forceinline__ float bf_hi(unsigned w) { return __uint_as_float(w & 0xffff0000u); }
__device__ __forceinline__ float bf2f(bf16_t h) { return __uint_as_float(((unsigned)h) << 16); }
__device__ __forceinline__ float wave_sum(float v) {
#pragma unroll
    for (int o = 1; o < 64; o <<= 1) v += __shfl_xor(v, o);
    return v;
}
__device__ __forceinline__ float fast_exp2(float x) { return __builtin_amdgcn_exp2f(x); }
__device__ __forceinline__ float fast_log2(float x) { return __builtin_amdgcn_logf(x); }
__device__ __forceinline__ float fast_rcp(float x) { return __builtin_amdgcn_rcpf(x); }

__device__ __forceinline__ int tid_now() { int t = (int)threadIdx.x; asm volatile("" : "+v"(t)); return t; }

struct Params { const float* in[27]; float* out; unsigned char* ws; int ph_lo, ph_hi; };

struct TrJob { int src, N, c0, ncols, K, gain, r0; size_t dst; };
__device__ __forceinline__ void tr_item(const float* W, int N, int c0, int ncols, int K, const float* gain, bf16_t* WT, int r0, int kb, int nb, LAS float* scr, int lane) {
    const int k0 = kb * 64, n0 = nb * 64;
    const float* src = W + (size_t)k0 * N + c0 + n0 + lane;
#pragma unroll 16
    for (int i = 0; i < 64; ++i) scr[i * 65 + lane] = src[(size_t)i * N];
    LDS_WAIT(); asm volatile("" ::: "memory");
    const int c = lane & 7;
    float gv[8];
#pragma unroll
    for (int e = 0; e < 8; ++e) gv[e] = gain ? gain[k0 + 8 * c + e] : 1.0f;
#pragma unroll
    for (int j = 0; j < 8; ++j) { const int n = (lane >> 3) + 8 * j; const LAS float* s = scr + (8 * c) * 65 + n;
        u32x4 o; o.x = cvtpk(s[0 * 65] * gv[0], s[1 * 65] * gv[1]); o.y = cvtpk(s[2 * 65] * gv[2], s[3 * 65] * gv[3]); o.z = cvtpk(s[4 * 65] * gv[4], s[5 * 65] * gv[5]); o.w = cvtpk(s[6 * 65] * gv[6], s[7 * 65] * gv[7]);
        if (n0 + n >= ncols) o = (u32x4){0u, 0u, 0u, 0u};
        *(u32x4*)(WT + (size_t)(r0 + n0 + n) * K + k0 + 8 * c) = o; }
    LDS_WAIT(); asm volatile("" ::: "memory");
}
constexpr int NJOBS = 21;
__device__ __forceinline__ TrJob get_job(int id) {
    TrJob j{};
    if (id < 16) { const int l = id >> 3, k = id & 7, ib = 2 + 8 * l;
        switch (k) {
        case 0: j = TrJob{ib + 1, 19552, 0, 7168, 4096, ib, 0, WS_WAIN + l * WAIN_BYTES}; break;
        case 1: j = TrJob{ib + 1, 19552, 7264, 12288, 4096, ib, 7168, WS_WAIN + l * WAIN_BYTES}; break;
        case 2: j = TrJob{ib + 1, 19552, 7168, 96, 4096, ib, 0, WS_WG + (size_t)l * 128 * 4096 * 2}; break;
        case 3: j = TrJob{ib + 7, 4096, 0, 4096, 4096, -1, 0, WS_WAOUT + l * WOUT_BYTES}; break;
        case 4: j = TrJob{ib + 3, 128, 0, 128, 4096, -1, 0, WS_W1T + (size_t)(l * 2 + 0) * 128 * 4096 * 2}; break;
        case 5: j = TrJob{ib + 5, 128, 0, 128, 4096, -1, 0, WS_W1T + (size_t)(l * 2 + 1) * 128 * 4096 * 2}; break;
        case 6: j = TrJob{ib + 4, 128, 0, 128, 128, -1, 0, WS_W2T + (size_t)(l * 2 + 0) * 128 * 128 * 2}; break;
        default: j = TrJob{ib + 6, 128, 0, 128, 128, -1, 0, WS_W2T + (size_t)(l * 2 + 1) * 128 * 128 * 2}; break;
        }
    } else {
        switch (id) {
        case 16: j = TrJob{19, 8192, 0, 8192, 4096, 18, 0, WS_WKVQ}; break;
        case 17: j = TrJob{21, 8192, 0, 8192, 4096, 20, 8192, WS_WKVQ}; break;
        case 18: j = TrJob{22, 4096, 0, 4096, 4096, -1, 0, WS_WBOUT}; break;
        case 19: j = TrJob{24, 8192, 0, 8192, 4096, 23, 0, WS_WB3}; break;
        default: j = TrJob{25, 4096, 0, 4096, 4096, -1, 0, WS_WBOUT + WOUT_BYTES}; break;
        }
    }
    return j;
}
__device__ __forceinline__ int job_items(const TrJob& j) { return (j.K / 64) * ((j.ncols + 63) / 64); }

__device__ __forceinline__ void phase_x_to_bf16(const float* x, bf16_t* xb, float* ss) {
    const int tid = tid_now(), lane = tid & 63, gw = blockIdx.x * 8 + __builtin_amdgcn_readfirstlane(tid >> 6), ngw = gridDim.x * 8;
    for (int m = gw; m < MTOK; m += ngw) {
        const f32x4* xr = (const f32x4*)(x + (size_t)m * DM) + 2 * lane; u32x4* o16 = (u32x4*)(xb + (size_t)m * DM) + lane;
        f32x4 v[16]; float s = 0.f;
#pragma unroll
        for (int j = 0; j < 8; ++j) { v[2 * j] = xr[128 * j]; v[2 * j + 1] = xr[128 * j + 1]; }
#pragma unroll
        for (int j = 0; j < 16; ++j) s += (v[j].x * v[j].x + v[j].y * v[j].y) + (v[j].z * v[j].z + v[j].w * v[j].w);
#pragma unroll
        for (int j = 0; j < 8; ++j) { u32x4 w; w.x = cvtpk(v[2 * j].x, v[2 * j].y); w.y = cvtpk(v[2 * j].z, v[2 * j].w); w.z = cvtpk(v[2 * j + 1].x, v[2 * j + 1].y); w.w = cvtpk(v[2 * j + 1].z, v[2 * j + 1].w); o16[64 * j] = w; }
        s = wave_sum(s);
        if (lane == 0) ss[m] = s;
    }
}
__device__ __forceinline__ void phase_final_norm(const bf16_t* xb, float* out, const float* g, const float* ss, LAS unsigned char* lds) {
    const int tid = tid_now(), lane = tid & 63, wave = __builtin_amdgcn_readfirstlane(tid >> 6);
    LAS float* RSF = (LAS float*)lds;
    for (int r0 = blockIdx.x * 64; r0 < MTOK; r0 += gridDim.x * 64) {
        __syncthreads();
        { const int row = tid & 63, part = tid >> 6; float s8 = 0.f;
#pragma unroll
          for (int p = 0; p < 8; ++p) s8 += ss[(size_t)(part * 8 + p) * MTOK + r0 + row];
          RSF[64 + part * 64 + row] = s8; }
        __syncthreads();
        if (tid < 64) { float t = 0.f;
#pragma unroll
            for (int q = 0; q < 8; ++q) t += RSF[64 + q * 64 + tid];
            RSF[tid] = 1.0f / sqrtf(t * (1.0f / DM) + RMS_EPS); }
        __syncthreads();
        for (int k = 0; k < 8; ++k) { const int m = r0 + wave * 8 + k;
            const u32x4* xr = (const u32x4*)(xb + (size_t)m * DM) + lane; f32x4* orow = (f32x4*)(out + (size_t)m * DM) + 2 * lane; const f32x4* gr = (const f32x4*)g + 2 * lane;
            const float rstd = RSF[wave * 8 + k];
#pragma unroll
            for (int j = 0; j < 8; ++j) { const u32x4 v = xr[64 * j];
                const f32x4 lo = (f32x4){__uint_as_float(v.x << 16), __uint_as_float(v.x & 0xffff0000u), __uint_as_float(v.y << 16), __uint_as_float(v.y & 0xffff0000u)};
                const f32x4 hi = (f32x4){__uint_as_float(v.z << 16), __uint_as_float(v.z & 0xffff0000u), __uint_as_float(v.w << 16), __uint_as_float(v.w & 0xffff0000u)};
                orow[128 * j] = lo * rstd * gr[128 * j]; orow[128 * j + 1] = hi * rstd * gr[128 * j + 1]; } }
    }
}

__device__ __forceinline__ void phase_prologue(const Params& P, LAS unsigned char* lds) {
    const int tid = tid_now(), lane = tid & 63, wave = __builtin_amdgcn_readfirstlane(tid >> 6), G = gridDim.x;
    LAS float* scr = (LAS float*)(lds + wave * 16640);
    const int gw = blockIdx.x * 8 + wave, ngw = G * 8;
    int base = 0;
    for (int id = 0; id < NJOBS; ++id) {
        const TrJob j = get_job(id); const int ni = job_items(j), nbn = (j.ncols + 63) / 64;
        int it = gw - (base % ngw); if (it < 0) it += ngw;
        const float* W = P.in[j.src]; const float* gain = j.gain >= 0 ? P.in[j.gain] : nullptr; bf16_t* WT = (bf16_t*)(P.ws + j.dst);
        for (; it < ni; it += ngw) tr_item(W, j.N, j.c0, j.ncols, j.K, gain, WT, j.r0, it / nbn, it % nbn, scr, lane);
        base += ni;
    }
    __syncthreads();
    for (int item = blockIdx.x; item < 64; item += G) {
        const int lk = item >> 4, kp = item & 15, l = lk >> 1, kv = lk & 1, ib = 2 + 8 * l;
        const float* pos = P.in[ib + 2]; const float* w1 = P.in[ib + 3 + 2 * kv];
        const int col = tid & 127, part = tid >> 7, kbeg = kp * 256 + part * 64; float s = 0.f;
#pragma unroll 8
        for (int k = kbeg; k < kbeg + 64; ++k) s += pos[k] * w1[(size_t)k * 128 + col];
        LAS float* red = (LAS float*)lds;
        red[part * 128 + col] = s; __syncthreads();
        if (tid < 128) ((float*)(P.ws + WS_C1))[item * 128 + tid] = (red[tid] + red[128 + tid]) + (red[256 + tid] + red[384 + tid]);
        __syncthreads();
    }
    phase_x_to_bf16(P.in[0], (bf16_t*)(P.ws + WS_XB), (float*)(P.ws + WS_SS));
}

__device__ __forceinline__ bf16x8 ld8(const bf16_t* p) { return *(const bf16x8*)p; }
__device__ __forceinline__ void compress_unit(const Params& P, int l, int cu, LAS unsigned char* lds) {
    const int tid = tid_now(), lane = tid & 63, wave = __builtin_amdgcn_readfirstlane(tid >> 6);
    const int rt = cu & 3, kv = (cu >> 2) & 1, bg = cu >> 3, b = bg >> 2, g = bg & 3;
    const bf16_t* raw = (const bf16_t*)(P.ws + WS_KV) + (size_t)(b * SEQ) * KVW + kv * 512 + g * 128;
    const bf16_t* w1t = (const bf16_t*)(P.ws + WS_W1T) + (size_t)(l * 2 + kv) * 128 * 4096;
    const bf16_t* w2t = (const bf16_t*)(P.ws + WS_W2T) + (size_t)(l * 2 + kv) * 128 * 128;
    const float* c1p = (const float*)(P.ws + WS_C1) + (size_t)(l * 2 + kv) * 16 * 128;
    bf16_t* outp = (bf16_t*)(P.ws + (kv ? WS_VC : WS_KC)) + (size_t)bg * 128 * 128;
    const int fr = lane & 15, fq = lane >> 4;
    LAS float* PART = (LAS float*)lds;
    LAS bf16_t* H = (LAS bf16_t*)(lds + 131072);
    {
        int n0 = rt * 32 + fr, n1 = n0 + 16; n0 = n0 > 126 ? 126 : n0; n1 = n1 > 126 ? 126 : n1;
        const bf16_t* ap0 = raw + (size_t)(16 * n0 + wave * 4) * KVW + fq * 8; const bf16_t* ap1 = raw + (size_t)(16 * n1 + wave * 4) * KVW + fq * 8;
        const bf16_t* bp = w1t + (size_t)fr * 4096 + wave * 512 + fq * 8;
        f32x4 acc[2][8];
#pragma unroll
        for (int i = 0; i < 2; ++i)
#pragma unroll
            for (int c = 0; c < 8; ++c) acc[i][c] = (f32x4){0.f, 0.f, 0.f, 0.f};
#pragma unroll 4
        for (int ks = 0; ks < 16; ++ks) {
            const bf16x8 a0 = ld8(ap0 + (size_t)(ks >> 2) * KVW + (ks & 3) * 32), a1 = ld8(ap1 + (size_t)(ks >> 2) * KVW + (ks & 3) * 32);
            bf16x8 bb[8];
#pragma unroll
            for (int c = 0; c < 8; ++c) bb[c] = ld8(bp + (size_t)c * 16 * 4096 + ks * 32);
#pragma unroll
            for (int c = 0; c < 8; ++c) { acc[0][c] = __builtin_amdgcn_mfma_f32_16x16x32_bf16(a0, bb[c], acc[0][c], 0, 0, 0); acc[1][c] = __builtin_amdgcn_mfma_f32_16x16x32_bf16(a1, bb[c], acc[1][c], 0, 0, 0); }
        }
#pragma unroll
        for (int i = 0; i < 2; ++i)
#pragma unroll
            for (int c = 0; c < 8; ++c)
#pragma unroll
                for (int r = 0; r < 4; ++r) PART[(wave * 32 + i * 16 + fq * 4 + r) * 128 + c * 16 + fr] = acc[i][c][r];
    }
    __syncthreads();
    { const int col = tid & 127; float cc = 0.f;
#pragma unroll
      for (int kp = 0; kp < 16; ++kp) cc += c1p[kp * 128 + col];
#pragma unroll
      for (int e = 0; e < 8; ++e) { const int row = (tid >> 7) * 8 + e; float v = cc;
#pragma unroll
          for (int w = 0; w < 8; ++w) v += PART[(w * 32 + row) * 128 + col];
          const float sv = v * fast_rcp(1.0f + fast_exp2(-v * LOG2E));
          H[row * 136 + col] = (bf16_t)(cvtpk(sv, 0.f) & 0xffffu); } }
    __syncthreads();
    const int rtile = wave & 1, ct0 = (wave >> 1) * 2;
    f32x4 o0 = {0.f, 0.f, 0.f, 0.f}, o1 = {0.f, 0.f, 0.f, 0.f};
#pragma unroll
    for (int ks = 0; ks < 4; ++ks) {
        const bf16x8 a = *(const LAS bf16x8*)(H + (rtile * 16 + fr) * 136 + ks * 32 + fq * 8);
        const bf16x8 b0 = ld8(w2t + (size_t)(ct0 * 16 + fr) * 128 + ks * 32 + fq * 8), b1 = ld8(w2t + (size_t)((ct0 + 1) * 16 + fr) * 128 + ks * 32 + fq * 8);
        o0 = __builtin_amdgcn_mfma_f32_16x16x32_bf16(a, b0, o0, 0, 0, 0);
        o1 = __builtin_amdgcn_mfma_f32_16x16x32_bf16(a, b1, o1, 0, 0, 0);
    }
#pragma unroll
    for (int c = 0; c < 2; ++c) { const int col = (ct0 + c) * 16 + fr;
#pragma unroll
        for (int r = 0; r < 4; ++r) { const int nr = rt * 32 + rtile * 16 + fq * 4 + r; const float v = nr < NCMP ? (c ? o1[r] : o0[r]) : 0.f;
            outp[(size_t)nr * 128 + col] = (bf16_t)(cvtpk(v, 0.f) & 0xffffu); } }
    __syncthreads();
}
__device__ __forceinline__ void gate_unit(const Params& P, int l, int gu, LAS unsigned char* lds) {
    const int tid = tid_now(), lane = tid & 63, wave = __builtin_amdgcn_readfirstlane(tid >> 6);
    const bf16_t* xb = (const bf16_t*)(P.ws + WS_XB); const bf16_t* wg = (const bf16_t*)(P.ws + WS_WG) + (size_t)l * 128 * 4096;
    const float* ss = l == 0 ? (const float*)(P.ws + WS_SS) : (const float*)(P.ws + WS_SSP); const int np = l == 0 ? 1 : SS_NP;
    float* Gt = (float*)(P.ws + WS_G);
    const int fr = lane & 15, fq = lane >> 4, kq = wave & 3, rh = wave >> 2;
    LAS float* PART = (LAS float*)lds;
    {
        const bf16_t* ap = xb + (size_t)(gu * 64 + rh * 32 + fr) * DM + kq * 1024 + fq * 8;
        const bf16_t* bp = wg + (size_t)fr * DM + kq * 1024 + fq * 8;
        f32x4 acc[2][6];
#pragma unroll
        for (int i = 0; i < 2; ++i)
#pragma unroll
            for (int c = 0; c < 6; ++c) acc[i][c] = (f32x4){0.f, 0.f, 0.f, 0.f};
#pragma unroll 4
        for (int ks = 0; ks < 32; ++ks) {
            const bf16x8 a0 = ld8(ap + ks * 32), a1 = ld8(ap + (size_t)16 * DM + ks * 32);
            bf16x8 bb[6];
#pragma unroll
            for (int c = 0; c < 6; ++c) bb[c] = ld8(bp + (size_t)c * 16 * DM + ks * 32);
#pragma unroll
            for (int c = 0; c < 6; ++c) { acc[0][c] = __builtin_amdgcn_mfma_f32_16x16x32_bf16(a0, bb[c], acc[0][c], 0, 0, 0); acc[1][c] = __builtin_amdgcn_mfma_f32_16x16x32_bf16(a1, bb[c], acc[1][c], 0, 0, 0); }
        }
#pragma unroll
        for (int i = 0; i < 2; ++i)
#pragma unroll
            for (int c = 0; c < 6; ++c)
#pragma unroll
                for (int r = 0; r < 4; ++r) PART[(kq * 64 + rh * 32 + i * 16 + fq * 4 + r) * 96 + c * 16 + fr] = acc[i][c][r];
    }
    LAS float* RSG = (LAS float*)(lds + 98304);
    if (tid < 64) RSG[tid] = 1.0f / sqrtf(row_sumsq(ss, np, gu * 64 + tid) * (1.0f / DM) + RMS_EPS);
    __syncthreads();
    for (int e = tid; e < 64 * 96; e += 512) { const int row = e / 96, col = e - row * 96;
        const float v = (PART[row * 96 + col] + PART[(64 + row) * 96 + col]) + (PART[(128 + row) * 96 + col] + PART[(192 + row) * 96 + col]);
        const float lg = v * RSG[row];
        Gt[(size_t)(gu * 64 + row) * NGATE + col] = fast_rcp(1.0f + fast_exp2(-lg * LOG2E)); }
    __syncthreads();
}

namespace att {
constexpr int SHM_K = 16384, SHM_V = 16384, NSLOT = 3;
constexpr int OFF_V = 0, OFF_K = NSLOT * SHM_V;
constexpr int OFF_IMP = NSLOT * (SHM_V + SHM_K);
constexpr int OFF_FIN = OFF_IMP + 8 * 32 * 33 * 4;
constexpr int OFF_SELM = OFF_FIN + 32 * 33 * 4;
constexpr int OFF_BT = OFF_SELM + 128;
constexpr int OFF_WS = OFF_BT + 8 * 132 * 4;
constexpr int OFF_DONE = OFF_WS + 8 * 64 * 4;
constexpr int ATT_LDS_END = OFF_DONE + 64;
static_assert(ATT_LDS_END <= MISC_OFF, "attention LDS map");

#define KSWZ(row, colB) ((row) * 256 + ((colB) ^ (((row) & 7) << 4)))
__device__ __forceinline__ int v_st(int k, int c) { const int kk = (k & ~0xC) | ((k & 4) << 1) | ((k & 8) >> 1); return ((kk >> 3) * 4 + (c >> 5)) * 512 + ((kk & 7) * 32 + (c & 31)) * 2; }
__device__ __forceinline__ int v_rd_base(int lane) { return ((lane & 3) << 3) | (((lane >> 2) & 3) << 6) | (((lane >> 4) & 1) << 5) | (((lane >> 5) & 1) << 8); }
constexpr int v_rd_off(int d0, int ks, int half) { return d0 * 512 + ks * 4096 + half * 2048; }
__device__ __forceinline__ int crow(int r, int hi) { return (r & 3) + 8 * (r >> 2) + 4 * hi; }

struct Geo { int tid, wid, lane, r32, hi, vb0; };
__device__ __forceinline__ Geo make_geo(LAS unsigned char* lds) {
    Geo g; g.tid = tid_now(); g.wid = __builtin_amdgcn_readfirstlane(g.tid >> 6); g.lane = g.tid & 63; g.r32 = g.lane & 31; g.hi = g.lane >> 5;
    g.vb0 = (int)(uintptr_t)(lds + OFF_V) + v_rd_base(g.lane);
    return g;
}
struct DmaOff { unsigned k[2], v[2]; };
__device__ __forceinline__ DmaOff make_dma(const Geo& g, int ld) {
    DmaOff d;
#pragma unroll
    for (int i = 0; i < 2; ++i) { const int ch = g.wid + 8 * i;
        const int krow = 4 * ch + (g.lane >> 4), kc = (g.lane & 15) ^ (krow & 7);
        d.k[i] = (unsigned)(krow * ld * 2 + kc * 16);
        const int sub = 2 * ch + (g.lane >> 5), kk = 8 * (sub >> 2) + ((g.lane & 31) >> 2), key = (kk & ~0xC) | ((kk & 4) << 1) | ((kk & 8) >> 1);
        d.v[i] = (unsigned)(key * ld * 2 + ((sub & 3) * 32 + (g.lane & 3) * 8) * 2); }
    return d;
}
__device__ __forceinline__ void dma_tile(LAS unsigned char* lds, int slot, const bf16_t* Kp, const bf16_t* Vp, size_t ld, int key0, DmaOff d, const Geo& g) {
    asm volatile("" : "+v"(d.k[0]), "+v"(d.k[1]), "+v"(d.v[0]), "+v"(d.v[1]));
    const char* kb = (const char*)Kp + (size_t)key0 * ld * 2; const char* vb = (const char*)Vp + (size_t)key0 * ld * 2;
#pragma unroll
    for (int i = 0; i < 2; ++i) {
        __builtin_amdgcn_global_load_lds((const unsigned*)(kb + d.k[i]), (LAS unsigned*)(lds + OFF_K + slot * SHM_K + (g.wid + 8 * i) * 1024), 16, 0, 0);
        __builtin_amdgcn_global_load_lds((const unsigned*)(vb + d.v[i]), (LAS unsigned*)(lds + OFF_V + slot * SHM_V + (g.wid + 8 * i) * 1024), 16, 0, 0); }
}
#define WAIT_VM(n) asm volatile("s_waitcnt vmcnt(" #n ")" ::: "memory")
#define RAW_BAR() do { asm volatile("s_waitcnt lgkmcnt(0)" ::: "memory"); __builtin_amdgcn_s_barrier(); asm volatile("" ::: "memory"); } while (0)
__device__ __forceinline__ void qkt(f32x16& p0, f32x16& p1, LAS unsigned char* lds, int buf, const Geo& g, const bf16x8* qr) {
    p0 = f32x16{}; p1 = f32x16{};
    LAS unsigned char* kb[4];
#pragma unroll
    for (int dd = 0; dd < 4; ++dd) kb[dd] = lds + OFF_K + buf * SHM_K + KSWZ(g.r32, (dd * 16 + g.hi * 8) * 2);
#pragma unroll
    for (int d0 = 0; d0 < 8; ++d0) { LAS unsigned char* a = kb[d0 & 3] + (d0 >> 2) * 128;
        const bf16x8 b0 = *(const LAS bf16x8*)a, b1 = *(const LAS bf16x8*)(a + 32 * 256);
        p0 = __builtin_amdgcn_mfma_f32_32x32x16_bf16(b0, qr[d0], p0, 0, 0, 0);
        p1 = __builtin_amdgcn_mfma_f32_32x32x16_bf16(b1, qr[d0], p1, 0, 0, 0); }
}
__device__ __forceinline__ void pv_tile(f32x16* o, int vb, bf16x8 pa0, bf16x8 pa1, bf16x8 pa2, bf16x8 pa3) {
#define TRRD(dst, off) asm volatile("ds_read_b64_tr_b16 %0, %1 offset:%2" : "=&v"(dst) : "v"(vb), "i"(off) : "memory")
#define PV_D0(d0) do { s16x4 l0, l1, l2, l3, h0, h1, h2, h3; constexpr int b_ = v_rd_off(d0, 0, 0); \
        TRRD(l0, b_); TRRD(h0, b_ + 2048); TRRD(l1, b_ + 4096); TRRD(h1, b_ + 6144); TRRD(l2, b_ + 8192); TRRD(h2, b_ + 10240); TRRD(l3, b_ + 12288); TRRD(h3, b_ + 14336); \
        asm volatile("s_waitcnt lgkmcnt(0)" ::: "memory"); SBAR(); \
        o[d0] = __builtin_amdgcn_mfma_f32_32x32x16_bf16(pa0, (bf16x8){l0[0], l0[1], l0[2], l0[3], h0[0], h0[1], h0[2], h0[3]}, o[d0], 0, 0, 0); \
        o[d0] = __builtin_amdgcn_mfma_f32_32x32x16_bf16(pa1, (bf16x8){l1[0], l1[1], l1[2], l1[3], h1[0], h1[1], h1[2], h1[3]}, o[d0], 0, 0, 0); \
        o[d0] = __builtin_amdgcn_mfma_f32_32x32x16_bf16(pa2, (bf16x8){l2[0], l2[1], l2[2], l2[3], h2[0], h2[1], h2[2], h2[3]}, o[d0], 0, 0, 0); \
        o[d0] = __builtin_amdgcn_mfma_f32_32x32x16_bf16(pa3, (bf16x8){l3[0], l3[1], l3[2], l3[3], h3[0], h3[1], h3[2], h3[3]}, o[d0], 0, 0, 0); } while (0)
    PV_D0(0); PV_D0(1); PV_D0(2); PV_D0(3);
#undef PV_D0
#undef TRRD
}
__device__ __forceinline__ void pack_p(const f32x16& p0, const f32x16& p1, bf16x8& pa0, bf16x8& pa1, bf16x8& pa2, bf16x8& pa3) {
#define PK4(P, B_, OUT) do { unsigned a0 = cvtpk(P[B_+0], P[B_+1]), a1 = cvtpk(P[B_+2], P[B_+3]); \
        unsigned b0 = cvtpk(P[B_+4], P[B_+5]), b1 = cvtpk(P[B_+6], P[B_+7]); \
        auto r0 = __builtin_amdgcn_permlane32_swap(a0, b0, false, false); auto r1 = __builtin_amdgcn_permlane32_swap(a1, b1, false, false); \
        u32x4 w = {r0[0], r1[0], r0[1], r1[1]}; OUT = *reinterpret_cast<bf16x8*>(&w); } while (0)
    PK4(p0, 0, pa0); PK4(p0, 8, pa1); PK4(p1, 0, pa2); PK4(p1, 8, pa3);
#undef PK4
}
__device__ __forceinline__ void pair_vals(float x, float& lo, float& hi) {
    auto rr = __builtin_amdgcn_permlane32_swap(__float_as_uint(x), __float_as_uint(x), false, false);
    lo = __uint_as_float(rr[0]); hi = __uint_as_float(rr[1]);
}
__device__ __forceinline__ float pair_max(float x) { float a, b; pair_vals(x, a, b); return fmaxf(a, b); }
__device__ __forceinline__ float pair_sum(float x) { float a, b; pair_vals(x, a, b); return a + b; }

constexpr float SM_THR = 8.0f;
__device__ __forceinline__ void rescale_o(f32x16* o, float alpha, LAS float* al_l, const Geo& g) {
    if (g.hi == 0) al_l[g.r32] = alpha;
    LDS_WAIT();
#pragma unroll
    for (int r = 0; r < 16; ++r) { const float a = al_l[crow(r, g.hi)];
#pragma unroll
        for (int d = 0; d < 4; ++d) o[d][r] *= a; }
}
__device__ __forceinline__ void softmax_step(f32x16& p0, f32x16& p1, float mulc, float badd, bool ok, float& m_reg, float& l_reg, f32x16* o, LAS float* al_l, const Geo& g) {
    const float NEG = -__builtin_inff();
    float xmax = fmaxf(p0[0], p1[0]);
#pragma unroll
    for (int r = 1; r < 16; ++r) xmax = fmaxf(xmax, fmaxf(p0[r], p1[r]));
    xmax = pair_max(xmax);
    const float smax = ok ? fmaf(xmax, mulc, badd) : NEG;
    float mn = m_reg, alpha = 1.0f;
    if (!__all(smax - m_reg <= SM_THR)) { mn = fmaxf(m_reg, smax); alpha = fast_exp2(m_reg - mn); m_reg = mn; rescale_o(o, alpha, al_l, g); }
    const float addc = ok ? (badd - mn) : NEG;
    float ps = 0.f;
#pragma unroll
    for (int r = 0; r < 16; ++r) { p0[r] = fast_exp2(fmaf(p0[r], mulc, addc)); ps += p0[r]; }
#pragma unroll
    for (int r = 0; r < 16; ++r) { p1[r] = fast_exp2(fmaf(p1[r], mulc, addc)); ps += p1[r]; }
    ps = pair_sum(ps);
    l_reg = l_reg * alpha + ps;
}

struct NsaT { const bf16_t* Q; const bf16_t* KV; const bf16_t* Z; const float* Gt; const bf16_t* KC; const bf16_t* VC; bf16_t* MIX; const float* rel_bias; };

constexpr int EMIT_ROWB = 144, EMIT_TILE = 32 * EMIT_ROWB;
static_assert(8 * EMIT_TILE <= OFF_SELM - OFF_IMP, "emit tiles fit the IMP + FIN region");
__device__ __forceinline__ void silu2_mul(unsigned ov, unsigned zv, float& lo, float& hi) {
    const float z0 = bf_lo(zv), z1 = bf_hi(zv);
    lo = bf_lo(ov) * z0 * fast_rcp(1.0f + fast_exp2(-z0 * LOG2E)); hi = bf_hi(ov) * z1 * fast_rcp(1.0f + fast_exp2(-z1 * LOG2E));
}
__device__ __forceinline__ float lane_xor1(float x) { return __int_as_float(__builtin_amdgcn_update_dpp(0, __float_as_int(x), 0xB1, 0xF, 0xF, true)); }
template <bool RMW, bool SCALE>
__device__ __forceinline__ void emit_tile(LAS unsigned char* lds, const f32x16* o, float f, const bf16_t* zb  , size_t zld,
                                          bf16_t* mb  , LAS float* li_l, const Geo& g) {
    const int row = g.lane >> 1, half = g.lane & 1;
    unsigned zoff = (unsigned)(row * (int)zld + half * 32), moff = (unsigned)(row * DM + half * 32);
    asm volatile("" : "+v"(zoff), "+v"(moff));
    u32x4 zv[2][4]; u32x4 old[2][4];
#pragma unroll
    for (int c = 0; c < 2; ++c)
#pragma unroll
        for (int q = 0; q < 4; ++q) zv[c][q] = *(const u32x4*)(zb + zoff + 64 * c + q * 8);
    if (RMW) {
#pragma unroll
        for (int c = 0; c < 2; ++c)
#pragma unroll
            for (int q = 0; q < 4; ++q) { const unsigned long long* ap = (const unsigned long long*)(mb + moff + 64 * c + q * 8);
                const unsigned long long a0 = __hip_atomic_load(ap, __ATOMIC_RELAXED, __HIP_MEMORY_SCOPE_AGENT), a1 = __hip_atomic_load(ap + 1, __ATOMIC_RELAXED, __HIP_MEMORY_SCOPE_AGENT);
                old[c][q] = (u32x4){(unsigned)a0, (unsigned)(a0 >> 32), (unsigned)a1, (unsigned)(a1 >> 32)}; }
    }
    float fr[16];
    if (SCALE) { if (g.hi == 0) li_l[g.r32] = f;
        LDS_WAIT();
#pragma unroll
        for (int r = 0; r < 16; ++r) fr[r] = li_l[(r & 3) + 8 * (r >> 2) + 4 * g.hi]; }
    LAS unsigned char* T = lds + OFF_IMP + g.wid * EMIT_TILE;
    const LAS unsigned char* trow = T + row * EMIT_ROWB + half * 64;
#pragma unroll
    for (int c = 0; c < 2; ++c) {
#pragma unroll
        for (int r = 0; r < 16; ++r) { const int rc = (r & 3) + 8 * (r >> 2);
#pragma unroll
            for (int dd = 0; dd < 2; ++dd) { const float v = SCALE ? o[2 * c + dd][r] * fr[r] : o[2 * c + dd][r]; const float vn = lane_xor1(v);
                if ((g.r32 & 1) == 0) *(LAS unsigned*)(T + (rc + 4 * g.hi) * EMIT_ROWB + (dd * 32 + g.r32) * 2) = cvtpk(v, vn); } }
        LDS_WAIT();
#pragma unroll
        for (int q = 0; q < 4; ++q) { const u32x4 ov = *(const LAS u32x4*)(trow + q * 16); u32x4 w;
#pragma unroll
            for (int e = 0; e < 4; ++e) { float lo, hi; silu2_mul(ov[e], zv[c][q][e], lo, hi);
                if (RMW) { lo += bf_lo(old[c][q][e]); hi += bf_hi(old[c][q][e]); }
                w[e] = cvtpk(lo, hi); }
            *(u32x4*)(mb + moff + 64 * c + q * 8) = w; }
        asm volatile("" ::: "memory");
    }
}

template <int MODE>
__device__ __forceinline__ void tile_softmax(f32x16& p0, f32x16& p1, int kb, int t0, bool selbit, const LAS float* btw, float& m_reg, float& l_reg, f32x16* o, LAS float* al_l, const Geo& g) {
    constexpr float C2 = SM_SCALE * LOG2E; const float NEG = -__builtin_inff();
    const bool near = (kb + 63 + 128 > t0);
    const bool wedge = (MODE == 2) && (t0 + 31 - kb >= 512);
    bool ok = (MODE == 1) ? selbit : true; float mulc = C2, badd = btw[128];
    if (near || wedge) {
        const int dq = t0 + g.r32 - kb - 4 * g.hi; const unsigned W = (MODE == 2) ? 512u : 0x7fffffffu;
#pragma unroll
        for (int r = 0; r < 16; ++r) { const int c = (r & 3) + 8 * (r >> 2);
            const unsigned d0 = (unsigned)(dq - c), d1 = (unsigned)(dq - c - 32);
            float b0 = btw[d0 < 128u ? d0 : 128u], b1 = btw[d1 < 128u ? d1 : 128u];
            asm volatile("" : "+v"(b0), "+v"(b1));
            p0[r] = (ok && d0 < W) ? fmaf(p0[r], C2, b0) : NEG; p1[r] = (ok && d1 < W) ? fmaf(p1[r], C2, b1) : NEG;
            if ((r & 3) == 3) asm volatile("" ::: "memory"); }
        mulc = 1.0f; badd = 0.f; ok = true;
    }
    softmax_step(p0, p1, mulc, badd, ok, m_reg, l_reg, o, al_l, g);
}

struct TileIter { unsigned rem; int nxt, j_hi, j, j1, j2; };
template <int MODE> __device__ __forceinline__ void ti_next(TileIter& it, int& dst) {
    if (MODE == 1) { dst = it.rem ? __builtin_ctz(it.rem) : -1; it.rem &= it.rem - 1u; } else { dst = (it.nxt <= it.j_hi) ? it.nxt : -1; ++it.nxt; } }
template <int MODE> __device__ __forceinline__ TileIter ti_init(unsigned umask, int j_lo, int j_hi) {
    TileIter it; it.rem = umask; it.nxt = j_lo; it.j_hi = j_hi; ti_next<MODE>(it, it.j); ti_next<MODE>(it, it.j1); ti_next<MODE>(it, it.j2); return it; }
__device__ __forceinline__ void branch_issue(LAS unsigned char* lds, const TileIter& it, const bf16_t* Kp, const bf16_t* Vp, size_t ld, const DmaOff& dof, const Geo& g) {
    dma_tile(lds, 0, Kp, Vp, ld, 64 * it.j, dof, g);
    if (it.j1 >= 0) dma_tile(lds, 1, Kp, Vp, ld, 64 * it.j1, dof, g);
}
template <int MODE>
__device__ __forceinline__ void branch_run(f32x16* o, float& l_out, LAS unsigned char* lds, TileIter it, const bf16_t* Kp, const bf16_t* Vp, size_t ld, const DmaOff& dof, const bf16x8* qr,
                                           unsigned selword, int t0, const LAS float* btw, LAS float* al_l, const Geo& g) {
    float m_reg = -1e30f, l_reg = 0.f;
#pragma unroll
    for (int d = 0; d < 4; ++d) o[d] = f32x16{};
    int slot = 0; bool first = true;
    for (;;) {
        if (first || it.j1 < 0) WAIT_VM(0); else WAIT_VM(4);
        first = false;
        RAW_BAR();
        if (it.j2 >= 0) dma_tile(lds, slot >= 1 ? slot - 1 : 2, Kp, Vp, ld, 64 * it.j2, dof, g);
        f32x16 p0, p1;
        qkt(p0, p1, lds, slot, g, qr);
        tile_softmax<MODE>(p0, p1, 64 * it.j, t0, ((selword >> it.j) & 1u) != 0u, btw, m_reg, l_reg, o, al_l, g);
        bf16x8 pa0, pa1, pa2, pa3; pack_p(p0, p1, pa0, pa1, pa2, pa3);
        pv_tile(o, g.vb0 + slot * SHM_V, pa0, pa1, pa2, pa3);
        if (it.j1 < 0) break;
        it.j = it.j1; it.j1 = it.j2; ti_next<MODE>(it, it.j2); slot = slot == 2 ? 0 : slot + 1;
    }
    RAW_BAR();
    l_out = l_reg;
}

__device__ __forceinline__ int t5_bucket(int d) {
    if (d < 16) return d;
    const float lr = logf((float)d / 16.0f);
    int large = 16 + (int)(lr / 2.0794415416798357f * 16.0f);
    return large < 31 ? large : 31;
}


struct NsaUnit { int b, grp, t0; };
__device__ __forceinline__ NsaUnit nsa_decode(int u) {
    const int p = u >> 1, s2 = u & 1, k = p >> 8, w = p & 255, bg = (w & 7) + 8 * k, i = ((w >> 3) + 8 * k) & 31;
    NsaUnit r; r.b = bg >> 2; r.grp = bg & 3; r.t0 = s2 ? 32 * i : 32 * (63 - i); return r; }
__device__ __forceinline__ void nsa_issue_cmp(LAS unsigned char* lds, const NsaT& A, const NsaUnit& U, const Geo& g) {
    const bf16_t* Kc = A.KC + (size_t)(U.b * NGRP + U.grp) * 128 * 128; const bf16_t* Vc = A.VC + (size_t)(U.b * NGRP + U.grp) * 128 * 128;
    const DmaOff dc = make_dma(g, 128);
    dma_tile(lds, 0, Kc, Vc, 128, 0, dc, g); dma_tile(lds, 1, Kc, Vc, 128, 64, dc, g);
}
__device__ __forceinline__ void nsa_unit(LAS unsigned char* lds, const NsaT& A, const NsaUnit U, bool build_bt) {
    const Geo g = make_geo(lds);
    __syncthreads();
    nsa_issue_cmp(lds, A, U, g);
    const int b = U.b, grp = U.grp, t0 = U.t0, h = grp * 8 + g.wid;
    LAS float* IMP = (LAS float*)(lds + OFF_IMP); LAS float* FIN = (LAS float*)(lds + OFF_FIN); LAS unsigned* SELM = (LAS unsigned*)(lds + OFF_SELM);
    LAS float* BT = (LAS float*)(lds + OFF_BT); LAS float* wsl = (LAS float*)(lds + OFF_WS) + g.wid * 64;
    const LAS float* btw = BT + g.wid * 132;
    float gates[3];
    { const float* gp = A.Gt + (size_t)(b * SEQ + t0) * NGATE + h + (unsigned)(g.r32 * NGATE);
#pragma unroll
      for (int br = 0; br < 3; ++br) gates[br] = gp[br * 32]; }
    bf16x8 qr[8];
    { const bf16_t* qp = A.Q + (size_t)(b * SEQ + t0) * DM + h * 128 + (unsigned)(g.r32 * DM + g.hi * 8);
#pragma unroll
      for (int d0 = 0; d0 < 8; ++d0) qr[d0] = *(const bf16x8*)(qp + d0 * 16); }
    if (build_bt) for (int e = g.tid; e < 8 * 129; e += 512) { const int r = e / 129, d = e - r * 129; BT[r * 132 + d] = A.rel_bias[t5_bucket(d) * NH + grp * 8 + r] * LOG2E; }
    const bf16_t* Ks = A.KV + (size_t)(b * SEQ) * KVW + 1024 + grp * 128; const bf16_t* Vs = Ks + 512;
    const bf16_t* Kw = Ks + 1024; const bf16_t* Vw = Kw + 512;
    const DmaOff dof = make_dma(g, KVW);
    f32x16 o[4]; float l_reg;
    unsigned selword, um;
    WAIT_VM(0);
    __syncthreads();
    {
        f32x16 pA0, pA1, pB0, pB1;
        qkt(pA0, pA1, lds, 0, g, qr); qkt(pB0, pB1, lds, 1, g, qr);
        constexpr float C2 = SM_SCALE * LOG2E; const float NEG = -__builtin_inff();
        const int dbase = t0 + g.r32 - 31 - 64 * g.hi;
        float pmax = NEG;
#pragma unroll
        for (int r = 0; r < 16; ++r) { const int c = (r & 3) + 8 * (r >> 2);
#define CSC(P, NL) do { const int dist = dbase - 16 * (NL); const unsigned ud = (unsigned)dist; const float bb = btw[ud < 128u ? ud : 128u]; \
            P[r] = dist >= 0 ? fmaf(P[r], C2, bb) : NEG; pmax = fmaxf(pmax, P[r]); } while (0)
            CSC(pA0, c); CSC(pA1, c + 32); CSC(pB0, c + 64); CSC(pB1, c + 96);
#undef CSC
        }
        pmax = pair_max(pmax);
        const float mref = (pmax == NEG) ? 0.f : pmax;
        float ps = 0.f;
#pragma unroll
        for (int r = 0; r < 16; ++r) { pA0[r] = fast_exp2(pA0[r] - mref); pA1[r] = fast_exp2(pA1[r] - mref); pB0[r] = fast_exp2(pB0[r] - mref); pB1[r] = fast_exp2(pB1[r] - mref);
            ps += (pA0[r] + pA1[r]) + (pB0[r] + pB1[r]); }
        ps = pair_sum(ps);
        l_reg = ps;
        const float inv = ps > 0.f ? 1.0f / ps : 0.f;
        float qs[16], e3[16];
#pragma unroll
        for (int i = 0; i < 4; ++i) {
            qs[0 + i] = ((pA0[4 * i] + pA0[4 * i + 1]) + (pA0[4 * i + 2] + pA0[4 * i + 3])) * inv; e3[0 + i] = pA0[4 * i + 3] * inv;
            qs[4 + i] = ((pA1[4 * i] + pA1[4 * i + 1]) + (pA1[4 * i + 2] + pA1[4 * i + 3])) * inv; e3[4 + i] = pA1[4 * i + 3] * inv;
            qs[8 + i] = ((pB0[4 * i] + pB0[4 * i + 1]) + (pB0[4 * i + 2] + pB0[4 * i + 3])) * inv; e3[8 + i] = pB0[4 * i + 3] * inv;
            qs[12 + i] = ((pB1[4 * i] + pB1[4 * i + 1]) + (pB1[4 * i + 2] + pB1[4 * i + 3])) * inv; e3[12 + i] = pB1[4 * i + 3] * inv;
        }
        { LAS float* ip = IMP + (g.wid * 32 + g.r32) * 33;
          float prev_hi1 = 0.f;
#pragma unroll
          for (int idx = 0; idx < 16; ++idx) { float lo, hi1; pair_vals(e3[idx], lo, hi1);
              const float add = g.hi ? lo : prev_hi1;
              ip[2 * idx + g.hi] = qs[idx] + add; prev_hi1 = hi1; } }
        bf16x8 a0, a1, a2, a3, c0, c1, c2, c3;
        pack_p(pA0, pA1, a0, a1, a2, a3); pack_p(pB0, pB1, c0, c1, c2, c3);
#pragma unroll
        for (int d = 0; d < 4; ++d) o[d] = f32x16{};
        pv_tile(o, g.vb0, a0, a1, a2, a3); pv_tile(o, g.vb0 + SHM_V, c0, c1, c2, c3);
    }
    LDS_WAIT();
    __syncthreads();
    dma_tile(lds, 0, Ks, Vs, KVW, 0, dof, g);
    {
        const int tl = g.tid >> 4, j0 = (g.tid & 15) * 2, tok = t0 + tl, cur = tok >> 6;
        float v2[2];
#pragma unroll
        for (int e = 0; e < 2; ++e) { const int j = j0 + e; float v = 0.f;
#pragma unroll
            for (int r = 0; r < 8; ++r) v += IMP[(r * 32 + tl) * 33 + j];
            const bool forced = (j == 0) || (j == cur) || (j == cur - 1), valid = (64 * j <= tok);
            v = forced ? 1.0e6f : (valid ? v : -1.0f); v2[e] = v; FIN[tl * 33 + j] = v; }
        LDS_WAIT();
        __syncthreads();
        unsigned bits = 0u;
#pragma unroll
        for (int e = 0; e < 2; ++e) { const int j = j0 + e; int cnt = 0;
#pragma unroll
            for (int i = 0; i < 32; ++i) { const float w = FIN[tl * 33 + i]; cnt += (w > v2[e] || (w == v2[e] && i < j)) ? 1 : 0; }
            if (cnt < 16) bits |= 1u << j; }
        bits |= (unsigned)__builtin_amdgcn_update_dpp(0, (int)bits, 0xB1, 0xF, 0xF, true);
        bits |= (unsigned)__builtin_amdgcn_update_dpp(0, (int)bits, 0x4E, 0xF, 0xF, true);
        bits |= (unsigned)__builtin_amdgcn_update_dpp(0, (int)bits, 0x141, 0xF, 0xF, true);
        bits |= (unsigned)__builtin_amdgcn_update_dpp(0, (int)bits, 0x140, 0xF, 0xF, true);
        if ((g.tid & 15) == 0) SELM[tl] = bits;
        LDS_WAIT();
        __syncthreads();
        selword = SELM[g.r32]; um = selword;
        um |= __shfl_xor(um, 1); um |= __shfl_xor(um, 2); um |= __shfl_xor(um, 4); um |= __shfl_xor(um, 8); um |= __shfl_xor(um, 16);
        const int jmax = (t0 + 31) >> 6;
        um = __builtin_amdgcn_readfirstlane(um) & (jmax >= 31 ? 0xffffffffu : ((2u << jmax) - 1u));
    }
    TileIter its = ti_init<1>(um, 0, 0);
    if (its.j1 >= 0) dma_tile(lds, 1, Ks, Vs, KVW, 64 * its.j1, dof, g);
    const bf16_t* zb = A.Z + (size_t)(b * SEQ + t0) * ZW + h * 128;
    bf16_t* mb = A.MIX + (size_t)(b * SEQ + t0) * DM + h * 128;
    emit_tile<false, true>(lds, o, (l_reg > 0.f ? 1.0f / l_reg : 0.f) * gates[0], zb, ZW, mb, wsl, g);
    branch_run<1>(o, l_reg, lds, its, Ks, Vs, KVW, dof, qr, selword, t0, btw, wsl + 32, g);
    const int lowk = t0 - 511;
    TileIter itw = ti_init<2>(0u, lowk > 0 ? lowk >> 6 : 0, (t0 + 31) >> 6);
    branch_issue(lds, itw, Kw, Vw, KVW, dof, g);
    emit_tile<true, true>(lds, o, (1.0f / l_reg) * gates[1], zb + 4096, ZW, mb, wsl, g);
    branch_run<2>(o, l_reg, lds, itw, Kw, Vw, KVW, dof, qr, 0u, t0, btw, wsl + 32, g);
    emit_tile<true, true>(lds, o, (1.0f / l_reg) * gates[2], zb + 8192, ZW, mb, wsl, g);
}
__device__ __forceinline__ void nsa_phase(LAS unsigned char* lds, const NsaT& A) {
    const int G = gridDim.x, first = 2 * (int)blockIdx.x;
    if (first >= 2048) return;
    int prev_grp = -1;
#pragma unroll 1
    for (int u = first; u < 2048; u = (u & 1) ? u + 2 * G - 1 : u + 1) {
        const NsaUnit U = nsa_decode(u);
        nsa_unit(lds, A, U, U.grp != prev_grp);
        prev_grp = U.grp;
    }
    VM_WAIT();
    __syncthreads();
}

constexpr bool SB_EARLY_EXIT = true;
constexpr float SB_PCUT = 1.0e-37f;
struct SbT { const bf16_t* QZ; const bf16_t* KVSH; bf16_t* MIX; };
struct SbUnit { int b, h, qb; };
__device__ __forceinline__ SbUnit sb_decode(int u) {
    const int p = u >> 1, s2 = u & 1, k = p >> 8, w = p & 255, bh = k * 64 + (w & 7) * 8 + (w >> 5), pi = ((w >> 3) + k) & 3;
    SbUnit r; r.b = bh >> 5; r.h = bh & 31; r.qb = s2 ? pi : 7 - pi; return r; }
__device__ __forceinline__ void sb_issue(LAS unsigned char* lds, const SbT& A, const SbUnit& U, const Geo& g) {
    const bf16_t* Kp = A.KVSH + (size_t)(U.b * SEQ) * 8192 + U.h * 128; const bf16_t* Vp = Kp + 4096;
    const DmaOff dof = make_dma(g, 8192); const int j = 4 * U.qb + 3;
    dma_tile(lds, 0, Kp, Vp, 8192, 64 * j, dof, g); dma_tile(lds, 1, Kp, Vp, 8192, 64 * (j - 1), dof, g);
}
__device__ __forceinline__ void sb_unit(LAS unsigned char* lds, const SbT& A, const SbUnit U, bool has_next, const SbUnit UN) {
    const Geo g = make_geo(lds);
    const int b = U.b, h = U.h, qb = U.qb;
    LAS unsigned* DONE = (LAS unsigned*)(lds + OFF_DONE);
    const int tw0 = qb * 256 + g.wid * 32, t = tw0 + g.r32;
    bf16x8 qr[8];
    { const bf16_t* qp = A.QZ + (size_t)(b * SEQ + tw0) * 8192 + h * 128 + (unsigned)(g.r32 * 8192 + g.hi * 8);
#pragma unroll
      for (int d0 = 0; d0 < 8; ++d0) qr[d0] = *(const bf16x8*)(qp + d0 * 16); }
    const bf16_t* Kp = A.KVSH + (size_t)(b * SEQ) * 8192 + h * 128; const bf16_t* Vp = Kp + 4096;
    f32x16 o[4];
#pragma unroll
    for (int d = 0; d < 4; ++d) o[d] = f32x16{};
    float PR = 1.0f; bool wdone = false;
    const DmaOff dof = make_dma(g, 8192);
    int j = 4 * qb + 3, bank = 0, slot = 0;
    for (int step = 0;; ++step) {
        if (step > 0 && j >= 1) WAIT_VM(4); else WAIT_VM(0);
        RAW_BAR();
        if (SB_EARLY_EXIT && step > 0) { unsigned all = 1u;
#pragma unroll
            for (int w = 0; w < 8; ++w) all &= DONE[bank * 8 + w];
            bank ^= 1;
            if (__builtin_amdgcn_readfirstlane(all)) break; }
        if (j >= 2) dma_tile(lds, slot >= 1 ? slot - 1 : 2, Kp, Vp, 8192, 64 * (j - 2), dof, g);
        const int kb = 64 * j;
        const bool active = (kb <= tw0 + 30) && !wdone;
        if (active) {
            f32x16 p0, p1;
            qkt(p0, p1, lds, slot, g, qr);
            const bool needmask = (kb + 63 >= tw0);
            const int dq = t - kb - 4 * g.hi;
            constexpr float ZS = SM_SCALE * LOG2E;
            float rr0[16], rr1[16];
#pragma unroll
            for (int r = 0; r < 16; ++r) { const int c = (r & 3) + 8 * (r >> 2);
                float e0 = fast_exp2(fminf(p0[r] * ZS, 64.0f)), e1 = fast_exp2(fminf(p1[r] * ZS, 64.0f));
                if (needmask) { e0 = (dq - c > 0) ? e0 : 0.f; e1 = (dq - c - 32 > 0) ? e1 : 0.f; }
                p0[r] = e0; p1[r] = e1; rr0[r] = fast_rcp(1.0f + e0); rr1[r] = fast_rcp(1.0f + e1); }
            float tot[8];
#pragma unroll
            for (int i = 0; i < 4; ++i) {
                rr0[4 * i + 2] *= rr0[4 * i + 3]; rr0[4 * i + 1] *= rr0[4 * i + 2]; rr0[4 * i] *= rr0[4 * i + 1]; tot[i] = rr0[4 * i];
                rr1[4 * i + 2] *= rr1[4 * i + 3]; rr1[4 * i + 1] *= rr1[4 * i + 2]; rr1[4 * i] *= rr1[4 * i + 1]; tot[4 + i] = rr1[4 * i];
            }
            float off[8]; float suf = PR;
#pragma unroll
            for (int idx = 7; idx >= 0; --idx) { float t0_, t1_; pair_vals(tot[idx], t0_, t1_);
                const float oh1 = suf; suf *= t1_; const float oh0 = suf; suf *= t0_; off[idx] = g.hi ? oh1 : oh0; }
            PR = suf;
#pragma unroll
            for (int r = 0; r < 16; ++r) { p0[r] *= rr0[r] * off[r >> 2]; p1[r] *= rr1[r] * off[4 + (r >> 2)]; }
            bf16x8 pa0, pa1, pa2, pa3; pack_p(p0, p1, pa0, pa1, pa2, pa3);
            pv_tile(o, g.vb0 + slot * SHM_V, pa0, pa1, pa2, pa3);
            if (SB_EARLY_EXIT) wdone = __all(PR < SB_PCUT);
        }
        if (SB_EARLY_EXIT && g.lane == 0) DONE[bank * 8 + g.wid] = wdone ? 1u : 0u;
        if (j == 0) break;
        --j; slot = slot == 2 ? 0 : slot + 1;
    }
    WAIT_VM(0);
    RAW_BAR();
    if (has_next) sb_issue(lds, A, UN, g);
    emit_tile<false, false>(lds, o, 1.0f, A.QZ + (size_t)(b * SEQ + tw0) * 8192 + 4096 + h * 128, 8192, A.MIX + (size_t)(b * SEQ + tw0) * DM + h * 128, (LAS float*)(lds + OFF_WS), g);
}
__device__ __forceinline__ void sb_phase(LAS unsigned char* lds, const SbT& A) {
    const int G = gridDim.x, first = 2 * (int)blockIdx.x;
    if (first >= 2048) return;
    { const Geo g = make_geo(lds); sb_issue(lds, A, sb_decode(first), g); }
#pragma unroll 1
    for (int u = first; u < 2048; u = (u & 1) ? u + 2 * G - 1 : u + 1) {
        const int un = (u & 1) ? u + 2 * G - 1 : u + 1; const bool has_next = un < 2048;
        sb_unit(lds, A, sb_decode(u), has_next, sb_decode(has_next ? un : u));
    }
    VM_WAIT();
    __syncthreads();
}
}

constexpr int NPHASES = 16;
__global__ void __launch_bounds__(512, 2) yoco_fwd(Params P) {
    extern __shared__ __attribute__((aligned(16))) unsigned char lds_raw[];
    LAS unsigned char* lds = (LAS unsigned char*)lds_raw;
    const int G = gridDim.x;
    volatile LAS unsigned* MISC = (volatile LAS unsigned*)(lds + MISC_OFF);
    { const int t0_ = tid_now(); if (t0_ < 64) MISC[t0_] = 0u; }
    __syncthreads();
    unsigned char* ws = P.ws;
    XcdBarrier bar = xcd_barrier_post((unsigned*)(ws + WS_CTL), MISC + 8);
    const int lo = P.ph_lo, hi = P.ph_hi;
#define IN(k) (lo <= (k) && (k) < hi)
#define SEAM(k) do { if (IN(k) && IN((k) + 1)) xcd_barrier(bar); } while (0)
    bf16_t* HN = (bf16_t*)(ws + WS_HN); bf16_t* XB = (bf16_t*)(ws + WS_XB); float* SS = (float*)(ws + WS_SS); float* SSP = (float*)(ws + WS_SSP);

    if (IN(0)) phase_prologue(P, lds);
    SEAM(0);

#pragma unroll
    for (int l = 0; l < 2; ++l) {
        const int pb = 1 + 4 * l;
        if (IN(pb)) {
            pg8::Gemm g{XB, (const bf16_t*)(ws + WS_WAIN + l * WAIN_BYTES), MTOK, NSA_N, DM}; pg8::StaticOrder S; S.init(MTOK, NSA_N, G, (int)blockIdx.x);
            const int fm = 8 * ((int)blockIdx.x & 7); LAS float* RS = (LAS float*)(lds + 131072);
            const float* ssrc = l == 0 ? SS : SSP; const int np = l == 0 ? 1 : SS_NP;
            { const int i4 = tid_now() * 4; f32x4 s4 = {0.f, 0.f, 0.f, 0.f};
#pragma unroll 16
              for (int p = 0; p < np; ++p) s4 += *(const f32x4*)(ssrc + (size_t)p * MTOK + fm * 256 + i4);
#pragma unroll
              for (int k = 0; k < 4; ++k) RS[i4 + k] = 1.0f / sqrtf(s4[k] * (1.0f / DM) + RMS_EPS); }
            __syncthreads();
            pg8::EpiSplit E{(bf16_t*)(ws + WS_Q), DM, 16, (bf16_t*)(ws + WS_KV), KVW, 28, (bf16_t*)(ws + WS_Z), ZW, ssrc, RS, fm, np};
            pg8::gemm_phase<pg8::EpiSplit, pg8::StaticOrder, true, true>(lds, g, S, E);
        }
        SEAM(pb);
        if (IN(pb + 1)) {
            for (int u = blockIdx.x; u < 256; u += G) { compress_unit(P, l, u, lds); gate_unit(P, l, u, lds); }
        }
        SEAM(pb + 1);
        if (IN(pb + 2)) {
            att::NsaT A{(const bf16_t*)(ws + WS_Q), (const bf16_t*)(ws + WS_KV), (const bf16_t*)(ws + WS_Z), (const float*)(ws + WS_G),
                        (const bf16_t*)(ws + WS_KC), (const bf16_t*)(ws + WS_VC), HN, P.in[1]};
            att::nsa_phase(lds, A);
        }
        SEAM(pb + 2);
        if (IN(pb + 3)) {
            pg8::Gemm g{HN, (const bf16_t*)(ws + WS_WAOUT + l * WOUT_BYTES), MTOK, DM, DM}; pg8::StaticOrder S; S.init(MTOK, DM, G, (int)blockIdx.x);
            pg8::EpiRes E{XB, P.out, DM, SSP, 0};
            pg8::gemm_phase<pg8::EpiRes, pg8::StaticOrder, true, true>(lds, g, S, E);
        }
        SEAM(pb + 3);
    }

#pragma unroll
    for (int l = 2; l < 4; ++l) {
        const int pb = 9 + 3 * (l - 2);
        if (IN(pb)) {
            const int N = (l == 2) ? 16384 : 8192;
            pg8::Gemm g{XB, (const bf16_t*)(ws + (l == 2 ? WS_WKVQ : WS_WB3)), MTOK, N, DM}; pg8::StaticOrder S; S.init(MTOK, N, G, (int)blockIdx.x);
            const int fm = 8 * ((int)blockIdx.x & 7); LAS float* RS = (LAS float*)(lds + 131072);
            const float* ssrc = SSP; const int np = SS_NP;
            { const int i4 = tid_now() * 4; f32x4 s4 = {0.f, 0.f, 0.f, 0.f};
#pragma unroll 16
              for (int p = 0; p < np; ++p) s4 += *(const f32x4*)(ssrc + (size_t)p * MTOK + fm * 256 + i4);
#pragma unroll
              for (int k = 0; k < 4; ++k) RS[i4 + k] = 1.0f / sqrtf(s4[k] * (1.0f / DM) + RMS_EPS); }
            __syncthreads();
            pg8::EpiSplit E{(bf16_t*)(ws + (l == 2 ? WS_KVSH : WS_QZ)), 8192, 32, (bf16_t*)(ws + WS_QZ), 8192, 1 << 20, nullptr, 0, ssrc, RS, fm, np};
            pg8::gemm_phase<pg8::EpiSplit, pg8::StaticOrder, true, true>(lds, g, S, E);
        }
        SEAM(pb);
        if (IN(pb + 1)) {
            att::SbT A{(const bf16_t*)(ws + WS_QZ), (const bf16_t*)(ws + WS_KVSH), HN};
            att::sb_phase(lds, A);
        }
        SEAM(pb + 1);
        if (IN(pb + 2)) {
            pg8::Gemm g{HN, (const bf16_t*)(ws + WS_WBOUT + (l - 2) * WOUT_BYTES), MTOK, DM, DM}; pg8::StaticOrder S; S.init(MTOK, DM, G, (int)blockIdx.x);
            pg8::EpiRes E{XB, P.out, DM, SSP, 0};
            pg8::gemm_phase<pg8::EpiRes, pg8::StaticOrder, true, true>(lds, g, S, E);
        }
        SEAM(pb + 2);
    }
    if (IN(15)) phase_final_norm(XB, P.out, P.in[26], SSP, lds);
#undef IN
#undef SEAM
}

extern "C" void kernel_launch(void* const* d_in, const int* in_sizes, int n_in, void* d_out, int out_size, void* d_ws, size_t ws_size, hipStream_t stream) {
    static int grid = 0;
    if (grid == 0) {
        if (n_in != 27 || out_size != MTOK * DM || ws_size < WS_END) { fprintf(stderr, "kernel_launch: unexpected shapes (n_in %d, out %d, ws %zu < %zu)\n", n_in, out_size, ws_size, (size_t)WS_END); grid = -1; return; }
        int dev = 0, cus = 0, per_cu = 0;
        if (hipGetDevice(&dev) != hipSuccess || hipDeviceGetAttribute(&cus, hipDeviceAttributeMultiprocessorCount, dev) != hipSuccess || cus <= 0) { grid = -1; return; }
        if (hipFuncSetAttribute((const void*)yoco_fwd, hipFuncAttributeMaxDynamicSharedMemorySize, LDS_BYTES) != hipSuccess) { fprintf(stderr, "kernel_launch: hipFuncSetAttribute failed\n"); grid = -1; return; }
        if (hipOccupancyMaxActiveBlocksPerMultiprocessor(&per_cu, (const void*)yoco_fwd, 512, LDS_BYTES) != hipSuccess || per_cu < 1) { fprintf(stderr, "kernel_launch: occupancy query says %d\n", per_cu); }
        (void)hipGetLastError();
        grid = cus;
    }
    if (grid < 0) return;
    (void)hipMemsetAsync((char*)d_ws + WS_CTL, 0, CTL_ZERO_BYTES, stream);
    Params p{};
    for (int i = 0; i < 27; ++i) p.in[i] = (const float*)d_in[i];
    p.out = (float*)d_out; p.ws = (unsigned char*)d_ws;
    p.ph_lo = 0; p.ph_hi = NPHASES;
    hipLaunchKernelGGL(yoco_fwd, dim3(grid), dim3(512), LDS_BYTES, stream, p);
}
```
